# Optimizing an MI355X kernel written in HIP

```python
import math
import jax, jax.numpy as jnp
from jax import lax
import numpy as np

D_MODEL = 1024
BATCH = 16
SEQ = 4096
DEPTH = 4

N_MEM = 256
GRID_W = 64
EPS = 1e-6
FOURIER_GROUPS = 4
FOURIER_GROUP_DIM = D_MODEL // 8
FOURIER_WIDTH = FOURIER_GROUPS * FOURIER_GROUP_DIM
NA_HEADS = 4
NA_HEAD_DIM = D_MODEL // 8
NA_WIDTH = NA_HEADS * NA_HEAD_DIM
NA_KH = 8
NA_KW = 16
AB_IN_WIDTH = FOURIER_WIDTH + 3 * NA_WIDTH
AB_OUT_WIDTH = FOURIER_WIDTH + NA_WIDTH
CONV_WIDTH = 3
XA_HEADS = 4
XA_HEAD_DIM = D_MODEL // XA_HEADS
D_FF = 2 * D_MODEL
N_EVEN = (DEPTH + 1) // 2
N_ODD = DEPTH // 2

kernel_name = "hybrid_fourier_natten_shortconv_encoder"


def rms_norm(x, g):
    xf = x.astype(jnp.float32)
    y = xf * lax.rsqrt(jnp.mean(xf * xf, axis=-1, keepdims=True) + EPS)
    return (y * g.astype(jnp.float32)).astype(x.dtype)


def dwconv3_centred(x, w):
    xp = jnp.pad(x, ((0, 0), (1, 1), (0, 0)))
    return xp[:, :-2] * w[0] + xp[:, 1:-1] * w[1] + xp[:, 2:] * w[2]


def fourier_mix(u):
    f = jnp.fft.fft2(u.astype(jnp.float32), axes=(1, 3), norm="ortho")
    return jnp.real(f).astype(u.dtype)


def neighborhood_attention(q, k, v, rpb):
    B, S, H, dh = q.shape
    rows = S // GRID_W
    kh = min(NA_KH, rows)
    kw = NA_KW
    qg = q.reshape(B, rows, GRID_W, H, dh)
    kg = k.reshape(B, rows, GRID_W, H, dh)
    vg = v.reshape(B, rows, GRID_W, H, dh)
    cols = jnp.arange(GRID_W)
    col_start = jnp.clip(cols - kw // 2, 0, GRID_W - kw)
    col_idx = col_start[:, None] + jnp.arange(kw)[None, :]
    col_off = col_idx - cols[:, None] + (NA_KW - 1)
    scale = dh ** -0.5

    def one_row(i):
        rs = jnp.clip(i - kh // 2, 0, rows - kh)
        q_i = lax.dynamic_index_in_dim(qg, i, axis=1, keepdims=False)
        k_blk = lax.dynamic_slice_in_dim(kg, rs, kh, axis=1)
        v_blk = lax.dynamic_slice_in_dim(vg, rs, kh, axis=1)
        k_win = k_blk[:, :, col_idx]
        v_win = v_blk[:, :, col_idx]
        s = jnp.einsum('bjhd,brjchd->bhjrc', q_i, k_win).astype(jnp.float32) * scale
        row_off = rs + jnp.arange(kh) - i + (NA_KH - 1)
        bias = rpb[:, row_off][:, :, col_off]
        s = s + jnp.transpose(bias, (0, 2, 1, 3)).astype(jnp.float32)[None]
        p = jax.nn.softmax(s.reshape(B, H, GRID_W, kh * kw), axis=-1)
        p = p.reshape(B, H, GRID_W, kh, kw).astype(v.dtype)
        return jnp.einsum('bhjrc,brjchd->bjhd', p, v_win)

    out = lax.map(one_row, jnp.arange(rows))
    return jnp.moveaxis(out, 0, 1).reshape(B, S, H, dh)


def fourier_na_mixer(h, w_in, rpb, w_out):
    B, S, _ = h.shape
    z = h @ w_in
    zf = z[..., :FOURIER_WIDTH]
    q = z[..., FOURIER_WIDTH:FOURIER_WIDTH + NA_WIDTH].reshape(B, S, NA_HEADS, NA_HEAD_DIM)
    k = z[..., FOURIER_WIDTH + NA_WIDTH:FOURIER_WIDTH + 2 * NA_WIDTH].reshape(B, S, NA_HEADS, NA_HEAD_DIM)
    v = z[..., FOURIER_WIDTH + 2 * NA_WIDTH:].reshape(B, S, NA_HEADS, NA_HEAD_DIM)
    yf = fourier_mix(zf.reshape(B, S, FOURIER_GROUPS, FOURIER_GROUP_DIM)).reshape(B, S, FOURIER_WIDTH)
    ya = neighborhood_attention(q, k, v, rpb).reshape(B, S, NA_WIDTH)
    return jnp.concatenate([yf, ya], axis=-1) @ w_out


def short_gated_conv_mixer(h, w_in, conv_w, w_out):
    z = h @ w_in
    gate_b = z[..., :D_MODEL]
    gate_c = z[..., D_MODEL:2 * D_MODEL]
    u = z[..., 2 * D_MODEL:]
    return (gate_b * dwconv3_centred(gate_c * u, conv_w)) @ w_out


def memory_cross_attention(h, m, wq, wkv, wo):
    B, S, D = h.shape
    q = (h @ wq).reshape(B, S, XA_HEADS, XA_HEAD_DIM)
    kv = m @ wkv
    k = kv[..., :D].reshape(B, -1, XA_HEADS, XA_HEAD_DIM)
    v = kv[..., D:].reshape(B, -1, XA_HEADS, XA_HEAD_DIM)
    s = jnp.einsum('bshd,bmhd->bhsm', q, k).astype(jnp.float32) * (XA_HEAD_DIM ** -0.5)
    p = jax.nn.softmax(s, axis=-1).astype(v.dtype)
    o = jnp.einsum('bhsm,bmhd->bshd', p, v).reshape(B, S, D)
    return o @ wo


def conv_ffn(h, w_up, conv_w, conv_b, w_down):
    z = h @ w_up
    u = z[..., :D_FF]
    g = dwconv3_centred(z[..., D_FF:], conv_w) + conv_b
    return (jax.nn.gelu(g, approximate=False) * u) @ w_down


def setup_inputs(seed: int = 0) -> dict:
    key = jax.random.key(seed)
    ks = jax.random.split(key, 24)
    f32 = jnp.float32
    nrm = lambda k, shape, fan_in: jax.random.normal(k, shape, f32) * (fan_in ** -0.5)
    gain = lambda k, shape: 1.0 + 0.1 * jax.random.normal(k, shape, f32)
    D = D_MODEL
    return {
        "x": jax.random.normal(ks[0], (BATCH, SEQ, D), f32),
        "mem": jax.random.normal(ks[1], (BATCH, N_MEM, D), f32),
        "mem_norm_g": gain(ks[2], (D,)),
        "mix_norm_g": gain(ks[3], (DEPTH, D)),
        "w_in_ab": nrm(ks[4], (N_EVEN, D, AB_IN_WIDTH), D),
        "rpb": 0.02 * jax.random.normal(ks[5], (N_EVEN, NA_HEADS, 2 * NA_KH - 1, 2 * NA_KW - 1), f32),
        "w_out_ab": nrm(ks[6], (N_EVEN, AB_OUT_WIDTH, D), AB_OUT_WIDTH),
        "w_in_c": nrm(ks[7], (N_ODD, D, 3 * D), D),
        "conv_c": nrm(ks[8], (N_ODD, CONV_WIDTH, D), CONV_WIDTH),
        "w_out_c": nrm(ks[9], (N_ODD, D, D), D),
        "xa_norm_g": gain(ks[10], (DEPTH, D)),
        "xa_wq": nrm(ks[11], (DEPTH, D, D), D),
        "xa_wkv": nrm(ks[12], (DEPTH, D, 2 * D), D),
        "xa_wo": nrm(ks[13], (DEPTH, D, D), D),
        "ffn_norm_g": gain(ks[14], (DEPTH, D)),
        "ffn_w_up": nrm(ks[15], (DEPTH, D, 2 * D_FF), D),
        "ffn_conv_w": nrm(ks[16], (DEPTH, CONV_WIDTH, D_FF), CONV_WIDTH),
        "ffn_conv_b": 0.02 * jax.random.normal(ks[17], (DEPTH, D_FF), f32),
        "ffn_w_down": nrm(ks[18], (DEPTH, D_FF, D), D_FF),
        "final_norm_g": gain(ks[19], (D,)),
    }


def reference(x, mem, mem_norm_g, mix_norm_g, w_in_ab, rpb, w_out_ab, w_in_c, conv_c, w_out_c,
              xa_norm_g, xa_wq, xa_wkv, xa_wo, ffn_norm_g, ffn_w_up, ffn_conv_w, ffn_conv_b,
              ffn_w_down, final_norm_g):
    m = rms_norm(mem, mem_norm_g)
    h = x
    for layer in range(DEPTH):
        hn = rms_norm(h, mix_norm_g[layer])
        if layer % 2 == 0:
            j = layer // 2
            h = h + fourier_na_mixer(hn, w_in_ab[j], rpb[j], w_out_ab[j])
        else:
            j = layer // 2
            h = h + short_gated_conv_mixer(hn, w_in_c[j], conv_c[j], w_out_c[j])
        h = h + memory_cross_attention(rms_norm(h, xa_norm_g[layer]), m,
                                       xa_wq[layer], xa_wkv[layer], xa_wo[layer])
        h = h + conv_ffn(rms_norm(h, ffn_norm_g[layer]), ffn_w_up[layer],
                         ffn_conv_w[layer], ffn_conv_b[layer], ffn_w_down[layer])
    return rms_norm(h, final_norm_g)
```

```cpp
#include <hip/hip_runtime.h>
#include <hip/hip_cooperative_groups.h>
#include <cstdio>
#include <cstdint>
namespace cg = cooperative_groups;

#define LAS __attribute__((address_space(3)))
typedef unsigned short bf16_t;
typedef short bf16x8 __attribute__((ext_vector_type(8)));
typedef float f32x4 __attribute__((ext_vector_type(4)));
typedef float f32x2 __attribute__((ext_vector_type(2)));
typedef unsigned u32x4 __attribute__((ext_vector_type(4)));
typedef unsigned u32x2 __attribute__((ext_vector_type(2)));

constexpr int DM = 1024, NB = 16, SEQ = 4096, NTOK = NB * SEQ, DEPTH = 4, NMEM = 256, DFF = 2048;
constexpr float EPS = 1e-6f;
constexpr float LOG2E = 1.4426950408889634f;

constexpr size_t MiB = 1u << 20;
constexpr size_t WS_SSP = 1 * MiB;
constexpr size_t WS_W = 2 * MiB;
constexpr size_t WS_FCAT = 112 * MiB;
constexpr size_t WS_MB = 176 * MiB;
constexpr size_t WS_KV = 184 * MiB;
constexpr size_t WS_WQK = 200 * MiB;
constexpr size_t WS_VWO = 232 * MiB;
constexpr size_t WS_HB = 264 * MiB;
constexpr size_t WS_Z = 392 * MiB;
constexpr size_t WS_END = 904 * MiB;
constexpr size_t Z_DT = 0, Z_QK = 128 * MiB, Z_VT = 256 * MiB, Z_YE = 320 * MiB, Z_YO = 384 * MiB;

constexpr size_t W_EVEN = 0;
constexpr size_t W_EVEN_SZ = (size_t)(1024 + 1024 + 1024) * 1024;
constexpr size_t W_ODD = W_EVEN + 2 * W_EVEN_SZ;
constexpr size_t W_ODD_SZ = (size_t)(3072 + 1024) * 1024;
constexpr size_t W_LAY = W_ODD + 2 * W_ODD_SZ;
constexpr size_t W_LAY_SZ = (size_t)(1024 + 2048 + 1024 + 4096 + 2048) * 1024;
static_assert((W_LAY + 4 * W_LAY_SZ) * 2 <= 110 * MiB, "weights fit");

constexpr int RING_BYTES = 131072, XCH_OFF = RING_BYTES, XCH_BYTES = 8192, BARST_OFF = XCH_OFF + XCH_BYTES, LDS_BYTES = BARST_OFF + 16;

struct Params {
  const float* in[20]; float* out; unsigned char* ws;
};

#define CAS __attribute__((address_space(4)))
__device__ __forceinline__ CAS const char* ka_ptr() { CAS const char* ka = (CAS const char*)__builtin_amdgcn_kernarg_segment_ptr(); asm volatile("" : "+s"(ka)); return ka; }
__device__ __forceinline__ unsigned long long ka_u64(int off) { return *(CAS const unsigned long long*)(ka_ptr() + off); }
__device__ __forceinline__ const float* kin(int i) { return (const float*)(__attribute__((address_space(1))) const float*)ka_u64(8 * i); }
__device__ __forceinline__ float* kout() { return (float*)(__attribute__((address_space(1))) float*)ka_u64(160); }
__device__ __forceinline__ unsigned char* kws() { return (unsigned char*)(__attribute__((address_space(1))) unsigned char*)ka_u64(168); }
#define GAS __attribute__((address_space(1)))
template <class T> __device__ __forceinline__ T* uni(T* p) { const unsigned long long v = (unsigned long long)p; const unsigned lo = __builtin_amdgcn_readfirstlane((unsigned)v), hi = __builtin_amdgcn_readfirstlane((unsigned)(v >> 32)); return (T*)(GAS T*)(((unsigned long long)hi << 32) | lo); }
__device__ __forceinline__ int uni(int v) { return __builtin_amdgcn_readfirstlane(v); }
__device__ __forceinline__ unsigned cvt_pk_bf16(float lo, float hi) { unsigned r; asm volatile("v_cvt_pk_bf16_f32 %0, %1, %2" : "=v"(r) : "v"(lo), "v"(hi)); return r; }
__device__ __forceinline__ float bf_lo(unsigned u) { return __uint_as_float(u << 16); }
__device__ __forceinline__ float bf_hi(unsigned u) { return __uint_as_float(u & 0xffff0000u); }
__device__ __forceinline__ float wave_sum(float v) {
#pragma unroll
  for (int o = 1; o < 64; o <<= 1) v += __shfl_xor(v, o);
  return v;
}
__device__ __forceinline__ f32x2 gelu_pk(f32x2 v) {
  const f32x2 av = __builtin_elementwise_abs(v), d = av * 0.2316418882f + 1.0f;
  f32x2 t; t.x = __builtin_amdgcn_rcpf(d.x); t.y = __builtin_amdgcn_rcpf(d.y);
  f32x2 q = t * 0.5307027145f + (-0.7265760135f); q = q * t + 0.7107068705f; q = q * t + (-0.142248368f); q = q * t + 0.127414796f; q = q * t;
  const f32x2 s = (v * v) * (-0.72134752044f);
  f32x2 e; e.x = __builtin_amdgcn_exp2f(s.x); e.y = __builtin_amdgcn_exp2f(s.y);
  const f32x2 m = v * (q * e), r = v - m;
  f32x2 o; o.x = v.x < 0.f ? m.x : r.x; o.y = v.y < 0.f ? m.y : r.y; return o;
}
__device__ __forceinline__ float rstd_of(const float* ssp, size_t row) {
  const f32x4 s = *(const f32x4*)(ssp + row * 4);
  return rsqrtf(((s.x + s.y) + (s.z + s.w)) * (1.0f / DM) + EPS);
}

__device__ __forceinline__ void unpack8(const u32x4 w, float (&f)[8]) {
  f[0] = bf_lo(w.x); f[1] = bf_hi(w.x); f[2] = bf_lo(w.y); f[3] = bf_hi(w.y); f[4] = bf_lo(w.z); f[5] = bf_hi(w.z); f[6] = bf_lo(w.w); f[7] = bf_hi(w.w);
}

constexpr int BM = 256, BK = 64, HALF = 128, HTB = HALF * BK * 2, NXCD = 8, WGM = 8;
__device__ __forceinline__ int lds_byte(int r, int c) { const int st = (r >> 4) * 2 + (c >> 5), rr = r & 15, cc = c & 31, ob = rr * 64 + cc * 2; return st * 1024 + (ob ^ (((ob >> 9) & 1) << 5)); }
__device__ __forceinline__ void stage_rc(int b, int& R, int& C) { const int st = b / 1024, sb = b % 1024, swz = sb ^ (((sb >> 9) & 1) << 5); R = (st >> 1) * 16 + swz / 64; C = (st & 1) * 32 + (swz % 64) / 2; }
__device__ __forceinline__ int perm32(int rho) { const int n = rho >> 4, i = rho & 15; return 8 * (i >> 2) + 4 * n + (i & 3); }

struct Unit { int pm, pn; };
struct Job {
  const bf16_t* A; const bf16_t* Bt;
  int lda, ldb, K, nM, nN;
  int adiv, bdiv, odiv;
  int a0, a1, a2, b0, b1, b2;
  int r0, r1, r2, c0, c1, c2;
  bf16_t* O; int ldc;
  const float* ssp; float cscale;
  const float* base; float* H; float* sspw;
  bf16_t* O2;
  const float* cw; const float* cb;
  const bf16_t* GB;
  int chain;
};
__device__ __forceinline__ Job job_std(const bf16_t* A, int lda, const bf16_t* Bt, int ldb, int K, int nM, int nN, bf16_t* O, int ldc) {
  Job j; j.A = A; j.Bt = Bt; j.lda = lda; j.ldb = ldb; j.K = K; j.nM = nM; j.nN = nN;
  j.adiv = 1 << 20; j.bdiv = 1 << 20; j.odiv = 1 << 20;
  j.a0 = 256 * lda; j.a1 = 0; j.a2 = 0; j.b0 = 0; j.b1 = 0; j.b2 = 256 * ldb;
  j.r0 = 256; j.r1 = 0; j.r2 = 0; j.c0 = 0; j.c1 = 0; j.c2 = 256;
  j.O = O; j.ldc = ldc; j.ssp = nullptr; j.cscale = 1.0f; j.base = nullptr; j.H = nullptr; j.sspw = nullptr; j.O2 = nullptr; j.cw = nullptr; j.cb = nullptr; j.GB = nullptr; j.chain = 0;
  return j;
}
struct StaticOrder {
  int nM, nN, nwg, G, c, chain;
  __device__ __forceinline__ void init(int nM_, int nN_, int G_, int c_, int chain_) { nM = nM_; nN = nN_; nwg = nM * nN; G = G_; c = c_; chain = chain_; }
  __device__ __forceinline__ bool next(int i, Unit& u) const {
    if (chain == 4) {
      if (G != 256) { const int L = i * G + c; if (L >= nwg) return false; u.pm = uni(L >> 1); u.pn = uni(L & 1); return true; }
      if (i > 0) return false; const int x = c & 7, j = c >> 3; u.pn = uni(x >> 2); u.pm = uni((4 * (x & 3) + (j >> 3)) * 8 + (j & 7)); return true; }
    if (chain) {
      int bq, pq;
      if (G == 256) { if (i >= 16) return false; const int x = c & 7, j = c >> 3; bq = 8 * (x >> 2) + (j >> 2); pq = 4 * (x & 3) + (j & 3); }
      else { const int ch = c + (i >> 4) * G; if (ch >= 256) return false; bq = ch >> 4; pq = ch & 15; }
      u.pm = uni(bq * 16 + (i & 15)); u.pn = uni(pq); return true; }
    const int L = i * G + c; if (L >= nwg) return false;
    int wgid = L; { const int q = nwg / NXCD, r = nwg % NXCD, xcd = wgid % NXCD, off = wgid / NXCD; wgid = (xcd < r ? xcd * (q + 1) : r * (q + 1) + (xcd - r) * q) + off; }
    const int nig = WGM * nN, gid = wgid / nig, fm = gid * WGM, gsz = (nM - fm) < WGM ? (nM - fm) : WGM;
    u.pm = uni(fm + ((wgid % nig) % gsz)); u.pn = uni((wgid % nig) / gsz); return true;
  }
};
__device__ __forceinline__ size_t job_aoff(const Job& g, const Unit& u) { return (size_t)(u.pm / g.adiv) * g.a1 + (size_t)(u.pm % g.adiv) * g.a0 + (size_t)u.pn * g.a2; }
__device__ __forceinline__ size_t job_boff(const Job& g, const Unit& u) { return (size_t)(u.pm / g.bdiv) * g.b1 + (size_t)(u.pm % g.bdiv) * g.b0 + (size_t)u.pn * g.b2; }

enum { EPI_SCALE = 0, EPI_SWAP = 1, EPI_RES = 2, EPI_SOFTMAX = 3, EPI_FFN = 4, EPI_DFT = 5, EPI_GCONV = 6 };
template <int CTRL> __device__ __forceinline__ float dppf(float old, float src) { return __builtin_bit_cast(float, __builtin_amdgcn_update_dpp(__builtin_bit_cast(int, old), __builtin_bit_cast(int, src), CTRL, 0xF, 0xF, false)); }

template <int EPI>
__device__ __forceinline__ void epilogue(f32x4 (&acc)[2][2][4][2], const Job& g, const Unit& u, int wr, int wc, int fr, int fq, LAS unsigned char* xch) {
  const int rl = wr * 64 + fr, cl = wc * 32 + 8 * fq;
  if constexpr (EPI == EPI_SCALE) {
    const size_t orow0 = (size_t)(u.pm / g.odiv) * g.r1 + (size_t)(u.pm % g.odiv) * g.r0 + (size_t)u.pn * g.r2;
    const int ocol0 = (u.pm / g.odiv) * g.c1 + (u.pm % g.odiv) * g.c0 + u.pn * g.c2;
    bf16_t* obase = uni(g.O + orow0 * g.ldc + ocol0);
    const float* sbase = uni(g.ssp + (size_t)u.pm * BM * 4);
    float scr8[8];
#pragma unroll
    for (int q = 0; q < 8; ++q) { scr8[q] = g.cscale; if (g.ssp) scr8[q] *= rstd_of(sbase, (size_t)(unsigned)((q >> 2) * HALF + rl + (q & 3) * 16)); }
#pragma unroll
    for (int ai = 0; ai < 2; ++ai)
#pragma unroll
      for (int m = 0; m < 4; ++m) {
        const int lr = ai * HALF + rl + m * 16;
        const float sc = scr8[ai * 4 + m];
        bf16_t* rowp = (bf16_t*)((char*)obase + (unsigned)(lr * g.ldc + cl) * 2u);
#pragma unroll
        for (int bj = 0; bj < 2; ++bj) {
          const f32x4 v0 = acc[ai][bj][m][0] * sc, v1 = acc[ai][bj][m][1] * sc;
          u32x4 w; w.x = cvt_pk_bf16(v0[0], v0[1]); w.y = cvt_pk_bf16(v0[2], v0[3]); w.z = cvt_pk_bf16(v1[0], v1[1]); w.w = cvt_pk_bf16(v1[2], v1[3]);
          __builtin_nontemporal_store(w, (u32x4*)(rowp + bj * HALF));
        }
      }
  } else if constexpr (EPI == EPI_SWAP) {
    float rs[2][8];
    const size_t tokt = (size_t)u.pn * BM;
    const float* sbase = uni(g.ssp + tokt * 4);
#pragma unroll
    for (int bj = 0; bj < 2; ++bj)
#pragma unroll
      for (int j = 0; j < 8; ++j) rs[bj][j] = rstd_of(sbase, (size_t)(unsigned)(cl + bj * HALF + j));
    const size_t bq = tokt >> 12, sq = tokt & 4095;
    bf16_t* dtb = uni(g.O + bq * 512 * 8192 + sq);
    bf16_t* vtb = uni(g.O2 + (size_t)((u.pm >= 2 ? u.pm - 2 : 0) * BM) * NTOK + tokt);
#pragma unroll
    for (int ai = 0; ai < 2; ++ai)
#pragma unroll
      for (int m = 0; m < 4; ++m) {
        const int lr = ai * HALF + rl + m * 16;
        int r1, r2, half;
        if (u.pm == 0) { const int gg = lr >> 6, cp = lr & 63; r1 = gg * 64 + cp; r2 = cp ? 256 + gg * 64 + 64 - cp : -1; half = 0; }
        else if (lr < 4) { r1 = 256 + lr * 64; r2 = -1; half = 0; }
        else { const int mm = lr - 4, gg = mm / 63, cp = 1 + mm % 63; r1 = gg * 64 + cp; r2 = 256 + gg * 64 + 64 - cp; half = 1; }
        bf16_t* p1 = (u.pm < 2) ? (bf16_t*)((char*)dtb + ((unsigned)(r1 * 8192 + half * 4096) + (unsigned)cl) * 2u) : (bf16_t*)((char*)vtb + ((unsigned)lr * (unsigned)NTOK + (unsigned)cl) * 2u);
        bf16_t* p2 = (bf16_t*)((char*)dtb + ((unsigned)((r2 < 0 ? 0 : r2) * 8192 + half * 4096) + (unsigned)cl) * 2u);
#pragma unroll
        for (int bj = 0; bj < 2; ++bj) {
          const f32x4 v0 = acc[ai][bj][m][0], v1 = acc[ai][bj][m][1];
          u32x4 w; w.x = cvt_pk_bf16(v0[0] * rs[bj][0], v0[1] * rs[bj][1]); w.y = cvt_pk_bf16(v0[2] * rs[bj][2], v0[3] * rs[bj][3]);
          w.z = cvt_pk_bf16(v1[0] * rs[bj][4], v1[1] * rs[bj][5]); w.w = cvt_pk_bf16(v1[2] * rs[bj][6], v1[3] * rs[bj][7]);
          __builtin_nontemporal_store(w, (u32x4*)(p1 + bj * HALF));
          if (u.pm < 2 && r2 >= 0) __builtin_nontemporal_store(w, (u32x4*)(p2 + bj * HALF));
          if (u.pm == 1 && lr < 4) {
            const u32x4 z = (u32x4){0u, 0u, 0u, 0u};
            __builtin_nontemporal_store(z, (u32x4*)((char*)dtb + ((unsigned)((256 + lr * 64) * 8192 + 4096) + (unsigned)(cl + bj * HALF)) * 2u));
            __builtin_nontemporal_store(z, (u32x4*)((char*)dtb + ((unsigned)((lr * 64) * 8192 + 4096) + (unsigned)(cl + bj * HALF)) * 2u));
          }
        }
      }
  } else if constexpr (EPI == EPI_RES) {
    LAS float* part = (LAS float*)xch;
    const size_t toff = (size_t)u.pm * BM * DM + (size_t)u.pn * BM;
    bf16_t* rO = uni(g.O + toff);
    u32x4 hbv[8][2];
#pragma unroll
    for (int q = 0; q < 8; ++q)
#pragma unroll
      for (int bj = 0; bj < 2; ++bj) hbv[q][bj] = *(const u32x4*)((const char*)rO + ((unsigned)(((q >> 2) * HALF + rl + (q & 3) * 16) * DM + cl) + bj * HALF) * 2u);
#pragma unroll
    for (int ai = 0; ai < 2; ++ai)
#pragma unroll
      for (int m = 0; m < 4; ++m) {
        const int lr = ai * HALF + rl + m * 16;
        const unsigned off = (unsigned)(lr * DM + cl);
        float ss = 0.f;
#pragma unroll
        for (int bj = 0; bj < 2; ++bj) {
          const u32x4 hb = hbv[ai * 4 + m][bj];
          f32x4 v0 = acc[ai][bj][m][0], v1 = acc[ai][bj][m][1];
          v0[0] += bf_lo(hb.x); v0[1] += bf_hi(hb.x); v0[2] += bf_lo(hb.y); v0[3] += bf_hi(hb.y);
          v1[0] += bf_lo(hb.z); v1[1] += bf_hi(hb.z); v1[2] += bf_lo(hb.w); v1[3] += bf_hi(hb.w);
          ss += (v0[0] * v0[0] + v0[1] * v0[1]) + (v0[2] * v0[2] + v0[3] * v0[3]) + (v1[0] * v1[0] + v1[1] * v1[1]) + (v1[2] * v1[2] + v1[3] * v1[3]);
          u32x4 w; w.x = cvt_pk_bf16(v0[0], v0[1]); w.y = cvt_pk_bf16(v0[2], v0[3]); w.z = cvt_pk_bf16(v1[0], v1[1]); w.w = cvt_pk_bf16(v1[2], v1[3]);
          *(u32x4*)((char*)rO + (off + bj * HALF) * 2u) = w;
        }
        ss += __shfl_xor(ss, 16); ss += __shfl_xor(ss, 32);
        if (fq == 0) part[lr * 4 + wc] = ss;
      }
    asm volatile("s_waitcnt lgkmcnt(0)" ::: "memory"); __builtin_amdgcn_s_barrier(); asm volatile("" ::: "memory");
    const int tix = (wr * 4 + wc) * 64 + fq * 16 + fr;
    if (tix < 256) {
      const f32x4 p = *(const LAS f32x4*)(part + tix * 4);
      float* sw = uni(g.sspw + (size_t)u.pm * BM * 4 + u.pn);
      *(float*)((char*)sw + (unsigned)tix * 16u) = (p.x + p.y) + (p.z + p.w);
    }
  } else if constexpr (EPI == EPI_DFT) {
    const int b = u.pm >> 3, st = u.pm & 7;
    bf16_t* obase = uni(g.O + ((size_t)b * SEQ + st * 256) * DM);
    bf16_t* mbase = uni(g.O + ((size_t)b * SEQ + SEQ - st * 256) * DM);
    const float sc = g.cscale;
#pragma unroll
    for (int ai = 0; ai < 2; ++ai)
#pragma unroll
      for (int m = 0; m < 4; ++m) {
        const int lr = ai * HALF + rl + m * 16;
        bf16_t* rowp = (bf16_t*)((char*)obase + (unsigned)(lr * DM) * 2u);
        bf16_t* mrow = mbase - (size_t)lr * DM;
        const bool mir = (st * 256 + lr) != 0;
#pragma unroll
        for (int bj = 0; bj < 2; ++bj) {
          const f32x4 v0 = acc[ai][bj][m][0] * sc, v1 = acc[ai][bj][m][1] * sc;
          u32x4 w; w.x = cvt_pk_bf16(v0[0], v0[1]); w.y = cvt_pk_bf16(v0[2], v0[3]); w.z = cvt_pk_bf16(v1[0], v1[1]); w.w = cvt_pk_bf16(v1[2], v1[3]);
          const int lc = bj * HALF + cl; const int c = 128 * (lc >> 6) + 64 * u.pn + (lc & 63);
          __builtin_nontemporal_store(w, (u32x4*)(rowp + c));
          if (mir) {
            const int gb = c & ~127, cp = c & 127;
            const unsigned ww[4] = {w.x, w.y, w.z, w.w};
#pragma unroll
            for (int j = 0; j < 8; ++j) mrow[gb + ((128 - (cp + j)) & 127)] = (bf16_t)((j & 1) ? (ww[j >> 1] >> 16) : (ww[j >> 1] & 0xffffu));
          }
        }
      }
  } else if constexpr (EPI == EPI_FFN || EPI == EPI_GCONV) {
    constexpr bool GC = (EPI == EPI_GCONV);
    constexpr int CSTR = GC ? DM : DFF;
    constexpr bool CH = !GC;
    LAS float* X = (LAS float*)xch;
    const int b = CH ? (u.pm >> 4) : u.pm / 17, ti = CH ? (u.pm & 15) : u.pm % 17, s0 = CH ? 256 * ti : 254 * ti - 1;
    LAS float* CYW = X + 1024 + (ti & 1) * 384;
    const LAS float* CYR = X + 1024 + ((ti + 1) & 1) * 384;
    const long row0 = (long)b * SEQ + s0;
    const float* sbase = uni(g.ssp + row0 * 4);
    const int ch0 = u.pn * 128 + cl;
#pragma unroll
    for (int ai = 0; ai < 2; ++ai)
#pragma unroll
      for (int m = 0; m < 4; ++m) {
        const int lr = ai * HALF + rl + m * 16;
        const float sc = rstd_of(sbase, (size_t)(unsigned)lr);
        const bool inb = CH ? true : ((unsigned)(s0 + lr) < (unsigned)SEQ);
#pragma unroll
        for (int n = 0; n < 2; ++n) {
          if constexpr (GC) { const f32x4 gv = (acc[ai][0][m][n] * sc) * (acc[ai][1][m][n] * sc); acc[ai][1][m][n] = inb ? gv : (f32x4){0.f, 0.f, 0.f, 0.f}; }
          else { acc[ai][0][m][n] = acc[ai][0][m][n] * sc; const f32x4 gv = acc[ai][1][m][n] * sc; acc[ai][1][m][n] = inb ? gv : (f32x4){0.f, 0.f, 0.f, 0.f}; } }
      }
#pragma unroll
    for (int ai = 0; ai < 2; ++ai) {
      const int seg = 2 * ai + wr;
      if (fr == 0) { *(LAS f32x4*)(X + (seg * 2 + 0) * 128 + cl) = acc[ai][1][0][0]; *(LAS f32x4*)(X + (seg * 2 + 0) * 128 + cl + 4) = acc[ai][1][0][1]; }
      if (fr == 15) { *(LAS f32x4*)(X + (seg * 2 + 1) * 128 + cl) = acc[ai][1][3][0]; *(LAS f32x4*)(X + (seg * 2 + 1) * 128 + cl + 4) = acc[ai][1][3][1]; }
    }
    if constexpr (CH) {
      if (wr == 1 && fr == 14) { *(LAS f32x4*)(CYW + cl) = acc[1][1][3][0]; *(LAS f32x4*)(CYW + cl + 4) = acc[1][1][3][1]; }
      if (wr == 1 && fr == 15) { *(LAS f32x4*)(CYW + 128 + cl) = acc[1][1][3][0]; *(LAS f32x4*)(CYW + 128 + cl + 4) = acc[1][1][3][1];
                                 *(LAS f32x4*)(CYW + 256 + cl) = acc[1][0][3][0]; *(LAS f32x4*)(CYW + 256 + cl + 4) = acc[1][0][3][1]; }
    }
    asm volatile("s_waitcnt lgkmcnt(0)" ::: "memory"); __builtin_amdgcn_s_barrier(); asm volatile("" ::: "memory");
    bf16_t* obase = uni(g.O + row0 * CSTR + u.pn * 128);
    const bf16_t* gbase = GC ? uni(g.GB + row0 * DM + u.pn * 128) : nullptr;
    float w0[8], w1[8], w2[8], bb[8];
    { const f32x4 a0 = *(const f32x4*)(g.cw + ch0), a1 = *(const f32x4*)(g.cw + ch0 + 4), b0 = *(const f32x4*)(g.cw + CSTR + ch0), b1 = *(const f32x4*)(g.cw + CSTR + ch0 + 4);
      const f32x4 c0 = *(const f32x4*)(g.cw + 2 * CSTR + ch0), c1 = *(const f32x4*)(g.cw + 2 * CSTR + ch0 + 4);
      f32x4 d0 = (f32x4){0.f, 0.f, 0.f, 0.f}, d1 = d0; if constexpr (!GC) { d0 = *(const f32x4*)(g.cb + ch0); d1 = *(const f32x4*)(g.cb + ch0 + 4); }
#pragma unroll
      for (int j = 0; j < 4; ++j) { w0[j] = a0[j]; w0[4 + j] = a1[j]; w1[j] = b0[j]; w1[4 + j] = b1[j]; w2[j] = c0[j]; w2[4 + j] = c1[j]; bb[j] = d0[j]; bb[4 + j] = d1[j]; } }
#pragma unroll
    for (int ai = 0; ai < 2; ++ai) {
      const int seg = 2 * ai + wr;
      f32x4 pl[2], nl[2];
      const int sp = seg > 0 ? seg - 1 : 0, sn = seg < 3 ? seg + 1 : 3;
      pl[0] = *(const LAS f32x4*)(X + (sp * 2 + 1) * 128 + cl); pl[1] = *(const LAS f32x4*)(X + (sp * 2 + 1) * 128 + cl + 4);
      nl[0] = *(const LAS f32x4*)(X + (sn * 2 + 0) * 128 + cl); nl[1] = *(const LAS f32x4*)(X + (sn * 2 + 0) * 128 + cl + 4);
      if constexpr (CH) {
        if (seg == 0) { if (ti > 0) { pl[0] = *(const LAS f32x4*)(CYR + 128 + cl); pl[1] = *(const LAS f32x4*)(CYR + 128 + cl + 4); } else { pl[0] = (f32x4){0.f, 0.f, 0.f, 0.f}; pl[1] = pl[0]; } }
        if (seg == 3) { nl[0] = (f32x4){0.f, 0.f, 0.f, 0.f}; nl[1] = nl[0]; }
      }
#pragma unroll
      for (int m = 0; m < 4; ++m) {
        const int lr = ai * HALF + rl + m * 16;
        float a[8];
#pragma unroll
        for (int n = 0; n < 2; ++n)
#pragma unroll
          for (int v = 0; v < 4; ++v) {
            const float cur = acc[ai][1][m][n][v];
            float oldp, oldn;
            if (m > 0) { const float t = acc[ai][1][m > 0 ? m - 1 : 0][n][v]; oldp = dppf<0x121>(t, t); } else oldp = pl[n][v];
            if (m < 3) { const float t = acc[ai][1][m < 3 ? m + 1 : 3][n][v]; oldn = dppf<0x12F>(t, t); } else oldn = nl[n][v];
            const float prev = dppf<0x111>(oldp, cur), next = dppf<0x101>(oldn, cur);
            a[4 * n + v] = w0[4 * n + v] * prev + w1[4 * n + v] * cur + w2[4 * n + v] * next + bb[4 * n + v];
          }
        if constexpr (!GC) {
#pragma unroll
          for (int j = 0; j < 8; j += 2) { const f32x2 ge = gelu_pk((f32x2){a[j], a[j + 1]}); a[j] = ge.x * acc[ai][0][m][j >> 2][j & 3]; a[j + 1] = ge.y * acc[ai][0][m][(j + 1) >> 2][(j + 1) & 3]; }
        }
        if (CH ? (lr != 255 || ti == 15) : (lr >= 1 && lr <= 254 && s0 + lr < SEQ)) {
          if constexpr (GC) { float gb[8]; unpack8(*(const u32x4*)((const char*)gbase + ((unsigned)lr * DM + (unsigned)cl) * 2u), gb);
#pragma unroll
            for (int j = 0; j < 8; ++j) a[j] *= gb[j]; }
          u32x4 w; w.x = cvt_pk_bf16(a[0], a[1]); w.y = cvt_pk_bf16(a[2], a[3]); w.z = cvt_pk_bf16(a[4], a[5]); w.w = cvt_pk_bf16(a[6], a[7]);
          __builtin_nontemporal_store(w, (u32x4*)((char*)obase + ((unsigned)lr * CSTR + (unsigned)cl) * 2u));
        }
      }
    }
    if constexpr (CH) {
      const int tix = (wr * 4 + wc) * 64 + fq * 16 + fr;
      if (ti > 0 && tix < 16) {
        const int ch = tix * 8, gch = u.pn * 128 + ch;
        const f32x4 ga0 = *(const LAS f32x4*)(CYR + ch), ga1 = *(const LAS f32x4*)(CYR + ch + 4), gb0 = *(const LAS f32x4*)(CYR + 128 + ch), gb1 = *(const LAS f32x4*)(CYR + 128 + ch + 4);
        const f32x4 uu0 = *(const LAS f32x4*)(CYR + 256 + ch), uu1 = *(const LAS f32x4*)(CYR + 256 + ch + 4), gn0 = *(const LAS f32x4*)(X + ch), gn1 = *(const LAS f32x4*)(X + ch + 4);
        const f32x4 p0 = *(const f32x4*)(g.cw + gch), p1 = *(const f32x4*)(g.cw + gch + 4), q0 = *(const f32x4*)(g.cw + CSTR + gch), q1 = *(const f32x4*)(g.cw + CSTR + gch + 4);
        const f32x4 r0 = *(const f32x4*)(g.cw + 2 * CSTR + gch), r1 = *(const f32x4*)(g.cw + 2 * CSTR + gch + 4), e0 = *(const f32x4*)(g.cb + gch), e1 = *(const f32x4*)(g.cb + gch + 4);
        const f32x4 x0 = p0 * ga0 + q0 * gb0 + r0 * gn0 + e0, x1 = p1 * ga1 + q1 * gb1 + r1 * gn1 + e1;
        const f32x2 y0 = gelu_pk((f32x2){x0[0], x0[1]}), y1 = gelu_pk((f32x2){x0[2], x0[3]}), y2 = gelu_pk((f32x2){x1[0], x1[1]}), y3 = gelu_pk((f32x2){x1[2], x1[3]});
        u32x4 w; w.x = cvt_pk_bf16(y0.x * uu0[0], y0.y * uu0[1]); w.y = cvt_pk_bf16(y1.x * uu0[2], y1.y * uu0[3]); w.z = cvt_pk_bf16(y2.x * uu1[0], y2.y * uu1[1]); w.w = cvt_pk_bf16(y3.x * uu1[2], y3.y * uu1[3]);
        __builtin_nontemporal_store(w, (u32x4*)(g.O + (row0 - 1) * CSTR + gch));
      }
    }
  } else {
    LAS float* mx = (LAS float*)xch;
    LAS float* sm = (LAS float*)(xch + 4096);
    const float* sbase = uni(g.ssp + (size_t)u.pm * BM * 4);
    bf16_t* obase = uni(g.O + (size_t)u.pm * BM * g.ldc + (size_t)u.pn * BM);
#pragma unroll
    for (int ai = 0; ai < 2; ++ai)
#pragma unroll
      for (int m = 0; m < 4; ++m) {
        const int lr = ai * HALF + rl + m * 16;
        const float sc = rstd_of(sbase, (size_t)(unsigned)lr);
        float mv = -3.0e38f;
#pragma unroll
        for (int bj = 0; bj < 2; ++bj)
#pragma unroll
          for (int n = 0; n < 2; ++n) { f32x4 v = acc[ai][bj][m][n] * sc; acc[ai][bj][m][n] = v; mv = fmaxf(mv, fmaxf(fmaxf(v[0], v[1]), fmaxf(v[2], v[3]))); }
        mv = fmaxf(mv, __shfl_xor(mv, 16)); mv = fmaxf(mv, __shfl_xor(mv, 32));
        if (fq == 0) mx[lr * 4 + wc] = mv;
      }
    asm volatile("s_waitcnt lgkmcnt(0)" ::: "memory"); __builtin_amdgcn_s_barrier(); asm volatile("" ::: "memory");
#pragma unroll
    for (int ai = 0; ai < 2; ++ai)
#pragma unroll
      for (int m = 0; m < 4; ++m) {
        const int lr = ai * HALF + rl + m * 16;
        const f32x4 m4 = *(const LAS f32x4*)(mx + lr * 4);
        const float M = fmaxf(fmaxf(m4.x, m4.y), fmaxf(m4.z, m4.w));
        float s = 0.f;
#pragma unroll
        for (int bj = 0; bj < 2; ++bj)
#pragma unroll
          for (int n = 0; n < 2; ++n) { f32x4 v = acc[ai][bj][m][n];
            v[0] = __builtin_amdgcn_exp2f(v[0] - M); v[1] = __builtin_amdgcn_exp2f(v[1] - M); v[2] = __builtin_amdgcn_exp2f(v[2] - M); v[3] = __builtin_amdgcn_exp2f(v[3] - M);
            acc[ai][bj][m][n] = v; s += (v[0] + v[1]) + (v[2] + v[3]); }
        s += __shfl_xor(s, 16); s += __shfl_xor(s, 32);
        if (fq == 0) sm[lr * 4 + wc] = s;
      }
    asm volatile("s_waitcnt lgkmcnt(0)" ::: "memory"); __builtin_amdgcn_s_barrier(); asm volatile("" ::: "memory");
#pragma unroll
    for (int ai = 0; ai < 2; ++ai)
#pragma unroll
      for (int m = 0; m < 4; ++m) {
        const int lr = ai * HALF + rl + m * 16;
        const f32x4 s4 = *(const LAS f32x4*)(sm + lr * 4);
        const float inv = 1.0f / ((s4.x + s4.y) + (s4.z + s4.w));
        bf16_t* rowp = (bf16_t*)((char*)obase + (unsigned)(lr * g.ldc + cl) * 2u);
#pragma unroll
        for (int bj = 0; bj < 2; ++bj) {
          const f32x4 v0 = acc[ai][bj][m][0] * inv, v1 = acc[ai][bj][m][1] * inv;
          u32x4 w; w.x = cvt_pk_bf16(v0[0], v0[1]); w.y = cvt_pk_bf16(v0[2], v0[3]); w.z = cvt_pk_bf16(v1[0], v1[1]); w.w = cvt_pk_bf16(v1[2], v1[3]);
          __builtin_nontemporal_store(w, (u32x4*)(rowp + bj * HALF));
        }
      }
  }
}

template <int EPI>
__device__ __forceinline__ void gemm_phase(LAS unsigned char* lds, const Job& g, int G, int c) {
  int tid = threadIdx.x; asm volatile("" : "+v"(tid));
  const int wid = __builtin_amdgcn_readfirstlane(tid >> 6), lane = tid & 63, wr = wid >> 2, wc = wid & 3, fr = lane & 15, fq = lane >> 4;
  const int nt = g.K / BK;
  int c_ = c; asm volatile("" : "+s"(c_));
  StaticOrder S; S.init(g.nM, g.nN, G, c_, g.chain);
  unsigned voffA, voffB;
  { int R, C; stage_rc(tid * 16, R, C); const int Rb = (R & ~31) + perm32(R & 31); voffA = (unsigned)(R * g.lda + C) * 2u; voffB = (unsigned)(Rb * g.ldb + C) * 2u; }
  const size_t rsA = (size_t)64 * g.lda * 2, rsB = (size_t)64 * g.ldb * 2, hA = 2 * rsA, hB = 2 * rsB;
  const size_t kstep = (size_t)(BK * 2);
  const unsigned ldsw = (unsigned)wid * 1024u;
  const int aoff = lds_byte(wr * 64 + fr, fq * 8), boff = lds_byte(wc * 32 + fr, fq * 8);
#define PG8_SA(b, h) (((b) * 2 + (h)) * HTB)
#define PG8_SB(b, h) ((4 + (b) * 2 + (h)) * HTB)
#define PG8_STAGE(bufoff, gbase, voff, rs) do { _Pragma("unroll") for (int _i = 0; _i < 2; ++_i) \
        __builtin_amdgcn_global_load_lds((const unsigned*)((const char*)(gbase) + (size_t)_i * (rs) + (voff)), (LAS unsigned*)(lds + (bufoff) + ldsw + _i * 8192), 16, 0, 0); } while (0)
#define PG8_LDA(dst, b, h) do { _Pragma("unroll") for (int m = 0; m < 4; ++m) _Pragma("unroll") for (int k = 0; k < 2; ++k) dst[m][k] = *(const LAS bf16x8*)(lds + PG8_SA(b, h) + aoff + m * 2048 + k * 1024); } while (0)
#define PG8_LDB(dst, b, h) do { _Pragma("unroll") for (int n = 0; n < 2; ++n) _Pragma("unroll") for (int k = 0; k < 2; ++k) dst[n][k] = *(const LAS bf16x8*)(lds + PG8_SB(b, h) + boff + n * 2048 + k * 1024); } while (0)
#define PG8_MMA(ai, bj, At, Bt) do { __builtin_amdgcn_s_setprio(1); _Pragma("unroll") for (int m = 0; m < 4; ++m) _Pragma("unroll") for (int n = 0; n < 2; ++n) _Pragma("unroll") for (int k = 0; k < 2; ++k) \
        acc[ai][bj][m][n] = __builtin_amdgcn_mfma_f32_16x16x32_bf16(Bt[n][k], At[m][k], acc[ai][bj][m][n], 0, 0, 0); __builtin_amdgcn_s_setprio(0); } while (0)
#define PG8_WAIT_V(n) asm volatile("s_waitcnt vmcnt(" #n ")" ::: "memory")
#define PG8_WAIT_L(n) asm volatile("s_waitcnt lgkmcnt(" #n ")" ::: "memory")
#define PG8_BAR __builtin_amdgcn_s_barrier()
#define PG8_SCHED __builtin_amdgcn_sched_barrier(0)
  Unit cur, nxt; int ui = 0;
  if (!S.next(0, cur)) return;
  const char* gA = uni((const char*)g.A); const char* gB = uni((const char*)g.Bt);
  f32x4 acc[2][2][4][2];
#pragma unroll
  for (int a = 0; a < 2; ++a)
#pragma unroll
    for (int b = 0; b < 2; ++b)
#pragma unroll
      for (int m = 0; m < 4; ++m)
#pragma unroll
        for (int n = 0; n < 2; ++n) acc[a][b][m][n] = (f32x4){0.f, 0.f, 0.f, 0.f};
  bf16x8 At[4][2], B0[2][2], B1[2][2];
  const char* cA = uni(gA + job_aoff(g, cur) * 2); const char* cB = uni(gB + job_boff(g, cur) * 2);
  PG8_STAGE(PG8_SB(0, 0), cB, voffB, rsB); PG8_STAGE(PG8_SB(0, 1), cB + hB, voffB, rsB); PG8_STAGE(PG8_SA(0, 0), cA, voffA, rsA); PG8_STAGE(PG8_SA(0, 1), cA + hA, voffA, rsA);
  if (wr == 1) PG8_BAR;
  PG8_WAIT_V(2); PG8_BAR;
  PG8_STAGE(PG8_SB(1, 0), cB + kstep, voffB, rsB); PG8_STAGE(PG8_SA(1, 0), cA + kstep, voffA, rsA); PG8_STAGE(PG8_SB(1, 1), cB + hB + kstep, voffB, rsB);
  PG8_WAIT_V(6); PG8_BAR;
  for (;;) {
    const bool has_next = S.next(ui + 1, nxt);
    const char* nA = has_next ? uni(gA + job_aoff(g, nxt) * 2) : cA; const char* nB = has_next ? uni(gB + job_boff(g, nxt) * 2) : cB;
    for (int t = 0; t < nt; t += 2) {
      const bool last = (t == nt - 2);
      const char* a1 = cA + (size_t)(t + 1) * kstep;
      const char* a2 = last ? nA : cA + (size_t)(t + 2) * kstep; const char* b2 = last ? nB : cB + (size_t)(t + 2) * kstep;
      const char* a3 = a2 + kstep; const char* b3 = b2 + kstep;
      PG8_LDB(B0, 0, 0); PG8_LDB(B1, 0, 1); PG8_SCHED; PG8_LDA(At, 0, 0); PG8_STAGE(PG8_SA(1, 1), a1 + hA, voffA, rsA);
      PG8_WAIT_V(8); PG8_WAIT_L(0); PG8_BAR; PG8_MMA(0, 0, At, B0); PG8_MMA(0, 1, At, B1); PG8_BAR; PG8_SCHED;
      PG8_LDA(At, 0, 1); PG8_STAGE(PG8_SB(0, 0), b2, voffB, rsB); PG8_STAGE(PG8_SB(0, 1), b2 + hB, voffB, rsB); PG8_STAGE(PG8_SA(0, 0), a2, voffA, rsA);
      PG8_WAIT_V(8); PG8_WAIT_L(0); PG8_BAR; PG8_MMA(1, 0, At, B0); PG8_MMA(1, 1, At, B1); PG8_BAR; PG8_SCHED;
      PG8_LDB(B0, 1, 0); PG8_LDB(B1, 1, 1); PG8_SCHED; PG8_LDA(At, 1, 0); PG8_STAGE(PG8_SA(0, 1), a2 + hA, voffA, rsA);
      PG8_WAIT_V(8); PG8_WAIT_L(0); PG8_BAR; PG8_MMA(0, 0, At, B0); PG8_MMA(0, 1, At, B1); PG8_BAR; PG8_SCHED;
      PG8_LDA(At, 1, 1); PG8_STAGE(PG8_SB(1, 0), b3, voffB, rsB); PG8_STAGE(PG8_SB(1, 1), b3 + hB, voffB, rsB); PG8_STAGE(PG8_SA(1, 0), a3, voffA, rsA);
      PG8_WAIT_V(8); PG8_WAIT_L(0); PG8_BAR; PG8_MMA(1, 0, At, B0); PG8_MMA(1, 1, At, B1); PG8_BAR; PG8_SCHED;
    }
    if (wr == 0) PG8_BAR;
    { int e_fr = fr, e_fq = fq; asm volatile("" : "+v"(e_fr), "+v"(e_fq));
      epilogue<EPI>(acc, g, cur, wr, wc, e_fr, e_fq, lds + XCH_OFF); }
    if (!has_next) break;
#pragma unroll
    for (int a = 0; a < 2; ++a)
#pragma unroll
      for (int b = 0; b < 2; ++b)
#pragma unroll
        for (int m = 0; m < 4; ++m)
#pragma unroll
          for (int n = 0; n < 2; ++n) acc[a][b][m][n] = (f32x4){0.f, 0.f, 0.f, 0.f};
    cur = nxt; cA = nA; cB = nB; ++ui;
    if (wr == 1) PG8_BAR;
  }
  PG8_WAIT_V(0);
  PG8_BAR;
#undef PG8_SA
#undef PG8_SB
#undef PG8_STAGE
#undef PG8_LDA
#undef PG8_LDB
#undef PG8_MMA
#undef PG8_WAIT_V
#undef PG8_WAIT_L
#undef PG8_BAR
#undef PG8_SCHED
}

__device__ __forceinline__ void transpose_item(const float* W, int ldw, int col0, int K, int N, bf16_t* WT, const float* gain, float cs, LAS float* scr, int item, int lane, int permup) {
  const int nblk = N / 32, kb = item / nblk, nb = item % nblk, k0 = 64 * kb, n0 = 32 * nb;
#pragma unroll
  for (int i = 0; i < 8; ++i) { const int kk = 8 * i + (lane >> 3), nn = (lane & 7) * 4; const float gv = gain ? gain[k0 + kk] * cs : cs;
    const f32x4 v = *(const f32x4*)(W + (size_t)(k0 + kk) * ldw + col0 + n0 + nn);
    LAS float* d = scr + kk * 33 + nn; d[0] = v.x * gv; d[1] = v.y * gv; d[2] = v.z * gv; d[3] = v.w * gv; }
  asm volatile("s_waitcnt lgkmcnt(0)" ::: "memory");
  const int c = lane & 7;
#pragma unroll
  for (int j = 0; j < 4; ++j) { const int n = (lane >> 3) + 8 * j; const LAS float* s = scr + (8 * c) * 33 + n;
    u32x4 o; o.x = cvt_pk_bf16(s[0 * 33], s[1 * 33]); o.y = cvt_pk_bf16(s[2 * 33], s[3 * 33]); o.z = cvt_pk_bf16(s[4 * 33], s[5 * 33]); o.w = cvt_pk_bf16(s[6 * 33], s[7 * 33]);
    const int nn = n0 + n; const int nr = (permup == 1) ? (((nn & 2047) >> 7) * 256 + (nn >> 11) * 128 + (nn & 127)) : (permup == 2) ? (((nn & 1023) >> 7) * 256 + (nn >> 10) * 128 + (nn & 127)) : nn;
    *(u32x4*)(WT + (size_t)nr * K + k0 + 8 * c) = o; }
  asm volatile("s_waitcnt lgkmcnt(0)" ::: "memory");
}
struct TrDesc { const float* W; int ldw, col0, K, N; bf16_t* WT; const float* gain; float cs; int nitems; int permup; };
__device__ __forceinline__ TrDesc tr_desc(bf16_t* wb, int d) {
  TrDesc t; t.cs = 1.0f; t.gain = nullptr; t.col0 = 0; t.permup = 0;
  if (d < 8) {
    const int j = d >> 2, w = d & 3; bf16_t* e = wb + W_EVEN + (size_t)j * W_EVEN_SZ;
    if (w < 3) { t.W = kin(4) + (size_t)j * DM * 2048; t.ldw = 2048; t.col0 = 512 + 512 * w; t.K = DM; t.N = 512; t.gain = kin(3) + (size_t)(2 * j) * DM;
      t.WT = (w == 0) ? e + (size_t)1024 * DM : (w == 1) ? e + (size_t)1536 * DM : e + (size_t)512 * DM;
      if (w == 0) t.cs = 0.08838834764831845f * LOG2E; }
    else { t.W = kin(6) + (size_t)j * DM * DM; t.ldw = DM; t.K = DM; t.N = DM; t.WT = e + (size_t)2048 * DM; }
  } else if (d < 14) {
    const int j = (d - 8) / 3, w = (d - 8) % 3; bf16_t* o = wb + W_ODD + (size_t)j * W_ODD_SZ;
    if (w == 0) { t.W = kin(7) + (size_t)j * DM * 3072; t.ldw = 3072; t.K = DM; t.N = 1024; t.gain = kin(3) + (size_t)(2 * j + 1) * DM; t.WT = o; }
    else if (w == 2) { t.W = kin(7) + (size_t)j * DM * 3072; t.ldw = 3072; t.col0 = 1024; t.K = DM; t.N = 2048; t.gain = kin(3) + (size_t)(2 * j + 1) * DM; t.WT = o + (size_t)1024 * DM; t.permup = 2; }
    else { t.W = kin(9) + (size_t)j * DM * DM; t.ldw = DM; t.K = DM; t.N = DM; t.WT = o + (size_t)3072 * DM; }
  } else {
    const int l = (d - 14) >> 2, w = (d - 14) & 3; bf16_t* y = wb + W_LAY + (size_t)l * W_LAY_SZ;
    if (w == 0) { t.W = kin(12) + (size_t)l * DM * 2048; t.ldw = 2048; t.K = DM; t.N = 2048; t.WT = y + (size_t)1024 * DM; }
    else if (w == 1) { t.W = kin(13) + (size_t)l * DM * DM; t.ldw = DM; t.K = DM; t.N = DM; t.WT = y + (size_t)3072 * DM; }
    else if (w == 2) { t.W = kin(15) + (size_t)l * DM * 4096; t.ldw = 4096; t.K = DM; t.N = 4096; t.gain = kin(14) + (size_t)l * DM; t.WT = y + (size_t)4096 * DM; t.permup = 1; }
    else { t.W = kin(18) + (size_t)l * DFF * DM; t.ldw = DM; t.K = DFF; t.N = DM; t.WT = y + (size_t)8192 * DM; }
  }
  t.nitems = (t.K / 64) * (t.N / 32);
  return t;
}

__device__ __forceinline__ void prologue(LAS unsigned char* lds) {
  int tid_ = threadIdx.x; asm volatile("" : "+v"(tid_));
  const int lane = tid_ & 63, wave = __builtin_amdgcn_readfirstlane(tid_ >> 6), gwave = (int)blockIdx.x * 8 + wave, ngw = (int)gridDim.x * 8;
  unsigned char* ws = kws();
  bf16_t* wb = (bf16_t*)(ws + WS_W);
  LAS float* scr = (LAS float*)(lds + wave * 16384);
  for (int d = 0; d < 30; ++d) {
    const TrDesc t = tr_desc(wb, d);
    for (int it = (gwave + d * 293) % ngw; it < t.nitems; it += ngw) transpose_item(t.W, t.ldw, t.col0, t.K, t.N, t.WT, t.gain, t.cs, scr, it, lane, t.permup);
  }
  {
    const size_t n4 = (size_t)DEPTH * DM * DM / 4;
    for (size_t i = (size_t)gwave * 64 + lane; i < n4; i += (size_t)ngw * 64) {
      const size_t e = i * 4; const int l = (int)(e / ((size_t)DM * DM)); const size_t r = e % ((size_t)DM * DM); const int k = (int)(r / DM);
      const f32x4 v = *(const f32x4*)(kin(11) + e); const float gv = kin(10)[l * DM + k] * (0.0625f * LOG2E);
      u32x2 w; w.x = cvt_pk_bf16(v[0] * gv, v[1] * gv); w.y = cvt_pk_bf16(v[2] * gv, v[3] * gv);
      *(u32x2*)(wb + W_LAY + (size_t)l * W_LAY_SZ + r) = w;
    }
  }
  LAS float* T = (LAS float*)(lds + RING_BYTES - 16384);
  __syncthreads();
  LAS float* T128 = (LAS float*)(lds + XCH_OFF);
  for (int i = tid_; i < 4096; i += 512) T[i] = cospif((float)i * (1.0f / 2048.0f));
  if (tid_ < 128) T128[tid_] = cospif((float)tid_ * (1.0f / 64.0f));
  __syncthreads();
  {
    bf16_t* F = (bf16_t*)(ws + WS_FCAT);
    const size_t nchunk = (size_t)4096 * 8192 / 8;
    for (size_t ci = (size_t)gwave * 64 + lane; ci < nchunk; ci += (size_t)ngw * 64) {
      const int s = (int)(ci >> 10), k0 = (int)(ci & 1023) * 8;
      float v[8];
#pragma unroll
      for (int j = 0; j < 8; ++j) { const int k = k0 + j; const int sr = s & 2047; const int idx = (k < 4096) ? ((sr * k) & 4095) : ((sr * (k - 4096) + ((s < 2048) ? 1024 : 3072)) & 4095); v[j] = T[idx]; }
      u32x4 w; w.x = cvt_pk_bf16(v[0], v[1]); w.y = cvt_pk_bf16(v[2], v[3]); w.z = cvt_pk_bf16(v[4], v[5]); w.w = cvt_pk_bf16(v[6], v[7]);
      *(u32x4*)(F + ci * 8) = w;
    }
  }
  for (int it = gwave; it < 2 * 1024 * 4; it += ngw) {
    const int j = it >> 12, k = (it >> 2) & 1023, gq = it & 3;
    const float* wrow = kin(4) + ((size_t)j * DM + k) * 2048 + gq * 128;
    const float gv = kin(3)[(2 * j) * DM + k];
    const float w0 = wrow[lane] * gv, w1 = wrow[64 + lane] * gv;
    float ac0 = 0.f, ac1 = 0.f, as0 = 0.f;
#pragma unroll 8
    for (int c = 0; c < 128; ++c) {
      const float wv = (c < 64) ? __shfl(w0, c) : __shfl(w1, c - 64);
      const int i0 = (c * lane) & 127, i1 = (c * (lane + 64)) & 127;
      ac0 += wv * T128[i0]; as0 += wv * T128[(i0 + 96) & 127];
      ac1 += wv * T128[i1];
    }
    bf16_t* e = wb + W_EVEN + (size_t)j * W_EVEN_SZ;
    e[(size_t)(gq * 64 + lane) * DM + k] = (bf16_t)(cvt_pk_bf16(ac0, 0.f) & 0xffff);
    if (lane == 0) e[(size_t)(256 + gq) * DM + k] = (bf16_t)(cvt_pk_bf16(ac1, 0.f) & 0xffff);
    else e[(size_t)(260 + gq * 63 + lane - 1) * DM + k] = (bf16_t)(cvt_pk_bf16(as0, 0.f) & 0xffff);
  }
  for (int r = gwave; r < NB * NMEM; r += ngw) {
    const f32x4* xr = (const f32x4*)(kin(1) + (size_t)r * DM) + lane; f32x4 v[4]; float s = 0.f;
#pragma unroll
    for (int j = 0; j < 4; ++j) { v[j] = xr[64 * j]; s += (v[j].x * v[j].x + v[j].y * v[j].y) + (v[j].z * v[j].z + v[j].w * v[j].w); }
    const float rs = rsqrtf(wave_sum(s) * (1.0f / DM) + EPS);
    u32x2* o = (u32x2*)((bf16_t*)(ws + WS_MB) + (size_t)r * DM) + lane;
#pragma unroll
    for (int j = 0; j < 4; ++j) { const f32x4 gg = *((const f32x4*)kin(2) + lane + 64 * j);
      u32x2 w; w.x = cvt_pk_bf16(v[j].x * rs * gg.x, v[j].y * rs * gg.y); w.y = cvt_pk_bf16(v[j].z * rs * gg.z, v[j].w * rs * gg.w); o[64 * j] = w; }
  }
  {
    const float* xin = kin(0); bf16_t* hbp = (bf16_t*)(ws + WS_HB); float* sspp = (float*)(ws + WS_SSP);
    for (int r = gwave; r < NTOK; r += 4 * ngw) {
      f32x4 v[4][4];
#pragma unroll
      for (int q = 0; q < 4; ++q) { const int rq = min(r + q * ngw, NTOK - 1); const f32x4* xr = (const f32x4*)(xin + (size_t)rq * DM) + lane;
#pragma unroll
        for (int j = 0; j < 4; ++j) v[q][j] = xr[64 * j]; }
#pragma unroll
      for (int q = 0; q < 4; ++q) { float sq = 0.f;
#pragma unroll
        for (int j = 0; j < 4; ++j) sq += (v[q][j].x * v[q][j].x + v[q][j].y * v[q][j].y) + (v[q][j].z * v[q][j].z + v[q][j].w * v[q][j].w);
        sq = wave_sum(sq);
        if (r + q * ngw >= NTOK) continue;
        u32x2* o = (u32x2*)(hbp + (size_t)(r + q * ngw) * DM) + lane;
#pragma unroll
        for (int j = 0; j < 4; ++j) { u32x2 w; w.x = cvt_pk_bf16(v[q][j].x, v[q][j].y); w.y = cvt_pk_bf16(v[q][j].z, v[q][j].w); o[64 * j] = w; }
        if (lane == 0) *(f32x4*)(sspp + (size_t)(r + q * ngw) * 4) = (f32x4){sq, 0.f, 0.f, 0.f}; }
    }
  }
}

__device__ __forceinline__ void natten_phase(const bf16_t* QK, const bf16_t* VT, bf16_t* Y, const float* rpb, LAS float* rpbs) {
  int tid_ = threadIdx.x; asm volatile("" : "+v"(tid_));
  const int lane = tid_ & 63, wave = __builtin_amdgcn_readfirstlane(tid_ >> 6);
  for (int i = tid_; i < 4 * 15 * 31; i += 512) rpbs[i] = rpb[i] * LOG2E;
  __syncthreads();
  const int n = lane & 15, g = lane >> 4;
  const int keyl = 8 * (n >> 2) + (n & 3);
  for (int slot = (int)blockIdx.x; slot < 256; slot += (int)gridDim.x)
  for (int it = 0; it < 4; ++it) {
    const int u = (slot * 4 + it) * 8 + wave;
    const int jb = u & 3, ip = (u >> 2) & 31, h = (u >> 7) & 3, b = u >> 9;
    const int i0 = 2 * ip;
    const int rs0 = min(max(i0 - 4, 0), 56), d1 = min(max(i0 - 3, 0), 56) - rs0;
    const int c0 = (jb == 0) ? 0 : (jb == 1) ? 8 : (jb == 2) ? 24 : 32;
    const int j = jb * 16 + n; const int cs = min(max(j - 8, 0), 48);
    const size_t tq = (size_t)b * SEQ + i0 * 64 + j;
    bf16x8 qf[2][4];
#pragma unroll
    for (int q = 0; q < 2; ++q)
#pragma unroll
      for (int ks = 0; ks < 4; ++ks) qf[q][ks] = *(const bf16x8*)(QK + (tq + q * 64) * 1024 + h * 128 + ks * 32 + 8 * g);
    f32x4 sc[2][9][2];
#pragma unroll
    for (int ur = 0; ur < 9; ++ur) {
      const int krow = min(rs0 + ur, 63);
      const size_t tk0 = (size_t)b * SEQ + (size_t)krow * 64 + c0;
#pragma unroll
      for (int t = 0; t < 2; ++t) {
        const bf16_t* kp = QK + (tk0 + keyl + 4 * t) * 1024 + 512 + h * 128 + 8 * g;
        f32x4 a0 = (f32x4){0.f, 0.f, 0.f, 0.f}, a1 = a0;
#pragma unroll
        for (int ks = 0; ks < 4; ++ks) { const bf16x8 kf = *(const bf16x8*)(kp + ks * 32);
          a0 = __builtin_amdgcn_mfma_f32_16x16x32_bf16(kf, qf[0][ks], a0, 0, 0, 0); a1 = __builtin_amdgcn_mfma_f32_16x16x32_bf16(kf, qf[1][ks], a1, 0, 0, 0); }
        sc[0][ur][t] = a0; sc[1][ur][t] = a1;
      }
    }
    float inv[2];
#pragma unroll
    for (int q = 0; q < 2; ++q) {
      const int dq = q ? d1 : 0, iq = i0 + q;
      float mx = -3.0e38f;
#pragma unroll
      for (int ur = 0; ur < 9; ++ur) {
        const bool rowv = (unsigned)(ur - dq) < 8u;
        const LAS float* brow = rpbs + h * 465 + min(max(rs0 + ur - iq + 7, 0), 14) * 31;
#pragma unroll
        for (int t = 0; t < 2; ++t)
#pragma unroll
          for (int v = 0; v < 4; ++v) {
            const int kc = c0 + 8 * g + 4 * t + v;
            const bool valid = rowv && (kc >= cs) && (kc < cs + 16);
            const int co = min(max(kc - j + 15, 0), 30);
            const float s = valid ? sc[q][ur][t][v] + brow[co] : -3.0e38f;
            sc[q][ur][t][v] = s; mx = fmaxf(mx, s);
          }
      }
      mx = fmaxf(mx, __shfl_xor(mx, 16)); mx = fmaxf(mx, __shfl_xor(mx, 32));
      float sum = 0.f;
#pragma unroll
      for (int ur = 0; ur < 9; ++ur)
#pragma unroll
        for (int t = 0; t < 2; ++t)
#pragma unroll
          for (int v = 0; v < 4; ++v) { const float e = __builtin_amdgcn_exp2f(sc[q][ur][t][v] - mx); sc[q][ur][t][v] = e; sum += e; }
      sum += __shfl_xor(sum, 16); sum += __shfl_xor(sum, 32);
      inv[q] = 1.0f / sum;
    }
    f32x4 o[2][8];
#pragma unroll
    for (int q = 0; q < 2; ++q)
#pragma unroll
      for (int dt = 0; dt < 8; ++dt) o[q][dt] = (f32x4){0.f, 0.f, 0.f, 0.f};
#pragma unroll
    for (int ur = 0; ur < 9; ++ur) {
      bf16x8 pf[2];
#pragma unroll
      for (int q = 0; q < 2; ++q) { u32x4 pw; pw.x = cvt_pk_bf16(sc[q][ur][0][0], sc[q][ur][0][1]); pw.y = cvt_pk_bf16(sc[q][ur][0][2], sc[q][ur][0][3]); pw.z = cvt_pk_bf16(sc[q][ur][1][0], sc[q][ur][1][1]); pw.w = cvt_pk_bf16(sc[q][ur][1][2], sc[q][ur][1][3]);
        pf[q] = __builtin_bit_cast(bf16x8, pw); }
      const int krow = min(rs0 + ur, 63);
      const bf16_t* vp = VT + (size_t)(h * 128 + n) * NTOK + (size_t)b * SEQ + (size_t)krow * 64 + c0 + 8 * g;
#pragma unroll
      for (int dt = 0; dt < 8; ++dt) { const bf16x8 vf = *(const bf16x8*)(vp + (size_t)dt * 16 * NTOK);
        o[0][dt] = __builtin_amdgcn_mfma_f32_16x16x32_bf16(vf, pf[0], o[0][dt], 0, 0, 0); o[1][dt] = __builtin_amdgcn_mfma_f32_16x16x32_bf16(vf, pf[1], o[1][dt], 0, 0, 0); }
    }
#pragma unroll
    for (int q = 0; q < 2; ++q) {
      bf16_t* yp = Y + (tq + q * 64) * 1024 + 512 + h * 128 + 4 * g;
#pragma unroll
      for (int dt = 0; dt < 8; ++dt) { u32x2 w; w.x = cvt_pk_bf16(o[q][dt][0] * inv[q], o[q][dt][1] * inv[q]); w.y = cvt_pk_bf16(o[q][dt][2] * inv[q], o[q][dt][3] * inv[q]); *(u32x2*)(yp + dt * 16) = w; }
    }
  }
}

__device__ __forceinline__ void dft_mid_row(const bf16_t* DT, bf16_t* Y, float scale) {
  int tid_ = threadIdx.x; asm volatile("" : "+v"(tid_));
  const int lane = tid_ & 63, gwave = (int)blockIdx.x * 8 + (tid_ >> 6), ngw = (int)gridDim.x * 8;
  for (int it = gwave; it < NB * 512; it += ngw) {
    const bf16_t* row = DT + (size_t)it * 8192;
    float s = 0.f;
#pragma unroll
    for (int i = 0; i < 8; ++i) { float f[8]; unpack8(*(const u32x4*)(row + (i * 64 + lane) * 8), f); s += (f[0] - f[1]) + (f[2] - f[3]) + (f[4] - f[5]) + (f[6] - f[7]); }
    s = wave_sum(s);
    if (lane == 0) { const int b = it >> 9, r = it & 511, c = 128 * ((r >> 6) & 3) + 64 * (r >> 8) + (r & 63); Y[((size_t)b * SEQ + 2048) * DM + c] = (bf16_t)(cvt_pk_bf16(s * scale, 0.f) & 0xffffu); }
  }
}
__device__ __forceinline__ void ffn_conv_phase(bf16_t* Z, const float* cw, const float* cb) {
  constexpr int R = 32;
  int tid_ = threadIdx.x; asm volatile("" : "+v"(tid_));
  const int gthread = (int)blockIdx.x * 512 + tid_, nthreads = (int)gridDim.x * 512;
  for (int item = gthread; item < (NTOK / R) * 256; item += nthreads) {
    const int cgp = item & 255, run = item >> 8, c = cgp * 8;
    float w0[8], w1[8], w2[8], bb[8];
#pragma unroll
    for (int j = 0; j < 8; ++j) { w0[j] = cw[c + j]; w1[j] = cw[DFF + c + j]; w2[j] = cw[2 * DFF + c + j]; bb[j] = cb[c + j]; }
    const size_t t0 = (size_t)run * R; const int s0 = (int)(t0 & (SEQ - 1));
    bf16_t* zp = Z + t0 * 4096 + c;
    float prev[8], cur[8], nxt[8];
    if (s0 == 0) {
#pragma unroll
      for (int j = 0; j < 8; ++j) prev[j] = 0.f;
    } else unpack8(*(const u32x4*)(zp - 4096 + DFF), prev);
    unpack8(*(const u32x4*)(zp + DFF), cur);
#pragma unroll 4
    for (int r = 0; r < R; ++r) {
      if (s0 + r + 1 < SEQ) unpack8(*(const u32x4*)(zp + (size_t)(r + 1) * 4096 + DFF), nxt);
      else {
#pragma unroll
        for (int j = 0; j < 8; ++j) nxt[j] = 0.f;
      }
      float uu[8]; unpack8(*(const u32x4*)(zp + (size_t)r * 4096), uu);
      float a[8];
#pragma unroll
      for (int j = 0; j < 8; j += 2) {
        f32x2 gv; gv.x = w0[j] * prev[j] + w1[j] * cur[j] + w2[j] * nxt[j] + bb[j]; gv.y = w0[j + 1] * prev[j + 1] + w1[j + 1] * cur[j + 1] + w2[j + 1] * nxt[j + 1] + bb[j + 1];
        const f32x2 ge = gelu_pk(gv); a[j] = ge.x * uu[j]; a[j + 1] = ge.y * uu[j + 1];
      }
      u32x4 w; w.x = cvt_pk_bf16(a[0], a[1]); w.y = cvt_pk_bf16(a[2], a[3]); w.z = cvt_pk_bf16(a[4], a[5]); w.w = cvt_pk_bf16(a[6], a[7]);
      *(u32x4*)(zp + (size_t)r * 4096) = w;
#pragma unroll
      for (int j = 0; j < 8; ++j) { prev[j] = cur[j]; cur[j] = nxt[j]; }
    }
  }
}
__device__ __forceinline__ void gconv_phase(const bf16_t* ZC, bf16_t* Y, const float* cw) {
  constexpr int R = 32;
  int tid_ = threadIdx.x; asm volatile("" : "+v"(tid_));
  const int gthread = (int)blockIdx.x * 512 + tid_, nthreads = (int)gridDim.x * 512;
  for (int item = gthread; item < (NTOK / R) * 128; item += nthreads) {
    const int cgp = item & 127, run = item >> 7, c = cgp * 8;
    float w0[8], w1[8], w2[8];
#pragma unroll
    for (int j = 0; j < 8; ++j) { w0[j] = cw[c + j]; w1[j] = cw[DM + c + j]; w2[j] = cw[2 * DM + c + j]; }
    const size_t t0 = (size_t)run * R; const int s0 = (int)(t0 & (SEQ - 1));
    const bf16_t* zp = ZC + t0 * 3072 + c;
    float prev[8], cur[8], nxt[8], ta[8], tb[8];
    if (s0 == 0) {
#pragma unroll
      for (int j = 0; j < 8; ++j) prev[j] = 0.f;
    } else { unpack8(*(const u32x4*)(zp - 3072 + 1024), ta); unpack8(*(const u32x4*)(zp - 3072 + 2048), tb);
#pragma unroll
      for (int j = 0; j < 8; ++j) prev[j] = ta[j] * tb[j]; }
    unpack8(*(const u32x4*)(zp + 1024), ta); unpack8(*(const u32x4*)(zp + 2048), tb);
#pragma unroll
    for (int j = 0; j < 8; ++j) cur[j] = ta[j] * tb[j];
#pragma unroll 4
    for (int r = 0; r < R; ++r) {
      if (s0 + r + 1 < SEQ) { unpack8(*(const u32x4*)(zp + (size_t)(r + 1) * 3072 + 1024), ta); unpack8(*(const u32x4*)(zp + (size_t)(r + 1) * 3072 + 2048), tb);
#pragma unroll
        for (int j = 0; j < 8; ++j) nxt[j] = ta[j] * tb[j]; }
      else {
#pragma unroll
        for (int j = 0; j < 8; ++j) nxt[j] = 0.f;
      }
      float gb[8]; unpack8(*(const u32x4*)(zp + (size_t)r * 3072), gb);
      float a[8];
#pragma unroll
      for (int j = 0; j < 8; ++j) a[j] = gb[j] * (w0[j] * prev[j] + w1[j] * cur[j] + w2[j] * nxt[j]);
      u32x4 w; w.x = cvt_pk_bf16(a[0], a[1]); w.y = cvt_pk_bf16(a[2], a[3]); w.z = cvt_pk_bf16(a[4], a[5]); w.w = cvt_pk_bf16(a[6], a[7]);
      *(u32x4*)(Y + (t0 + r) * 1024 + c) = w;
#pragma unroll
      for (int j = 0; j < 8; ++j) { prev[j] = cur[j]; cur[j] = nxt[j]; }
    }
  }
}

#define XB_TMO      128
#define XB_XCNT(j)  (256  + 64 * (j))
#define XB_XSUB(j)  (1280 + 64 * (j))
#define XB_XGEN(j)  (2304 + 64 * (j))
#define XB_TOP      3328
#define XB_TOPGEN   3392
#define XCD_BAR_WORDS 3456
#define XB_SPIN_CAP (1u << 18)
__device__ __forceinline__ unsigned xb_ld(unsigned* p)              { return __hip_atomic_load(p, __ATOMIC_RELAXED, __HIP_MEMORY_SCOPE_AGENT); }
__device__ __forceinline__ unsigned xb_add(unsigned* p, unsigned v) { return __hip_atomic_fetch_add(p, v, __ATOMIC_RELAXED, __HIP_MEMORY_SCOPE_AGENT); }
__device__ __forceinline__ unsigned xb_xcc_id() { return (unsigned)__builtin_amdgcn_s_getreg((3 << 11) | 20) & 0xFu; }
#define XB_SPIN(cond, bar) do { unsigned _sp = 0; while (cond) { __builtin_amdgcn_s_sleep(1); \
    if ((++_sp & 255u) == 0u) { if (xb_ld(&(bar)[XB_TMO])) break; if (_sp > XB_SPIN_CAP) { atomicAdd(&(bar)[XB_TMO], 1u); break; } } } } while (0)
__device__ __forceinline__ void xcd_barrier_complete(unsigned* bar, unsigned x, unsigned& nloc, unsigned& nx) {
  const unsigned G = gridDim.x * gridDim.y * gridDim.z;
  unsigned sum, cnt, mine, sp = 0u;
  for (;;) {
    sum = 0u; cnt = 0u; mine = 0u;
#pragma unroll
    for (unsigned j = 0; j < 16; ++j) { const unsigned c = xb_ld(&bar[XB_XCNT(j)]); sum += c; cnt += (c > 0u) ? 1u : 0u; mine = (j == x) ? c : mine; }
    if (sum == G) break;
    __builtin_amdgcn_s_sleep(1);
    if ((++sp & 255u) == 0u) { if (xb_ld(&bar[XB_TMO])) break; if (sp > XB_SPIN_CAP) { atomicAdd(&bar[XB_TMO], 1u); break; } }
  }
  nloc = mine > 0u ? mine : 1u; nx = cnt > 0u ? cnt : 1u;
}
__device__ __forceinline__ void xcd_barrier(volatile LAS unsigned* st) {
  asm volatile("s_waitcnt vmcnt(0)" ::: "memory");
  __syncthreads();
  if (threadIdx.x == 0) {
    unsigned* bar = (unsigned*)kws();
    const unsigned x = xb_xcc_id();
    __builtin_amdgcn_s_waitcnt(0);
    unsigned nloc = st[0], nx = st[1];
    if (nloc == 0u) { xcd_barrier_complete(bar, x, nloc, nx); st[0] = nloc; st[1] = nx; }
    const unsigned old = xb_add(&bar[XB_XSUB(x)], 1u);
    const unsigned gen = old / nloc;
    if (old + 1u == (gen + 1u) * nloc) {
      __builtin_amdgcn_fence(__ATOMIC_RELEASE, "agent");
      asm volatile("s_waitcnt vmcnt(0)" ::: "memory");
      const unsigned og = xb_add(&bar[XB_TOP], 1u);
      const unsigned tg = og / nx;
      if (og + 1u == (tg + 1u) * nx) xb_add(&bar[XB_TOPGEN], 1u);
      else XB_SPIN(xb_ld(&bar[XB_TOPGEN]) == tg, bar);
      __builtin_amdgcn_fence(__ATOMIC_ACQUIRE, "agent");
      xb_add(&bar[XB_XGEN(x)], 1u);
      asm volatile("s_waitcnt vmcnt(0)" ::: "memory");
    } else {
      XB_SPIN(xb_ld(&bar[XB_XGEN(x)]) == gen, bar);
      __builtin_amdgcn_fence(__ATOMIC_ACQUIRE, "agent");
      asm volatile("s_waitcnt vmcnt(0)" ::: "memory");
    }
  }
  __syncthreads();
}

__device__ __forceinline__ Job job_kv(unsigned char* ws, int l) {
  bf16_t* wl = (bf16_t*)(ws + WS_W) + W_LAY + (size_t)l * W_LAY_SZ;
  return job_std((bf16_t*)(ws + WS_MB), DM, wl + (size_t)1024 * DM, DM, DM, 16, 8, (bf16_t*)(ws + WS_KV), 2048);
}
__device__ __forceinline__ Job job_qk(unsigned char* ws, int l) {
  bf16_t* wl = (bf16_t*)(ws + WS_W) + W_LAY + (size_t)l * W_LAY_SZ;
  Job j = job_std((bf16_t*)(ws + WS_KV), 2048, wl, DM, 256, 64, 4, (bf16_t*)(ws + WS_WQK), DM);
  j.adiv = 4; j.a1 = 256 * 2048; j.a0 = 256; j.bdiv = 4; j.b1 = 0; j.b0 = 256; j.b2 = 256 * DM;
  return j;
}
__device__ __forceinline__ Job job_vo(unsigned char* ws, int l) {
  bf16_t* wl = (bf16_t*)(ws + WS_W) + W_LAY + (size_t)l * W_LAY_SZ;
  Job j = job_std(wl + (size_t)3072 * DM, DM, (bf16_t*)(ws + WS_KV) + 1024, 2048, 256, 16, 16, (bf16_t*)(ws + WS_VWO), DM);
  j.adiv = 4; j.a0 = 256 * DM; j.a1 = 256; j.bdiv = 4; j.b1 = 256; j.b0 = 0; j.b2 = 256 * 2048;
  j.odiv = 4; j.r1 = 0; j.r0 = 256; j.r2 = 1024; j.c1 = 256; j.c0 = 0; j.c2 = 0;
  return j;
}

__global__ void __launch_bounds__(512, 2) fwd_megakernel(Params p) {
  extern __shared__ __attribute__((aligned(16))) unsigned char lds_raw[];
  LAS unsigned char* lds = (LAS unsigned char*)lds_raw;
  cg::grid_group grid = cg::this_grid();
  const int G = gridDim.x, bx = blockIdx.x;

  volatile LAS unsigned* barst = (volatile LAS unsigned*)(lds + BARST_OFF);
  if (threadIdx.x < 4) barst[threadIdx.x] = 0u;
  if (bx == 0) { unsigned* bar = (unsigned*)kws(); for (int i = threadIdx.x; i < XCD_BAR_WORDS; i += 512) bar[i] = 0u; }
#ifndef NO_PRO
  prologue(lds);
#endif
  grid.sync();
  if (threadIdx.x == 0) (void)xb_add(&((unsigned*)kws())[XB_XCNT(xb_xcc_id())], 1u);
#define GRID_SYNC() xcd_barrier(barst)

#pragma unroll 1
  for (int l = 0; l < DEPTH; ++l) {
    const int jx = l >> 1;
    if ((l & 1) == 0) {
      { unsigned char* ws = kws(); bf16_t* we = (bf16_t*)(ws + WS_W) + W_EVEN + (size_t)jx * W_EVEN_SZ;
        Job js = job_std(we, DM, (bf16_t*)(ws + WS_HB), DM, DM, 4, 256, (bf16_t*)(ws + WS_Z + Z_DT), 0); js.ssp = (float*)(ws + WS_SSP); js.O2 = (bf16_t*)(ws + WS_Z + Z_VT);
        gemm_phase<EPI_SWAP>(lds, js, G, bx); }
      { unsigned char* ws = kws(); bf16_t* we = (bf16_t*)(ws + WS_W) + W_EVEN + (size_t)jx * W_EVEN_SZ;
        Job jq = job_std((bf16_t*)(ws + WS_HB), DM, we + (size_t)1024 * DM, DM, DM, 256, 4, (bf16_t*)(ws + WS_Z + Z_QK), DM); jq.ssp = (float*)(ws + WS_SSP);
        gemm_phase<EPI_SCALE>(lds, jq, G, bx); }
      { const Job jkv = job_kv(kws(), l); gemm_phase<EPI_SCALE>(lds, jkv, G, bx); }
      GRID_SYNC();
      { unsigned char* ws = kws();
        Job jd = job_std((bf16_t*)(ws + WS_FCAT), 8192, (bf16_t*)(ws + WS_Z + Z_DT), 8192, 8192, 128, 2, (bf16_t*)(ws + WS_Z + Z_YE), DM);
        jd.adiv = 8; jd.a0 = 256 * 8192; jd.a1 = 0; jd.a2 = 2048 * 8192;     jd.bdiv = 8; jd.b1 = 512 * 8192; jd.b0 = 0; jd.b2 = 256 * 8192; jd.cscale = 0.0013810679320049757f;
        jd.chain = 4;
        gemm_phase<EPI_DFT>(lds, jd, G, bx);
        dft_mid_row((bf16_t*)(ws + WS_Z + Z_DT), (bf16_t*)(ws + WS_Z + Z_YE), 0.0013810679320049757f); }
      { const Job jqk = job_qk(kws(), l); gemm_phase<EPI_SCALE>(lds, jqk, G, bx); }
      { const Job jvo = job_vo(kws(), l); gemm_phase<EPI_SCALE>(lds, jvo, G, bx); }
#ifndef NO_NATTEN
      { unsigned char* ws = kws();
        natten_phase((bf16_t*)(ws + WS_Z + Z_QK), (bf16_t*)(ws + WS_Z + Z_VT), (bf16_t*)(ws + WS_Z + Z_YE), kin(5) + (size_t)jx * 4 * 15 * 31, (LAS float*)(lds + XCH_OFF)); }
#endif
      GRID_SYNC();
    } else {
      { unsigned char* ws = kws(); bf16_t* wo = (bf16_t*)(ws + WS_W) + W_ODD + (size_t)jx * W_ODD_SZ;
        Job ji = job_std((bf16_t*)(ws + WS_HB), DM, wo, DM, DM, 256, 4, (bf16_t*)(ws + WS_Z), DM); ji.ssp = (float*)(ws + WS_SSP);
        gemm_phase<EPI_SCALE>(lds, ji, G, bx); }
      { const Job jkv = job_kv(kws(), l); gemm_phase<EPI_SCALE>(lds, jkv, G, bx); }
      GRID_SYNC();
      { unsigned char* ws = kws(); bf16_t* wo = (bf16_t*)(ws + WS_W) + W_ODD + (size_t)jx * W_ODD_SZ;
        Job jc = job_std((bf16_t*)(ws + WS_HB) - DM, DM, wo + (size_t)1024 * DM, DM, DM, 272, 8, (bf16_t*)(ws + WS_Z + Z_YO), DM); jc.ssp = (float*)(ws + WS_SSP);
        jc.adiv = 17; jc.a1 = SEQ * DM; jc.a0 = 254 * DM; jc.cw = kin(8) + (size_t)jx * 3 * DM; jc.GB = (const bf16_t*)(ws + WS_Z);
        gemm_phase<EPI_GCONV>(lds, jc, G, bx); }
      { const Job jqk = job_qk(kws(), l); gemm_phase<EPI_SCALE>(lds, jqk, G, bx); }
      { const Job jvo = job_vo(kws(), l); gemm_phase<EPI_SCALE>(lds, jvo, G, bx); }
      GRID_SYNC();
    }
    { unsigned char* ws = kws(); bf16_t* wb = (bf16_t*)(ws + WS_W);
      const bf16_t* wout = ((l & 1) == 0) ? wb + W_EVEN + (size_t)jx * W_EVEN_SZ + (size_t)2048 * DM : wb + W_ODD + (size_t)jx * W_ODD_SZ + (size_t)3072 * DM;
      const bf16_t* Ymix = (bf16_t*)(ws + WS_Z + (((l & 1) == 0) ? Z_YE : Z_YO));
      Job jo = job_std(Ymix, DM, wout, DM, DM, 256, 4, (bf16_t*)(ws + WS_HB), DM); jo.sspw = (float*)(ws + WS_SSP);
      gemm_phase<EPI_RES>(lds, jo, G, bx); }
    GRID_SYNC();
    { unsigned char* ws = kws();
      Job jx1 = job_std((bf16_t*)(ws + WS_HB), DM, (bf16_t*)(ws + WS_WQK), DM, DM, 256, 4, (bf16_t*)(ws + WS_Z), DM); jx1.bdiv = 16; jx1.b1 = DM * DM; jx1.ssp = (float*)(ws + WS_SSP);
      gemm_phase<EPI_SOFTMAX>(lds, jx1, G, bx); }
    GRID_SYNC();
    { unsigned char* ws = kws();
      Job jx2 = job_std((bf16_t*)(ws + WS_Z), DM, (bf16_t*)(ws + WS_VWO), DM, DM, 256, 4, (bf16_t*)(ws + WS_HB), DM); jx2.bdiv = 16; jx2.b1 = DM * DM; jx2.sspw = (float*)(ws + WS_SSP);
      gemm_phase<EPI_RES>(lds, jx2, G, bx); }
    GRID_SYNC();
    { unsigned char* ws = kws(); bf16_t* wl = (bf16_t*)(ws + WS_W) + W_LAY + (size_t)l * W_LAY_SZ;
      Job ju = job_std((bf16_t*)(ws + WS_HB), DM, wl + (size_t)4096 * DM, DM, DM, 256, 16, (bf16_t*)(ws + WS_Z), DFF); ju.ssp = (float*)(ws + WS_SSP);
      ju.chain = 1; ju.cw = kin(16) + (size_t)l * 3 * DFF; ju.cb = kin(17) + (size_t)l * DFF;
      gemm_phase<EPI_FFN>(lds, ju, G, bx); }
    GRID_SYNC();
    { unsigned char* ws = kws(); bf16_t* wl = (bf16_t*)(ws + WS_W) + W_LAY + (size_t)l * W_LAY_SZ;
      Job jd2 = job_std((bf16_t*)(ws + WS_Z), DFF, wl + (size_t)8192 * DM, DFF, DFF, 256, 4, (bf16_t*)(ws + WS_HB), DM); jd2.sspw = (float*)(ws + WS_SSP);
      gemm_phase<EPI_RES>(lds, jd2, G, bx); }
    GRID_SYNC();
  }
  {
    int tid = threadIdx.x; asm volatile("" : "+v"(tid));
    const int lane = tid & 63, gwave = bx * 8 + (tid >> 6), ngw = G * 8;
    float* H = kout(); unsigned char* ws = kws(); const float* ssp = (const float*)(ws + WS_SSP); const bf16_t* HB = (const bf16_t*)(ws + WS_HB); const float* gf = kin(19);
    f32x4 gg[4];
#pragma unroll
    for (int j = 0; j < 4; ++j) gg[j] = *((const f32x4*)gf + lane + 64 * j);
    for (int r = gwave; r < NTOK; r += 2 * ngw) {
      u32x2 hv[2][4]; float rs[2];
#pragma unroll
      for (int q = 0; q < 2; ++q) { const int rq = min(r + q * ngw, NTOK - 1); rs[q] = rstd_of(ssp, (size_t)rq);
#pragma unroll
        for (int j = 0; j < 4; ++j) hv[q][j] = *((const u32x2*)(HB + (size_t)rq * DM) + lane + 64 * j); }
#pragma unroll
      for (int q = 0; q < 2; ++q) { if (r + q * ngw >= NTOK) continue;
        f32x4* orow = (f32x4*)(H + (size_t)(r + q * ngw) * DM) + lane;
#pragma unroll
        for (int j = 0; j < 4; ++j) { const f32x4 v = (f32x4){bf_lo(hv[q][j].x), bf_hi(hv[q][j].x), bf_lo(hv[q][j].y), bf_hi(hv[q][j].y)}; orow[64 * j] = v * rs[q] * gg[j]; } }
    }
  }
}

extern "C" void kernel_launch(void* const* d_in, const int* in_sizes, int n_in, void* d_out, int out_size, void* d_ws, size_t ws_size, hipStream_t stream) {
  static int grid_blocks = 0;
  if (!grid_blocks) {
    int dev = 0, cus = 0, per_cu = 0;
    (void)hipGetDevice(&dev);
    (void)hipDeviceGetAttribute(&cus, hipDeviceAttributeMultiprocessorCount, dev);
    (void)hipFuncSetAttribute((const void*)fwd_megakernel, hipFuncAttributeMaxDynamicSharedMemorySize, LDS_BYTES);
    (void)hipOccupancyMaxActiveBlocksPerMultiprocessor(&per_cu, (const void*)fwd_megakernel, 512, LDS_BYTES);
    if (per_cu < 1) per_cu = 1;
    grid_blocks = cus * per_cu;
    if (n_in != 20 || out_size != NTOK * DM || ws_size < WS_END) { fprintf(stderr, "kernel_launch: unexpected shapes/workspace (n_in %d out %d ws %zu)\n", n_in, out_size, ws_size); grid_blocks = -1; }
  }
  if (grid_blocks < 0) return;
  Params p{};
  for (int i = 0; i < 20; ++i) p.in[i] = (const float*)d_in[i];
  p.out = (float*)d_out; p.ws = (unsigned char*)d_ws;
  void* args[] = {&p};
  hipError_t e = hipLaunchCooperativeKernel((void*)fwd_megakernel, dim3(grid_blocks), dim3(512), args, LDS_BYTES, stream);
  if (e != hipSuccess) fprintf(stderr, "cooperative launch failed: %s (grid %d)\n", hipGetErrorString(e), grid_blocks);
}
#ifdef TEST_EPI
__global__ void __launch_bounds__(512, 2) test_kernel(Job j, int G) {
  extern __shared__ __attribute__((aligned(16))) unsigned char lds_raw[];
  gemm_phase<TEST_EPI>((LAS unsigned char*)lds_raw, j, G, blockIdx.x);
}
#endif
```

```cpp
#include <hip/hip_runtime.h>
#include <hip/hip_cooperative_groups.h>
#include <cstdio>
#include <cstdint>
namespace cg = cooperative_groups;

#define LAS __attribute__((address_space(3)))
typedef unsigned short bf16_t;
typedef short bf16x8 __attribute__((ext_vector_type(8)));
typedef float f32x4 __attribute__((ext_vector_type(4)));
typedef float f32x2 __attribute__((ext_vector_type(2)));
typedef unsigned u32x4 __attribute__((ext_vector_type(4)));
typedef unsigned u32x2 __attribute__((ext_vector_type(2)));

constexpr int DM = 1024, NB = 16, SEQ = 4096, NTOK = NB * SEQ, DEPTH = 4, NMEM = 256, DFF = 2048;
constexpr float EPS = 1e-6f;
constexpr float LOG2E = 1.4426950408889634f;

constexpr size_t MiB = 1u << 20;
constexpr size_t WS_SSP = 1 * MiB;
constexpr size_t WS_W = 2 * MiB;
constexpr size_t WS_FCAT = 112 * MiB;
constexpr size_t WS_MB = 176 * MiB;
constexpr size_t WS_KV = 184 * MiB;
constexpr size_t WS_WQK = 200 * MiB;
constexpr size_t WS_VWO = 232 * MiB;
constexpr size_t WS_HB = 264 * MiB;
constexpr size_t WS_Z = 392 * MiB;
constexpr size_t WS_END = 904 * MiB;
constexpr size_t Z_DT = 0, Z_QK = 128 * MiB, Z_VT = 256 * MiB, Z_YE = 320 * MiB, Z_YO = 384 * MiB;

constexpr size_t W_EVEN = 0;
constexpr size_t W_EVEN_SZ = (size_t)(1024 + 1024 + 1024) * 1024;
constexpr size_t W_ODD = W_EVEN + 2 * W_EVEN_SZ;
constexpr size_t W_ODD_SZ = (size_t)(3072 + 1024) * 1024;
constexpr size_t W_LAY = W_ODD + 2 * W_ODD_SZ;
constexpr size_t W_LAY_SZ = (size_t)(1024 + 2048 + 1024 + 4096 + 2048) * 1024;
static_assert((W_LAY + 4 * W_LAY_SZ) * 2 <= 110 * MiB, "weights fit");

constexpr int RING_BYTES = 131072, XCH_OFF = RING_BYTES, XCH_BYTES = 8192, BARST_OFF = XCH_OFF + XCH_BYTES, LDS_BYTES = BARST_OFF + 16;

struct Params {
  const float* in[20]; float* out; unsigned char* ws;
};

#define CAS __attribute__((address_space(4)))
__device__ __forceinline__ CAS const char* ka_ptr() { CAS const char* ka = (CAS const char*)__builtin_amdgcn_kernarg_segment_ptr(); asm volatile("" : "+s"(ka)); return ka; }
__device__ __forceinline__ unsigned long long ka_u64(int off) { return *(CAS const unsigned long long*)(ka_ptr() + off); }
__device__ __forceinline__ const float* kin(int i) { return (const float*)(__attribute__((address_space(1))) const float*)ka_u64(8 * i); }
__device__ __forceinline__ float* kout() { return (float*)(__attribute__((address_space(1))) float*)ka_u64(160); }
__device__ __forceinline__ unsigned char* kws() { return (unsigned char*)(__attribute__((address_space(1))) unsigned char*)ka_u64(168); }
#define GAS __attribute__((address_space(1)))
template <class T> __device__ __forceinline__ T* uni(T* p) { const unsigned long long v = (unsigned long long)p; const unsigned lo = __builtin_amdgcn_readfirstlane((unsigned)v), hi = __builtin_amdgcn_readfirstlane((unsigned)(v >> 32)); return (T*)(GAS T*)(((unsigned long long)hi << 32) | lo); }
__device__ __forceinline__ int uni(int v) { return __builtin_amdgcn_readfirstlane(v); }
__device__ __forceinline__ unsigned cvt_pk_bf16(float lo, float hi) { unsigned r; asm volatile("v_cvt_pk_bf16_f32 %0, %1, %2" : "=v"(r) : "v"(lo), "v"(hi)); return r; }
__device__ __forceinline__ float bf_lo(unsigned u) { return __uint_as_float(u << 16); }
__device__ __forceinline__ float bf_hi(unsigned u) { return __uint_as_float(u & 0xffff0000u); }
__device__ __forceinline__ float wave_sum(float v) {
#pragma unroll
  for (int o = 1; o < 64; o <<= 1) v += __shfl_xor(v, o);
  return v;
}
__device__ __forceinline__ f32x2 gelu_pk(f32x2 v) {
  const f32x2 av = __builtin_elementwise_abs(v), d = av * 0.2316418882f + 1.0f;
  f32x2 t; t.x = __builtin_amdgcn_rcpf(d.x); t.y = __builtin_amdgcn_rcpf(d.y);
  f32x2 q = t * 0.5307027145f + (-0.7265760135f); q = q * t + 0.7107068705f; q = q * t + (-0.142248368f); q = q * t + 0.127414796f; q = q * t;
  const f32x2 s = (v * v) * (-0.72134752044f);
  f32x2 e; e.x = __builtin_amdgcn_exp2f(s.x); e.y = __builtin_amdgcn_exp2f(s.y);
  const f32x2 m = v * (q * e), r = v - m;
  f32x2 o; o.x = v.x < 0.f ? m.x : r.x; o.y = v.y < 0.f ? m.y : r.y; return o;
}
__device__ __forceinline__ float rstd_of(const float* ssp, size_t row) {
  const f32x4 s = *(const f32x4*)(ssp + row * 4);
  return rsqrtf(((s.x + s.y) + (s.z + s.w)) * (1.0f / DM) + EPS);
}

__device__ __forceinline__ void unpack8(const u32x4 w, float (&f)[8]) {
  f[0] = bf_lo(w.x); f[1] = bf_hi(w.x); f[2] = bf_lo(w.y); f[3] = bf_hi(w.y); f[4] = bf_lo(w.z); f[5] = bf_hi(w.z); f[6] = bf_lo(w.w); f[7] = bf_hi(w.w);
}

constexpr int BM = 256, BK = 64, HALF = 128, HTB = HALF * BK * 2, NXCD = 8, WGM = 8;
__device__ __forceinline__ int lds_byte(int r, int c) { const int st = (r >> 4) * 2 + (c >> 5), rr = r & 15, cc = c & 31, ob = rr * 64 + cc * 2; return st * 1024 + (ob ^ (((ob >> 9) & 1) << 5)); }
__device__ __forceinline__ void stage_rc(int b, int& R, int& C) { const int st = b / 1024, sb = b % 1024, swz = sb ^ (((sb >> 9) & 1) << 5); R = (st >> 1) * 16 + swz / 64; C = (st & 1) * 32 + (swz % 64) / 2; }
__device__ __forceinline__ int perm32(int rho) { const int n = rho >> 4, i = rho & 15; return 8 * (i >> 2) + 4 * n + (i & 3); }

struct Unit { int pm, pn; };
struct Job {
  const bf16_t* A; const bf16_t* Bt;
  int lda, ldb, K, nM, nN;
  int adiv, bdiv, odiv;
  int a0, a1, a2, b0, b1, b2;
  int r0, r1, r2, c0, c1, c2;
  bf16_t* O; int ldc;
  const float* ssp; float cscale;
  const float* base; float* H; float* sspw;
  bf16_t* O2;
  const float* cw; const float* cb;
  const bf16_t* GB;
  int chain;
};
__device__ __forceinline__ Job job_std(const bf16_t* A, int lda, const bf16_t* Bt, int ldb, int K, int nM, int nN, bf16_t* O, int ldc) {
  Job j; j.A = A; j.Bt = Bt; j.lda = lda; j.ldb = ldb; j.K = K; j.nM = nM; j.nN = nN;
  j.adiv = 1 << 20; j.bdiv = 1 << 20; j.odiv = 1 << 20;
  j.a0 = 256 * lda; j.a1 = 0; j.a2 = 0; j.b0 = 0; j.b1 = 0; j.b2 = 256 * ldb;
  j.r0 = 256; j.r1 = 0; j.r2 = 0; j.c0 = 0; j.c1 = 0; j.c2 = 256;
  j.O = O; j.ldc = ldc; j.ssp = nullptr; j.cscale = 1.0f; j.base = nullptr; j.H = nullptr; j.sspw = nullptr; j.O2 = nullptr; j.cw = nullptr; j.cb = nullptr; j.GB = nullptr; j.chain = 0;
  return j;
}
struct StaticOrder {
  int nM, nN, nwg, G, c, chain;
  __device__ __forceinline__ void init(int nM_, int nN_, int G_, int c_, int chain_) { nM = nM_; nN = nN_; nwg = nM * nN; G = G_; c = c_; chain = chain_; }
  __device__ __forceinline__ bool next(int i, Unit& u) const {
    if (chain == 4) {
      if (G != 256) { const int L = i * G + c; if (L >= nwg) return false; u.pm = uni(L >> 1); u.pn = uni(L & 1); return true; }
      if (i > 0) return false; const int x = c & 7, j = c >> 3; u.pn = uni(x >> 2); u.pm = uni((4 * (x & 3) + (j >> 3)) * 8 + (j & 7)); return true; }
    if (chain) {
      int bq, pq;
      if (G == 256) { if (i >= 16) return false; const int x = c & 7, j = c >> 3; bq = 8 * (x >> 2) + (j >> 2); pq = 4 * (x & 3) + (j & 3); }
      else { const int ch = c + (i >> 4) * G; if (ch >= 256) return false; bq = ch >> 4; pq = ch & 15; }
      u.pm = uni(bq * 16 + (i & 15)); u.pn = uni(pq); return true; }
    const int L = i * G + c; if (L >= nwg) return false;
    int wgid = L; { const int q = nwg / NXCD, r = nwg % NXCD, xcd = wgid % NXCD, off = wgid / NXCD; wgid = (xcd < r ? xcd * (q + 1) : r * (q + 1) + (xcd - r) * q) + off; }
    const int nig = WGM * nN, gid = wgid / nig, fm = gid * WGM, gsz = (nM - fm) < WGM ? (nM - fm) : WGM;
    u.pm = uni(fm + ((wgid % nig) % gsz)); u.pn = uni((wgid % nig) / gsz); return true;
  }
};
__device__ __forceinline__ size_t job_aoff(const Job& g, const Unit& u) { return (size_t)(u.pm / g.adiv) * g.a1 + (size_t)(u.pm % g.adiv) * g.a0 + (size_t)u.pn * g.a2; }
__device__ __forceinline__ size_t job_boff(const Job& g, const Unit& u) { return (size_t)(u.pm / g.bdiv) * g.b1 + (size_t)(u.pm % g.bdiv) * g.b0 + (size_t)u.pn * g.b2; }

#define RSTD_BATCH8(dst, sb, ROWOF) do { f32x4 _t[8]; _Pragma("unroll") for (int _q = 0; _q < 8; ++_q) _t[_q] = *(const f32x4*)((sb) + (size_t)(unsigned)(ROWOF(_q)) * 4); \
    __builtin_amdgcn_sched_barrier(0); _Pragma("unroll") for (int _q = 0; _q < 8; ++_q) (dst)[_q] = rsqrtf(((_t[_q].x + _t[_q].y) + (_t[_q].z + _t[_q].w)) * (1.0f / DM) + EPS); } while (0)
#define ROW8(q) (((q) >> 2) * HALF + rl + ((q) & 3) * 16)
enum { EPI_SCALE = 0, EPI_SWAP = 1, EPI_RES = 2, EPI_SOFTMAX = 3, EPI_FFN = 4, EPI_DFT = 5, EPI_GCONV = 6 };
template <int CTRL> __device__ __forceinline__ float dppf(float old, float src) { return __builtin_bit_cast(float, __builtin_amdgcn_update_dpp(__builtin_bit_cast(int, old), __builtin_bit_cast(int, src), CTRL, 0xF, 0xF, false)); }

template <int EPI>
__device__ __forceinline__ void epilogue(f32x4 (&acc)[2][2][4][2], const Job& g, const Unit& u, int wr, int wc, int fr, int fq, LAS unsigned char* xch) {
  const int rl = wr * 64 + fr, cl = wc * 32 + 8 * fq;
  if constexpr (EPI == EPI_SCALE) {
    const size_t orow0 = (size_t)(u.pm / g.odiv) * g.r1 + (size_t)(u.pm % g.odiv) * g.r0 + (size_t)u.pn * g.r2;
    const int ocol0 = (u.pm / g.odiv) * g.c1 + (u.pm % g.odiv) * g.c0 + u.pn * g.c2;
    bf16_t* obase = uni(g.O + orow0 * g.ldc + ocol0);
    const float* sbase = uni(g.ssp + (size_t)u.pm * BM * 4);
    float scr8[8];
    { const float* sb = g.ssp ? sbase : (const float*)uni(g.A);
      RSTD_BATCH8(scr8, sb, ROW8);
#pragma unroll
      for (int q = 0; q < 8; ++q) scr8[q] = g.ssp ? scr8[q] * g.cscale : g.cscale; }
#pragma unroll
    for (int ai = 0; ai < 2; ++ai)
#pragma unroll
      for (int m = 0; m < 4; ++m) {
        const int lr = ai * HALF + rl + m * 16;
        const float sc = scr8[ai * 4 + m];
        bf16_t* rowp = (bf16_t*)((char*)obase + (unsigned)(lr * g.ldc + cl) * 2u);
#pragma unroll
        for (int bj = 0; bj < 2; ++bj) {
          const f32x4 v0 = acc[ai][bj][m][0] * sc, v1 = acc[ai][bj][m][1] * sc;
          u32x4 w; w.x = cvt_pk_bf16(v0[0], v0[1]); w.y = cvt_pk_bf16(v0[2], v0[3]); w.z = cvt_pk_bf16(v1[0], v1[1]); w.w = cvt_pk_bf16(v1[2], v1[3]);
          __builtin_nontemporal_store(w, (u32x4*)(rowp + bj * HALF));
        }
      }
  } else if constexpr (EPI == EPI_SWAP) {
    float rs[2][8];
    const size_t tokt = (size_t)u.pn * BM;
    const float* sbase = uni(g.ssp + tokt * 4);
#define COL8A(q) (cl + (q))
#define COL8B(q) (cl + HALF + (q))
    RSTD_BATCH8(rs[0], sbase, COL8A);
    RSTD_BATCH8(rs[1], sbase, COL8B);
    __builtin_amdgcn_sched_barrier(0);
    const size_t bq = tokt >> 12, sq = tokt & 4095;
    bf16_t* dtb = uni(g.O + bq * 512 * 8192 + sq);
    bf16_t* vtb = uni(g.O2 + (size_t)((u.pm >= 2 ? u.pm - 2 : 0) * BM) * NTOK + tokt);
#pragma unroll
    for (int ai = 0; ai < 2; ++ai)
#pragma unroll
      for (int m = 0; m < 4; ++m) {
        const int lr = ai * HALF + rl + m * 16;
        int r1, r2, half;
        if (u.pm == 0) { const int gg = lr >> 6, cp = lr & 63; r1 = gg * 64 + cp; r2 = cp ? 256 + gg * 64 + 64 - cp : -1; half = 0; }
        else if (lr < 4) { r1 = 256 + lr * 64; r2 = -1; half = 0; }
        else { const int mm = lr - 4, gg = mm / 63, cp = 1 + mm % 63; r1 = gg * 64 + cp; r2 = 256 + gg * 64 + 64 - cp; half = 1; }
        bf16_t* p1 = (u.pm < 2) ? (bf16_t*)((char*)dtb + ((unsigned)(r1 * 8192 + half * 4096) + (unsigned)cl) * 2u) : (bf16_t*)((char*)vtb + ((unsigned)lr * (unsigned)NTOK + (unsigned)cl) * 2u);
        bf16_t* p2 = (bf16_t*)((char*)dtb + ((unsigned)((r2 < 0 ? 0 : r2) * 8192 + half * 4096) + (unsigned)cl) * 2u);
#pragma unroll
        for (int bj = 0; bj < 2; ++bj) {
          const f32x4 v0 = acc[ai][bj][m][0], v1 = acc[ai][bj][m][1];
          u32x4 w; w.x = cvt_pk_bf16(v0[0] * rs[bj][0], v0[1] * rs[bj][1]); w.y = cvt_pk_bf16(v0[2] * rs[bj][2], v0[3] * rs[bj][3]);
          w.z = cvt_pk_bf16(v1[0] * rs[bj][4], v1[1] * rs[bj][5]); w.w = cvt_pk_bf16(v1[2] * rs[bj][6], v1[3] * rs[bj][7]);
          __builtin_nontemporal_store(w, (u32x4*)(p1 + bj * HALF));
          if (u.pm < 2 && r2 >= 0) __builtin_nontemporal_store(w, (u32x4*)(p2 + bj * HALF));
          if (u.pm == 1 && lr < 4) {
            const u32x4 z = (u32x4){0u, 0u, 0u, 0u};
            __builtin_nontemporal_store(z, (u32x4*)((char*)dtb + ((unsigned)((256 + lr * 64) * 8192 + 4096) + (unsigned)(cl + bj * HALF)) * 2u));
            __builtin_nontemporal_store(z, (u32x4*)((char*)dtb + ((unsigned)((lr * 64) * 8192 + 4096) + (unsigned)(cl + bj * HALF)) * 2u));
          }
        }
      }
  } else if constexpr (EPI == EPI_RES) {
    LAS float* part = (LAS float*)xch;
    const size_t toff = (size_t)u.pm * BM * DM + (size_t)u.pn * BM;
    bf16_t* rO = uni(g.O + toff);
    u32x4 hbv[8][2];
#pragma unroll
    for (int q = 0; q < 8; ++q)
#pragma unroll
      for (int bj = 0; bj < 2; ++bj) hbv[q][bj] = *(const u32x4*)((const char*)rO + ((unsigned)(((q >> 2) * HALF + rl + (q & 3) * 16) * DM + cl) + bj * HALF) * 2u);
    __builtin_amdgcn_sched_barrier(0);
#pragma unroll
    for (int ai = 0; ai < 2; ++ai)
#pragma unroll
      for (int m = 0; m < 4; ++m) {
        const int lr = ai * HALF + rl + m * 16;
        const unsigned off = (unsigned)(lr * DM + cl);
        float ss = 0.f;
#pragma unroll
        for (int bj = 0; bj < 2; ++bj) {
          const u32x4 hb = hbv[ai * 4 + m][bj];
          f32x4 v0 = acc[ai][bj][m][0], v1 = acc[ai][bj][m][1];
          v0[0] += bf_lo(hb.x); v0[1] += bf_hi(hb.x); v0[2] += bf_lo(hb.y); v0[3] += bf_hi(hb.y);
          v1[0] += bf_lo(hb.z); v1[1] += bf_hi(hb.z); v1[2] += bf_lo(hb.w); v1[3] += bf_hi(hb.w);
          ss += (v0[0] * v0[0] + v0[1] * v0[1]) + (v0[2] * v0[2] + v0[3] * v0[3]) + (v1[0] * v1[0] + v1[1] * v1[1]) + (v1[2] * v1[2] + v1[3] * v1[3]);
          u32x4 w; w.x = cvt_pk_bf16(v0[0], v0[1]); w.y = cvt_pk_bf16(v0[2], v0[3]); w.z = cvt_pk_bf16(v1[0], v1[1]); w.w = cvt_pk_bf16(v1[2], v1[3]);
          *(u32x4*)((char*)rO + (off + bj * HALF) * 2u) = w;
        }
        ss += __shfl_xor(ss, 16); ss += __shfl_xor(ss, 32);
        if (fq == 0) part[lr * 4 + wc] = ss;
      }
    asm volatile("s_waitcnt lgkmcnt(0)" ::: "memory"); __builtin_amdgcn_s_barrier(); asm volatile("" ::: "memory");
    const int tix = (wr * 4 + wc) * 64 + fq * 16 + fr;
    if (tix < 256) {
      const f32x4 p = *(const LAS f32x4*)(part + tix * 4);
      float* sw = uni(g.sspw + (size_t)u.pm * BM * 4 + u.pn);
      *(float*)((char*)sw + (unsigned)tix * 16u) = (p.x + p.y) + (p.z + p.w);
    }
  } else if constexpr (EPI == EPI_DFT) {
    const int b = u.pm >> 3, st = u.pm & 7;
    bf16_t* obase = uni(g.O + ((size_t)b * SEQ + st * 256) * DM);
    bf16_t* mbase = uni(g.O + ((size_t)b * SEQ + SEQ - st * 256) * DM);
    const float sc = g.cscale;
#pragma unroll
    for (int ai = 0; ai < 2; ++ai)
#pragma unroll
      for (int m = 0; m < 4; ++m) {
        const int lr = ai * HALF + rl + m * 16;
        bf16_t* rowp = (bf16_t*)((char*)obase + (unsigned)(lr * DM) * 2u);
        bf16_t* mrow = mbase - (size_t)lr * DM;
        const bool mir = (st * 256 + lr) != 0;
#pragma unroll
        for (int bj = 0; bj < 2; ++bj) {
          const f32x4 v0 = acc[ai][bj][m][0] * sc, v1 = acc[ai][bj][m][1] * sc;
          u32x4 w; w.x = cvt_pk_bf16(v0[0], v0[1]); w.y = cvt_pk_bf16(v0[2], v0[3]); w.z = cvt_pk_bf16(v1[0], v1[1]); w.w = cvt_pk_bf16(v1[2], v1[3]);
          const int lc = bj * HALF + cl; const int c = 128 * (lc >> 6) + 64 * u.pn + (lc & 63);
          __builtin_nontemporal_store(w, (u32x4*)(rowp + c));
          if (mir) {
            const int gb = c & ~127, cp = c & 127;
            const unsigned ww[4] = {w.x, w.y, w.z, w.w};
#pragma unroll
            for (int j = 0; j < 8; ++j) mrow[gb + ((128 - (cp + j)) & 127)] = (bf16_t)((j & 1) ? (ww[j >> 1] >> 16) : (ww[j >> 1] & 0xffffu));
          }
        }
      }
  } else if constexpr (EPI == EPI_FFN || EPI == EPI_GCONV) {
    constexpr bool GC = (EPI == EPI_GCONV);
    constexpr int CSTR = GC ? DM : DFF;
    constexpr bool CH = !GC;
    LAS float* X = (LAS float*)xch;
    const int b = CH ? (u.pm >> 4) : u.pm / 17, ti = CH ? (u.pm & 15) : u.pm % 17, s0 = CH ? 256 * ti : 254 * ti - 1;
    LAS float* CYW = X + 1024 + (ti & 1) * 384;
    const LAS float* CYR = X + 1024 + ((ti + 1) & 1) * 384;
    const long row0 = (long)b * SEQ + s0;
    const float* sbase = uni(g.ssp + row0 * 4);
    const int ch0 = u.pn * 128 + cl;
    float rs8[8];
    RSTD_BATCH8(rs8, sbase, ROW8);
    __builtin_amdgcn_sched_barrier(0);
#pragma unroll
    for (int ai = 0; ai < 2; ++ai)
#pragma unroll
      for (int m = 0; m < 4; ++m) {
        const int lr = ai * HALF + rl + m * 16;
        const float sc = rs8[ai * 4 + m];
        const bool inb = CH ? true : ((unsigned)(s0 + lr) < (unsigned)SEQ);
#pragma unroll
        for (int n = 0; n < 2; ++n) {
          if constexpr (GC) { const f32x4 gv = (acc[ai][0][m][n] * sc) * (acc[ai][1][m][n] * sc); acc[ai][1][m][n] = inb ? gv : (f32x4){0.f, 0.f, 0.f, 0.f}; }
          else { acc[ai][0][m][n] = acc[ai][0][m][n] * sc; const f32x4 gv = acc[ai][1][m][n] * sc; acc[ai][1][m][n] = inb ? gv : (f32x4){0.f, 0.f, 0.f, 0.f}; } }
      }
#pragma unroll
    for (int ai = 0; ai < 2; ++ai) {
      const int seg = 2 * ai + wr;
      if (fr == 0) { *(LAS f32x4*)(X + (seg * 2 + 0) * 128 + cl) = acc[ai][1][0][0]; *(LAS f32x4*)(X + (seg * 2 + 0) * 128 + cl + 4) = acc[ai][1][0][1]; }
      if (fr == 15) { *(LAS f32x4*)(X + (seg * 2 + 1) * 128 + cl) = acc[ai][1][3][0]; *(LAS f32x4*)(X + (seg * 2 + 1) * 128 + cl + 4) = acc[ai][1][3][1]; }
    }
    if constexpr (CH) {
      if (wr == 1 && fr == 14) { *(LAS f32x4*)(CYW + cl) = acc[1][1][3][0]; *(LAS f32x4*)(CYW + cl + 4) = acc[1][1][3][1]; }
      if (wr == 1 && fr == 15) { *(LAS f32x4*)(CYW + 128 + cl) = acc[1][1][3][0]; *(LAS f32x4*)(CYW + 128 + cl + 4) = acc[1][1][3][1];
                                 *(LAS f32x4*)(CYW + 256 + cl) = acc[1][0][3][0]; *(LAS f32x4*)(CYW + 256 + cl + 4) = acc[1][0][3][1]; }
    }
    asm volatile("s_waitcnt lgkmcnt(0)" ::: "memory"); __builtin_amdgcn_s_barrier(); asm volatile("" ::: "memory");
    bf16_t* obase = uni(g.O + row0 * CSTR + u.pn * 128);
    const bf16_t* gbase = GC ? uni(g.GB + row0 * DM + u.pn * 128) : nullptr;
    float w0[8], w1[8], w2[8], bb[8];
    { const f32x4 a0 = *(const f32x4*)(g.cw + ch0), a1 = *(const f32x4*)(g.cw + ch0 + 4), b0 = *(const f32x4*)(g.cw + CSTR + ch0), b1 = *(const f32x4*)(g.cw + CSTR + ch0 + 4);
      const f32x4 c0 = *(const f32x4*)(g.cw + 2 * CSTR + ch0), c1 = *(const f32x4*)(g.cw + 2 * CSTR + ch0 + 4);
      f32x4 d0 = (f32x4){0.f, 0.f, 0.f, 0.f}, d1 = d0; if constexpr (!GC) { d0 = *(const f32x4*)(g.cb + ch0); d1 = *(const f32x4*)(g.cb + ch0 + 4); }
#pragma unroll
      for (int j = 0; j < 4; ++j) { w0[j] = a0[j]; w0[4 + j] = a1[j]; w1[j] = b0[j]; w1[4 + j] = b1[j]; w2[j] = c0[j]; w2[4 + j] = c1[j]; bb[j] = d0[j]; bb[4 + j] = d1[j]; } }
#pragma unroll
    for (int ai = 0; ai < 2; ++ai) {
      const int seg = 2 * ai + wr;
      f32x4 pl[2], nl[2];
      const int sp = seg > 0 ? seg - 1 : 0, sn = seg < 3 ? seg + 1 : 3;
      pl[0] = *(const LAS f32x4*)(X + (sp * 2 + 1) * 128 + cl); pl[1] = *(const LAS f32x4*)(X + (sp * 2 + 1) * 128 + cl + 4);
      nl[0] = *(const LAS f32x4*)(X + (sn * 2 + 0) * 128 + cl); nl[1] = *(const LAS f32x4*)(X + (sn * 2 + 0) * 128 + cl + 4);
      if constexpr (CH) {
        if (seg == 0) { if (ti > 0) { pl[0] = *(const LAS f32x4*)(CYR + 128 + cl); pl[1] = *(const LAS f32x4*)(CYR + 128 + cl + 4); } else { pl[0] = (f32x4){0.f, 0.f, 0.f, 0.f}; pl[1] = pl[0]; } }
        if (seg == 3) { nl[0] = (f32x4){0.f, 0.f, 0.f, 0.f}; nl[1] = nl[0]; }
      }
#pragma unroll
      for (int m = 0; m < 4; ++m) {
        const int lr = ai * HALF + rl + m * 16;
        float a[8];
#pragma unroll
        for (int n = 0; n < 2; ++n)
#pragma unroll
          for (int v = 0; v < 4; ++v) {
            const float cur = acc[ai][1][m][n][v];
            float oldp, oldn;
            if (m > 0) { const float t = acc[ai][1][m > 0 ? m - 1 : 0][n][v]; oldp = dppf<0x121>(t, t); } else oldp = pl[n][v];
            if (m < 3) { const float t = acc[ai][1][m < 3 ? m + 1 : 3][n][v]; oldn = dppf<0x12F>(t, t); } else oldn = nl[n][v];
            const float prev = dppf<0x111>(oldp, cur), next = dppf<0x101>(oldn, cur);
            a[4 * n + v] = w0[4 * n + v] * prev + w1[4 * n + v] * cur + w2[4 * n + v] * next + bb[4 * n + v];
          }
        if constexpr (!GC) {
#pragma unroll
          for (int j = 0; j < 8; j += 2) { const f32x2 ge = gelu_pk((f32x2){a[j], a[j + 1]}); a[j] = ge.x * acc[ai][0][m][j >> 2][j & 3]; a[j + 1] = ge.y * acc[ai][0][m][(j + 1) >> 2][(j + 1) & 3]; }
        }
        if (CH ? (lr != 255 || ti == 15) : (lr >= 1 && lr <= 254 && s0 + lr < SEQ)) {
          if constexpr (GC) { float gb[8]; unpack8(*(const u32x4*)((const char*)gbase + ((unsigned)lr * DM + (unsigned)cl) * 2u), gb);
#pragma unroll
            for (int j = 0; j < 8; ++j) a[j] *= gb[j]; }
          u32x4 w; w.x = cvt_pk_bf16(a[0], a[1]); w.y = cvt_pk_bf16(a[2], a[3]); w.z = cvt_pk_bf16(a[4], a[5]); w.w = cvt_pk_bf16(a[6], a[7]);
          __builtin_nontemporal_store(w, (u32x4*)((char*)obase + ((unsigned)lr * CSTR + (unsigned)cl) * 2u));
        }
      }
    }
    if constexpr (CH) {
      const int tix = (wr * 4 + wc) * 64 + fq * 16 + fr;
      if (ti > 0 && tix < 16) {
        const int ch = tix * 8, gch = u.pn * 128 + ch;
        const f32x4 ga0 = *(const LAS f32x4*)(CYR + ch), ga1 = *(const LAS f32x4*)(CYR + ch + 4), gb0 = *(const LAS f32x4*)(CYR + 128 + ch), gb1 = *(const LAS f32x4*)(CYR + 128 + ch + 4);
        const f32x4 uu0 = *(const LAS f32x4*)(CYR + 256 + ch), uu1 = *(const LAS f32x4*)(CYR + 256 + ch + 4), gn0 = *(const LAS f32x4*)(X + ch), gn1 = *(const LAS f32x4*)(X + ch + 4);
        const f32x4 p0 = *(const f32x4*)(g.cw + gch), p1 = *(const f32x4*)(g.cw + gch + 4), q0 = *(const f32x4*)(g.cw + CSTR + gch), q1 = *(const f32x4*)(g.cw + CSTR + gch + 4);
        const f32x4 r0 = *(const f32x4*)(g.cw + 2 * CSTR + gch), r1 = *(const f32x4*)(g.cw + 2 * CSTR + gch + 4), e0 = *(const f32x4*)(g.cb + gch), e1 = *(const f32x4*)(g.cb + gch + 4);
        const f32x4 x0 = p0 * ga0 + q0 * gb0 + r0 * gn0 + e0, x1 = p1 * ga1 + q1 * gb1 + r1 * gn1 + e1;
        const f32x2 y0 = gelu_pk((f32x2){x0[0], x0[1]}), y1 = gelu_pk((f32x2){x0[2], x0[3]}), y2 = gelu_pk((f32x2){x1[0], x1[1]}), y3 = gelu_pk((f32x2){x1[2], x1[3]});
        u32x4 w; w.x = cvt_pk_bf16(y0.x * uu0[0], y0.y * uu0[1]); w.y = cvt_pk_bf16(y1.x * uu0[2], y1.y * uu0[3]); w.z = cvt_pk_bf16(y2.x * uu1[0], y2.y * uu1[1]); w.w = cvt_pk_bf16(y3.x * uu1[2], y3.y * uu1[3]);
        __builtin_nontemporal_store(w, (u32x4*)(g.O + (row0 - 1) * CSTR + gch));
      }
    }
  } else {
    LAS float* mx = (LAS float*)xch;
    LAS float* sm = (LAS float*)(xch + 4096);
    const float* sbase = uni(g.ssp + (size_t)u.pm * BM * 4);
    bf16_t* obase = uni(g.O + (size_t)u.pm * BM * g.ldc + (size_t)u.pn * BM);
    float rs8[8];
    RSTD_BATCH8(rs8, sbase, ROW8);
    __builtin_amdgcn_sched_barrier(0);
#pragma unroll
    for (int ai = 0; ai < 2; ++ai)
#pragma unroll
      for (int m = 0; m < 4; ++m) {
        const int lr = ai * HALF + rl + m * 16;
        const float sc = rs8[ai * 4 + m];
        float mv = -3.0e38f;
#pragma unroll
        for (int bj = 0; bj < 2; ++bj)
#pragma unroll
          for (int n = 0; n < 2; ++n) { f32x4 v = acc[ai][bj][m][n] * sc; acc[ai][bj][m][n] = v; mv = fmaxf(mv, fmaxf(fmaxf(v[0], v[1]), fmaxf(v[2], v[3]))); }
        mv = fmaxf(mv, __shfl_xor(mv, 16)); mv = fmaxf(mv, __shfl_xor(mv, 32));
        if (fq == 0) mx[lr * 4 + wc] = mv;
      }
    asm volatile("s_waitcnt lgkmcnt(0)" ::: "memory"); __builtin_amdgcn_s_barrier(); asm volatile("" ::: "memory");
#pragma unroll
    for (int ai = 0; ai < 2; ++ai)
#pragma unroll
      for (int m = 0; m < 4; ++m) {
        const int lr = ai * HALF + rl + m * 16;
        const f32x4 m4 = *(const LAS f32x4*)(mx + lr * 4);
        const float M = fmaxf(fmaxf(m4.x, m4.y), fmaxf(m4.z, m4.w));
        float s = 0.f;
#pragma unroll
        for (int bj = 0; bj < 2; ++bj)
#pragma unroll
          for (int n = 0; n < 2; ++n) { f32x4 v = acc[ai][bj][m][n];
            v[0] = __builtin_amdgcn_exp2f(v[0] - M); v[1] = __builtin_amdgcn_exp2f(v[1] - M); v[2] = __builtin_amdgcn_exp2f(v[2] - M); v[3] = __builtin_amdgcn_exp2f(v[3] - M);
            acc[ai][bj][m][n] = v; s += (v[0] + v[1]) + (v[2] + v[3]); }
        s += __shfl_xor(s, 16); s += __shfl_xor(s, 32);
        if (fq == 0) sm[lr * 4 + wc] = s;
      }
    asm volatile("s_waitcnt lgkmcnt(0)" ::: "memory"); __builtin_amdgcn_s_barrier(); asm volatile("" ::: "memory");
#pragma unroll
    for (int ai = 0; ai < 2; ++ai)
#pragma unroll
      for (int m = 0; m < 4; ++m) {
        const int lr = ai * HALF + rl + m * 16;
        const f32x4 s4 = *(const LAS f32x4*)(sm + lr * 4);
        const float inv = 1.0f / ((s4.x + s4.y) + (s4.z + s4.w));
        bf16_t* rowp = (bf16_t*)((char*)obase + (unsigned)(lr * g.ldc + cl) * 2u);
#pragma unroll
        for (int bj = 0; bj < 2; ++bj) {
          const f32x4 v0 = acc[ai][bj][m][0] * inv, v1 = acc[ai][bj][m][1] * inv;
          u32x4 w; w.x = cvt_pk_bf16(v0[0], v0[1]); w.y = cvt_pk_bf16(v0[2], v0[3]); w.z = cvt_pk_bf16(v1[0], v1[1]); w.w = cvt_pk_bf16(v1[2], v1[3]);
          __builtin_nontemporal_store(w, (u32x4*)(rowp + bj * HALF));
        }
      }
  }
}

template <int EPI>
__device__ __forceinline__ void gemm_phase(LAS unsigned char* lds, const Job& g, int G, int c) {
  int tid = threadIdx.x; asm volatile("" : "+v"(tid));
  const int wid = __builtin_amdgcn_readfirstlane(tid >> 6), lane = tid & 63, wr = wid >> 2, wc = wid & 3, fr = lane & 15, fq = lane >> 4;
  const int nt = g.K / BK;
  int c_ = c; asm volatile("" : "+s"(c_));
  StaticOrder S; S.init(g.nM, g.nN, G, c_, g.chain);
  unsigned voffA, voffB;
  { int R, C; stage_rc(tid * 16, R, C); const int Rb = (R & ~31) + perm32(R & 31); voffA = (unsigned)(R * g.lda + C) * 2u; voffB = (unsigned)(Rb * g.ldb + C) * 2u; }
  const size_t rsA = (size_t)64 * g.lda * 2, rsB = (size_t)64 * g.ldb * 2, hA = 2 * rsA, hB = 2 * rsB;
  const size_t kstep = (size_t)(BK * 2);
  const unsigned ldsw = (unsigned)wid * 1024u;
  const int aoff = lds_byte(wr * 64 + fr, fq * 8), boff = lds_byte(wc * 32 + fr, fq * 8);
#define PG8_SA(b, h) (((b) * 2 + (h)) * HTB)
#define PG8_SB(b, h) ((4 + (b) * 2 + (h)) * HTB)
#define PG8_STAGE(bufoff, gbase, voff, rs) do { _Pragma("unroll") for (int _i = 0; _i < 2; ++_i) \
        __builtin_amdgcn_global_load_lds((const unsigned*)((const char*)(gbase) + (size_t)_i * (rs) + (voff)), (LAS unsigned*)(lds + (bufoff) + ldsw + _i * 8192), 16, 0, 0); } while (0)
#define PG8_LDA(dst, b, h) do { _Pragma("unroll") for (int m = 0; m < 4; ++m) _Pragma("unroll") for (int k = 0; k < 2; ++k) dst[m][k] = *(const LAS bf16x8*)(lds + PG8_SA(b, h) + aoff + m * 2048 + k * 1024); } while (0)
#define PG8_LDB(dst, b, h) do { _Pragma("unroll") for (int n = 0; n < 2; ++n) _Pragma("unroll") for (int k = 0; k < 2; ++k) dst[n][k] = *(const LAS bf16x8*)(lds + PG8_SB(b, h) + boff + n * 2048 + k * 1024); } while (0)
#define PG8_MMA(ai, bj, At, Bt) do { __builtin_amdgcn_s_setprio(1); _Pragma("unroll") for (int m = 0; m < 4; ++m) _Pragma("unroll") for (int n = 0; n < 2; ++n) _Pragma("unroll") for (int k = 0; k < 2; ++k) \
        acc[ai][bj][m][n] = __builtin_amdgcn_mfma_f32_16x16x32_bf16(Bt[n][k], At[m][k], acc[ai][bj][m][n], 0, 0, 0); __builtin_amdgcn_s_setprio(0); } while (0)
#define PG8_WAIT_V(n) asm volatile("s_waitcnt vmcnt(" #n ")" ::: "memory")
#define PG8_WAIT_L(n) asm volatile("s_waitcnt lgkmcnt(" #n ")" ::: "memory")
#define PG8_BAR __builtin_amdgcn_s_barrier()
#define PG8_SCHED __builtin_amdgcn_sched_barrier(0)
  Unit cur, nxt; int ui = 0;
  if (!S.next(0, cur)) return;
  const char* gA = uni((const char*)g.A); const char* gB = uni((const char*)g.Bt);
  f32x4 acc[2][2][4][2];
#pragma unroll
  for (int a = 0; a < 2; ++a)
#pragma unroll
    for (int b = 0; b < 2; ++b)
#pragma unroll
      for (int m = 0; m < 4; ++m)
#pragma unroll
        for (int n = 0; n < 2; ++n) acc[a][b][m][n] = (f32x4){0.f, 0.f, 0.f, 0.f};
  bf16x8 At[4][2], B0[2][2], B1[2][2];
  const char* cA = uni(gA + job_aoff(g, cur) * 2); const char* cB = uni(gB + job_boff(g, cur) * 2);
  PG8_STAGE(PG8_SB(0, 0), cB, voffB, rsB); PG8_STAGE(PG8_SB(0, 1), cB + hB, voffB, rsB); PG8_STAGE(PG8_SA(0, 0), cA, voffA, rsA); PG8_STAGE(PG8_SA(0, 1), cA + hA, voffA, rsA);
  if (wr == 1) PG8_BAR;
  PG8_WAIT_V(2); PG8_BAR;
  PG8_STAGE(PG8_SB(1, 0), cB + kstep, voffB, rsB); PG8_STAGE(PG8_SA(1, 0), cA + kstep, voffA, rsA); PG8_STAGE(PG8_SB(1, 1), cB + hB + kstep, voffB, rsB);
  PG8_WAIT_V(6); PG8_BAR;
  for (;;) {
    const bool has_next = S.next(ui + 1, nxt);
    const char* nA = has_next ? uni(gA + job_aoff(g, nxt) * 2) : cA; const char* nB = has_next ? uni(gB + job_boff(g, nxt) * 2) : cB;
    for (int t = 0; t < nt; t += 2) {
      const bool last = (t == nt - 2);
      const char* a1 = cA + (size_t)(t + 1) * kstep;
      const char* a2 = last ? nA : cA + (size_t)(t + 2) * kstep; const char* b2 = last ? nB : cB + (size_t)(t + 2) * kstep;
      const char* a3 = a2 + kstep; const char* b3 = b2 + kstep;
      PG8_LDB(B0, 0, 0); PG8_LDB(B1, 0, 1); PG8_SCHED; PG8_LDA(At, 0, 0); PG8_STAGE(PG8_SA(1, 1), a1 + hA, voffA, rsA);
      PG8_WAIT_V(8); PG8_WAIT_L(0); PG8_BAR; PG8_MMA(0, 0, At, B0); PG8_MMA(0, 1, At, B1); PG8_BAR; PG8_SCHED;
      PG8_LDA(At, 0, 1); PG8_STAGE(PG8_SB(0, 0), b2, voffB, rsB); PG8_STAGE(PG8_SB(0, 1), b2 + hB, voffB, rsB); PG8_STAGE(PG8_SA(0, 0), a2, voffA, rsA);
      PG8_WAIT_V(8); PG8_WAIT_L(0); PG8_BAR; PG8_MMA(1, 0, At, B0); PG8_MMA(1, 1, At, B1); PG8_BAR; PG8_SCHED;
      PG8_LDB(B0, 1, 0); PG8_LDB(B1, 1, 1); PG8_SCHED; PG8_LDA(At, 1, 0); PG8_STAGE(PG8_SA(0, 1), a2 + hA, voffA, rsA);
      PG8_WAIT_V(8); PG8_WAIT_L(0); PG8_BAR; PG8_MMA(0, 0, At, B0); PG8_MMA(0, 1, At, B1); PG8_BAR; PG8_SCHED;
      PG8_LDA(At, 1, 1); PG8_STAGE(PG8_SB(1, 0), b3, voffB, rsB); PG8_STAGE(PG8_SB(1, 1), b3 + hB, voffB, rsB); PG8_STAGE(PG8_SA(1, 0), a3, voffA, rsA);
      PG8_WAIT_V(8); PG8_WAIT_L(0); PG8_BAR; PG8_MMA(1, 0, At, B0); PG8_MMA(1, 1, At, B1); PG8_BAR; PG8_SCHED;
    }
    if (wr == 0) PG8_BAR;
    { int e_fr = fr, e_fq = fq; asm volatile("" : "+v"(e_fr), "+v"(e_fq));
      epilogue<EPI>(acc, g, cur, wr, wc, e_fr, e_fq, lds + XCH_OFF); }
    if (!has_next) break;
#pragma unroll
    for (int a = 0; a < 2; ++a)
#pragma unroll
      for (int b = 0; b < 2; ++b)
#pragma unroll
        for (int m = 0; m < 4; ++m)
#pragma unroll
          for (int n = 0; n < 2; ++n) acc[a][b][m][n] = (f32x4){0.f, 0.f, 0.f, 0.f};
    cur = nxt; cA = nA; cB = nB; ++ui;
    if (wr == 1) PG8_BAR;
  }
  PG8_WAIT_V(0);
  PG8_BAR;
#undef PG8_SA
#undef PG8_SB
#undef PG8_STAGE
#undef PG8_LDA
#undef PG8_LDB
#undef PG8_MMA
#undef PG8_WAIT_V
#undef PG8_WAIT_L
#undef PG8_BAR
#undef PG8_SCHED
}

__device__ __forceinline__ void transpose_item(const float* W, int ldw, int col0, int K, int N, bf16_t* WT, const float* gain, float cs, LAS float* scr, int item, int lane, int permup) {
  const int nblk = N / 32, kb = item / nblk, nb = item % nblk, k0 = 64 * kb, n0 = 32 * nb;
#pragma unroll
  for (int i = 0; i < 8; ++i) { const int kk = 8 * i + (lane >> 3), nn = (lane & 7) * 4; const float gv = gain ? gain[k0 + kk] * cs : cs;
    const f32x4 v = *(const f32x4*)(W + (size_t)(k0 + kk) * ldw + col0 + n0 + nn);
    LAS float* d = scr + kk * 33 + nn; d[0] = v.x * gv; d[1] = v.y * gv; d[2] = v.z * gv; d[3] = v.w * gv; }
  asm volatile("s_waitcnt lgkmcnt(0)" ::: "memory");
  const int c = lane & 7;
#pragma unroll
  for (int j = 0; j < 4; ++j) { const int n = (lane >> 3) + 8 * j; const LAS float* s = scr + (8 * c) * 33 + n;
    u32x4 o; o.x = cvt_pk_bf16(s[0 * 33], s[1 * 33]); o.y = cvt_pk_bf16(s[2 * 33], s[3 * 33]); o.z = cvt_pk_bf16(s[4 * 33], s[5 * 33]); o.w = cvt_pk_bf16(s[6 * 33], s[7 * 33]);
    const int nn = n0 + n; const int nr = (permup == 1) ? (((nn & 2047) >> 7) * 256 + (nn >> 11) * 128 + (nn & 127)) : (permup == 2) ? (((nn & 1023) >> 7) * 256 + (nn >> 10) * 128 + (nn & 127)) : nn;
    *(u32x4*)(WT + (size_t)nr * K + k0 + 8 * c) = o; }
  asm volatile("s_waitcnt lgkmcnt(0)" ::: "memory");
}
struct TrDesc { const float* W; int ldw, col0, K, N; bf16_t* WT; const float* gain; float cs; int nitems; int permup; };
__device__ __forceinline__ TrDesc tr_desc(bf16_t* wb, int d) {
  TrDesc t; t.cs = 1.0f; t.gain = nullptr; t.col0 = 0; t.permup = 0;
  if (d < 8) {
    const int j = d >> 2, w = d & 3; bf16_t* e = wb + W_EVEN + (size_t)j * W_EVEN_SZ;
    if (w < 3) { t.W = kin(4) + (size_t)j * DM * 2048; t.ldw = 2048; t.col0 = 512 + 512 * w; t.K = DM; t.N = 512; t.gain = kin(3) + (size_t)(2 * j) * DM;
      t.WT = (w == 0) ? e + (size_t)1024 * DM : (w == 1) ? e + (size_t)1536 * DM : e + (size_t)512 * DM;
      if (w == 0) t.cs = 0.08838834764831845f * LOG2E; }
    else { t.W = kin(6) + (size_t)j * DM * DM; t.ldw = DM; t.K = DM; t.N = DM; t.WT = e + (size_t)2048 * DM; }
  } else if (d < 14) {
    const int j = (d - 8) / 3, w = (d - 8) % 3; bf16_t* o = wb + W_ODD + (size_t)j * W_ODD_SZ;
    if (w == 0) { t.W = kin(7) + (size_t)j * DM * 3072; t.ldw = 3072; t.K = DM; t.N = 1024; t.gain = kin(3) + (size_t)(2 * j + 1) * DM; t.WT = o; }
    else if (w == 2) { t.W = kin(7) + (size_t)j * DM * 3072; t.ldw = 3072; t.col0 = 1024; t.K = DM; t.N = 2048; t.gain = kin(3) + (size_t)(2 * j + 1) * DM; t.WT = o + (size_t)1024 * DM; t.permup = 2; }
    else { t.W = kin(9) + (size_t)j * DM * DM; t.ldw = DM; t.K = DM; t.N = DM; t.WT = o + (size_t)3072 * DM; }
  } else {
    const int l = (d - 14) >> 2, w = (d - 14) & 3; bf16_t* y = wb + W_LAY + (size_t)l * W_LAY_SZ;
    if (w == 0) { t.W = kin(12) + (size_t)l * DM * 2048; t.ldw = 2048; t.K = DM; t.N = 2048; t.WT = y + (size_t)1024 * DM; }
    else if (w == 1) { t.W = kin(13) + (size_t)l * DM * DM; t.ldw = DM; t.K = DM; t.N = DM; t.WT = y + (size_t)3072 * DM; }
    else if (w == 2) { t.W = kin(15) + (size_t)l * DM * 4096; t.ldw = 4096; t.K = DM; t.N = 4096; t.gain = kin(14) + (size_t)l * DM; t.WT = y + (size_t)4096 * DM; t.permup = 1; }
    else { t.W = kin(18) + (size_t)l * DFF * DM; t.ldw = DM; t.K = DFF; t.N = DM; t.WT = y + (size_t)8192 * DM; }
  }
  t.nitems = (t.K / 64) * (t.N / 32);
  return t;
}

__device__ __forceinline__ void prologue(LAS unsigned char* lds) {
  int tid_ = threadIdx.x; asm volatile("" : "+v"(tid_));
  const int lane = tid_ & 63, wave = __builtin_amdgcn_readfirstlane(tid_ >> 6), gwave = (int)blockIdx.x * 8 + wave, ngw = (int)gridDim.x * 8;
  unsigned char* ws = kws();
  bf16_t* wb = (bf16_t*)(ws + WS_W);
  LAS float* scr = (LAS float*)(lds + wave * 16384);
  for (int d = 0; d < 30; ++d) {
    const TrDesc t = tr_desc(wb, d);
    for (int it = (gwave + d * 293) % ngw; it < t.nitems; it += ngw) transpose_item(t.W, t.ldw, t.col0, t.K, t.N, t.WT, t.gain, t.cs, scr, it, lane, t.permup);
  }
  {
    const size_t n4 = (size_t)DEPTH * DM * DM / 4;
    for (size_t i = (size_t)gwave * 64 + lane; i < n4; i += (size_t)ngw * 64) {
      const size_t e = i * 4; const int l = (int)(e / ((size_t)DM * DM)); const size_t r = e % ((size_t)DM * DM); const int k = (int)(r / DM);
      const f32x4 v = *(const f32x4*)(kin(11) + e); const float gv = kin(10)[l * DM + k] * (0.0625f * LOG2E);
      u32x2 w; w.x = cvt_pk_bf16(v[0] * gv, v[1] * gv); w.y = cvt_pk_bf16(v[2] * gv, v[3] * gv);
      *(u32x2*)(wb + W_LAY + (size_t)l * W_LAY_SZ + r) = w;
    }
  }
  LAS float* T = (LAS float*)(lds + RING_BYTES - 16384);
  __syncthreads();
  LAS float* T128 = (LAS float*)(lds + XCH_OFF);
  for (int i = tid_; i < 4096; i += 512) T[i] = cospif((float)i * (1.0f / 2048.0f));
  if (tid_ < 128) T128[tid_] = cospif((float)tid_ * (1.0f / 64.0f));
  __syncthreads();
  {
    bf16_t* F = (bf16_t*)(ws + WS_FCAT);
    const size_t nchunk = (size_t)4096 * 8192 / 8;
    for (size_t ci = (size_t)gwave * 64 + lane; ci < nchunk; ci += (size_t)ngw * 64) {
      const int s = (int)(ci >> 10), k0 = (int)(ci & 1023) * 8;
      float v[8];
#pragma unroll
      for (int j = 0; j < 8; ++j) { const int k = k0 + j; const int sr = s & 2047; const int idx = (k < 4096) ? ((sr * k) & 4095) : ((sr * (k - 4096) + ((s < 2048) ? 1024 : 3072)) & 4095); v[j] = T[idx]; }
      u32x4 w; w.x = cvt_pk_bf16(v[0], v[1]); w.y = cvt_pk_bf16(v[2], v[3]); w.z = cvt_pk_bf16(v[4], v[5]); w.w = cvt_pk_bf16(v[6], v[7]);
      *(u32x4*)(F + ci * 8) = w;
    }
  }
  for (int it = gwave; it < 2 * 1024 * 4; it += ngw) {
    const int j = it >> 12, k = (it >> 2) & 1023, gq = it & 3;
    const float* wrow = kin(4) + ((size_t)j * DM + k) * 2048 + gq * 128;
    const float gv = kin(3)[(2 * j) * DM + k];
    const float w0 = wrow[lane] * gv, w1 = wrow[64 + lane] * gv;
    float ac0 = 0.f, ac1 = 0.f, as0 = 0.f;
#pragma unroll 8
    for (int c = 0; c < 128; ++c) {
      const float wv = (c < 64) ? __shfl(w0, c) : __shfl(w1, c - 64);
      const int i0 = (c * lane) & 127, i1 = (c * (lane + 64)) & 127;
      ac0 += wv * T128[i0]; as0 += wv * T128[(i0 + 96) & 127];
      ac1 += wv * T128[i1];
    }
    bf16_t* e = wb + W_EVEN + (size_t)j * W_EVEN_SZ;
    e[(size_t)(gq * 64 + lane) * DM + k] = (bf16_t)(cvt_pk_bf16(ac0, 0.f) & 0xffff);
    if (lane == 0) e[(size_t)(256 + gq) * DM + k] = (bf16_t)(cvt_pk_bf16(ac1, 0.f) & 0xffff);
    else e[(size_t)(260 + gq * 63 + lane - 1) * DM + k] = (bf16_t)(cvt_pk_bf16(as0, 0.f) & 0xffff);
  }
  for (int r = gwave; r < NB * NMEM; r += ngw) {
    const f32x4* xr = (const f32x4*)(kin(1) + (size_t)r * DM) + lane; f32x4 v[4]; float s = 0.f;
#pragma unroll
    for (int j = 0; j < 4; ++j) { v[j] = xr[64 * j]; s += (v[j].x * v[j].x + v[j].y * v[j].y) + (v[j].z * v[j].z + v[j].w * v[j].w); }
    const float rs = rsqrtf(wave_sum(s) * (1.0f / DM) + EPS);
    u32x2* o = (u32x2*)((bf16_t*)(ws + WS_MB) + (size_t)r * DM) + lane;
#pragma unroll
    for (int j = 0; j < 4; ++j) { const f32x4 gg = *((const f32x4*)kin(2) + lane + 64 * j);
      u32x2 w; w.x = cvt_pk_bf16(v[j].x * rs * gg.x, v[j].y * rs * gg.y); w.y = cvt_pk_bf16(v[j].z * rs * gg.z, v[j].w * rs * gg.w); o[64 * j] = w; }
  }
  {
    const float* xin = kin(0); bf16_t* hbp = (bf16_t*)(ws + WS_HB); float* sspp = (float*)(ws + WS_SSP);
    for (int r = gwave; r < NTOK; r += 4 * ngw) {
      f32x4 v[4][4];
#pragma unroll
      for (int q = 0; q < 4; ++q) { const int rq = min(r + q * ngw, NTOK - 1); const f32x4* xr = (const f32x4*)(xin + (size_t)rq * DM) + lane;
#pragma unroll
        for (int j = 0; j < 4; ++j) v[q][j] = xr[64 * j]; }
#pragma unroll
      for (int q = 0; q < 4; ++q) { float sq = 0.f;
#pragma unroll
        for (int j = 0; j < 4; ++j) sq += (v[q][j].x * v[q][j].x + v[q][j].y * v[q][j].y) + (v[q][j].z * v[q][j].z + v[q][j].w * v[q][j].w);
        sq = wave_sum(sq);
        if (r + q * ngw >= NTOK) continue;
        u32x2* o = (u32x2*)(hbp + (size_t)(r + q * ngw) * DM) + lane;
#pragma unroll
        for (int j = 0; j < 4; ++j) { u32x2 w; w.x = cvt_pk_bf16(v[q][j].x, v[q][j].y); w.y = cvt_pk_bf16(v[q][j].z, v[q][j].w); o[64 * j] = w; }
        if (lane == 0) *(f32x4*)(sspp + (size_t)(r + q * ngw) * 4) = (f32x4){sq, 0.f, 0.f, 0.f}; }
    }
  }
}

__device__ __forceinline__ void natten_phase(const bf16_t* QK, const bf16_t* VT, bf16_t* Y, const float* rpb, LAS float* rpbs) {
  int tid_ = threadIdx.x; asm volatile("" : "+v"(tid_));
  const int lane = tid_ & 63, wave = __builtin_amdgcn_readfirstlane(tid_ >> 6);
  for (int i = tid_; i < 4 * 15 * 31; i += 512) rpbs[i] = rpb[i] * LOG2E;
  __syncthreads();
  const int n = lane & 15, g = lane >> 4;
  const int keyl = 8 * (n >> 2) + (n & 3);
  for (int slot = (int)blockIdx.x; slot < 256; slot += (int)gridDim.x)
  for (int it = 0; it < 4; ++it) {
    const int u = (slot * 4 + it) * 8 + wave;
    const int jb = u & 3, ip = (u >> 2) & 31, h = (u >> 7) & 3, b = u >> 9;
    const int i0 = 2 * ip;
    const int rs0 = min(max(i0 - 4, 0), 56), d1 = min(max(i0 - 3, 0), 56) - rs0;
    const int c0 = (jb == 0) ? 0 : (jb == 1) ? 8 : (jb == 2) ? 24 : 32;
    const int j = jb * 16 + n; const int cs = min(max(j - 8, 0), 48);
    const size_t tq = (size_t)b * SEQ + i0 * 64 + j;
    bf16x8 qf[2][4];
#pragma unroll
    for (int q = 0; q < 2; ++q)
#pragma unroll
      for (int ks = 0; ks < 4; ++ks) qf[q][ks] = *(const bf16x8*)(QK + (tq + q * 64) * 1024 + h * 128 + ks * 32 + 8 * g);
    f32x4 sc[2][9][2];
#pragma unroll
    for (int ur = 0; ur < 9; ++ur) {
      const int krow = min(rs0 + ur, 63);
      const size_t tk0 = (size_t)b * SEQ + (size_t)krow * 64 + c0;
      bf16x8 kf[2][4];
#pragma unroll
      for (int t = 0; t < 2; ++t) {
        const bf16_t* kp = QK + (tk0 + keyl + 4 * t) * 1024 + 512 + h * 128 + 8 * g;
#pragma unroll
        for (int ks = 0; ks < 4; ++ks) kf[t][ks] = *(const bf16x8*)(kp + ks * 32);
      }
      __builtin_amdgcn_sched_barrier(0);
#pragma unroll
      for (int t = 0; t < 2; ++t) {
        f32x4 a0 = (f32x4){0.f, 0.f, 0.f, 0.f}, a1 = a0;
#pragma unroll
        for (int ks = 0; ks < 4; ++ks) { a0 = __builtin_amdgcn_mfma_f32_16x16x32_bf16(kf[t][ks], qf[0][ks], a0, 0, 0, 0); a1 = __builtin_amdgcn_mfma_f32_16x16x32_bf16(kf[t][ks], qf[1][ks], a1, 0, 0, 0); }
        sc[0][ur][t] = a0; sc[1][ur][t] = a1;
      }
      __builtin_amdgcn_sched_barrier(0);
    }
    float inv[2];
#pragma unroll
    for (int q = 0; q < 2; ++q) {
      const int dq = q ? d1 : 0, iq = i0 + q;
      float mx = -3.0e38f;
#pragma unroll
      for (int ur = 0; ur < 9; ++ur) {
        const bool rowv = (unsigned)(ur - dq) < 8u;
        const LAS float* brow = rpbs + h * 465 + min(max(rs0 + ur - iq + 7, 0), 14) * 31;
#pragma unroll
        for (int t = 0; t < 2; ++t)
#pragma unroll
          for (int v = 0; v < 4; ++v) {
            const int kc = c0 + 8 * g + 4 * t + v;
            const bool valid = rowv && (kc >= cs) && (kc < cs + 16);
            const int co = min(max(kc - j + 15, 0), 30);
            const float s = valid ? sc[q][ur][t][v] + brow[co] : -3.0e38f;
            sc[q][ur][t][v] = s; mx = fmaxf(mx, s);
          }
      }
      mx = fmaxf(mx, __shfl_xor(mx, 16)); mx = fmaxf(mx, __shfl_xor(mx, 32));
      float sum = 0.f;
#pragma unroll
      for (int ur = 0; ur < 9; ++ur)
#pragma unroll
        for (int t = 0; t < 2; ++t)
#pragma unroll
          for (int v = 0; v < 4; ++v) { const float e = __builtin_amdgcn_exp2f(sc[q][ur][t][v] - mx); sc[q][ur][t][v] = e; sum += e; }
      sum += __shfl_xor(sum, 16); sum += __shfl_xor(sum, 32);
      inv[q] = 1.0f / sum;
    }
    f32x4 o[2][8];
#pragma unroll
    for (int q = 0; q < 2; ++q)
#pragma unroll
      for (int dt = 0; dt < 8; ++dt) o[q][dt] = (f32x4){0.f, 0.f, 0.f, 0.f};
    bf16x8 pf[2][9];
#pragma unroll
    for (int ur = 0; ur < 9; ++ur)
#pragma unroll
      for (int q = 0; q < 2; ++q) { u32x4 pw; pw.x = cvt_pk_bf16(sc[q][ur][0][0], sc[q][ur][0][1]); pw.y = cvt_pk_bf16(sc[q][ur][0][2], sc[q][ur][0][3]); pw.z = cvt_pk_bf16(sc[q][ur][1][0], sc[q][ur][1][1]); pw.w = cvt_pk_bf16(sc[q][ur][1][2], sc[q][ur][1][3]);
        pf[q][ur] = __builtin_bit_cast(bf16x8, pw); }
    bf16x8 vf[2][8];
    { const bf16_t* vp = VT + (size_t)(h * 128 + n) * NTOK + (size_t)b * SEQ + (size_t)min(rs0, 63) * 64 + c0 + 8 * g;
#pragma unroll
      for (int dt = 0; dt < 8; ++dt) vf[0][dt] = *(const bf16x8*)(vp + (size_t)dt * 16 * NTOK); }
#pragma unroll
    for (int ur = 0; ur < 9; ++ur) {
      if (ur + 1 < 9) { const bf16_t* vp = VT + (size_t)(h * 128 + n) * NTOK + (size_t)b * SEQ + (size_t)min(rs0 + ur + 1, 63) * 64 + c0 + 8 * g;
#pragma unroll
        for (int dt = 0; dt < 8; ++dt) vf[(ur + 1) & 1][dt] = *(const bf16x8*)(vp + (size_t)dt * 16 * NTOK); }
      __builtin_amdgcn_sched_barrier(0);
#pragma unroll
      for (int dt = 0; dt < 8; ++dt) { o[0][dt] = __builtin_amdgcn_mfma_f32_16x16x32_bf16(vf[ur & 1][dt], pf[0][ur], o[0][dt], 0, 0, 0); o[1][dt] = __builtin_amdgcn_mfma_f32_16x16x32_bf16(vf[ur & 1][dt], pf[1][ur], o[1][dt], 0, 0, 0); }
      __builtin_amdgcn_sched_barrier(0);
    }
#pragma unroll
    for (int q = 0; q < 2; ++q) {
      bf16_t* yp = Y + (tq + q * 64) * 1024 + 512 + h * 128 + 4 * g;
#pragma unroll
      for (int dt = 0; dt < 8; ++dt) { u32x2 w; w.x = cvt_pk_bf16(o[q][dt][0] * inv[q], o[q][dt][1] * inv[q]); w.y = cvt_pk_bf16(o[q][dt][2] * inv[q], o[q][dt][3] * inv[q]); *(u32x2*)(yp + dt * 16) = w; }
    }
  }
}

__device__ __forceinline__ void dft_mid_row(const bf16_t* DT, bf16_t* Y, float scale) {
  int tid_ = threadIdx.x; asm volatile("" : "+v"(tid_));
  const int lane = tid_ & 63, gwave = (int)blockIdx.x * 8 + (tid_ >> 6), ngw = (int)gridDim.x * 8;
  for (int it = gwave; it < NB * 512; it += ngw) {
    const bf16_t* row = DT + (size_t)it * 8192;
    float s = 0.f;
#pragma unroll
    for (int i = 0; i < 8; ++i) { float f[8]; unpack8(*(const u32x4*)(row + (i * 64 + lane) * 8), f); s += (f[0] - f[1]) + (f[2] - f[3]) + (f[4] - f[5]) + (f[6] - f[7]); }
    s = wave_sum(s);
    if (lane == 0) { const int b = it >> 9, r = it & 511, c = 128 * ((r >> 6) & 3) + 64 * (r >> 8) + (r & 63); Y[((size_t)b * SEQ + 2048) * DM + c] = (bf16_t)(cvt_pk_bf16(s * scale, 0.f) & 0xffffu); }
  }
}
__device__ __forceinline__ void ffn_conv_phase(bf16_t* Z, const float* cw, const float* cb) {
  constexpr int R = 32;
  int tid_ = threadIdx.x; asm volatile("" : "+v"(tid_));
  const int gthread = (int)blockIdx.x * 512 + tid_, nthreads = (int)gridDim.x * 512;
  for (int item = gthread; item < (NTOK / R) * 256; item += nthreads) {
    const int cgp = item & 255, run = item >> 8, c = cgp * 8;
    float w0[8], w1[8], w2[8], bb[8];
#pragma unroll
    for (int j = 0; j < 8; ++j) { w0[j] = cw[c + j]; w1[j] = cw[DFF + c + j]; w2[j] = cw[2 * DFF + c + j]; bb[j] = cb[c + j]; }
    const size_t t0 = (size_t)run * R; const int s0 = (int)(t0 & (SEQ - 1));
    bf16_t* zp = Z + t0 * 4096 + c;
    float prev[8], cur[8], nxt[8];
    if (s0 == 0) {
#pragma unroll
      for (int j = 0; j < 8; ++j) prev[j] = 0.f;
    } else unpack8(*(const u32x4*)(zp - 4096 + DFF), prev);
    unpack8(*(const u32x4*)(zp + DFF), cur);
#pragma unroll 4
    for (int r = 0; r < R; ++r) {
      if (s0 + r + 1 < SEQ) unpack8(*(const u32x4*)(zp + (size_t)(r + 1) * 4096 + DFF), nxt);
      else {
#pragma unroll
        for (int j = 0; j < 8; ++j) nxt[j] = 0.f;
      }
      float uu[8]; unpack8(*(const u32x4*)(zp + (size_t)r * 4096), uu);
      float a[8];
#pragma unroll
      for (int j = 0; j < 8; j += 2) {
        f32x2 gv; gv.x = w0[j] * prev[j] + w1[j] * cur[j] + w2[j] * nxt[j] + bb[j]; gv.y = w0[j + 1] * prev[j + 1] + w1[j + 1] * cur[j + 1] + w2[j + 1] * nxt[j + 1] + bb[j + 1];
        const f32x2 ge = gelu_pk(gv); a[j] = ge.x * uu[j]; a[j + 1] = ge.y * uu[j + 1];
      }
      u32x4 w; w.x = cvt_pk_bf16(a[0], a[1]); w.y = cvt_pk_bf16(a[2], a[3]); w.z = cvt_pk_bf16(a[4], a[5]); w.w = cvt_pk_bf16(a[6], a[7]);
      *(u32x4*)(zp + (size_t)r * 4096) = w;
#pragma unroll
      for (int j = 0; j < 8; ++j) { prev[j] = cur[j]; cur[j] = nxt[j]; }
    }
  }
}
__device__ __forceinline__ void gconv_phase(const bf16_t* ZC, bf16_t* Y, const float* cw) {
  constexpr int R = 32;
  int tid_ = threadIdx.x; asm volatile("" : "+v"(tid_));
  const int gthread = (int)blockIdx.x * 512 + tid_, nthreads = (int)gridDim.x * 512;
  for (int item = gthread; item < (NTOK / R) * 128; item += nthreads) {
    const int cgp = item & 127, run = item >> 7, c = cgp * 8;
    float w0[8], w1[8], w2[8];
#pragma unroll
    for (int j = 0; j < 8; ++j) { w0[j] = cw[c + j]; w1[j] = cw[DM + c + j]; w2[j] = cw[2 * DM + c + j]; }
    const size_t t0 = (size_t)run * R; const int s0 = (int)(t0 & (SEQ - 1));
    const bf16_t* zp = ZC + t0 * 3072 + c;
    float prev[8], cur[8], nxt[8], ta[8], tb[8];
    if (s0 == 0) {
#pragma unroll
      for (int j = 0; j < 8; ++j) prev[j] = 0.f;
    } else { unpack8(*(const u32x4*)(zp - 3072 + 1024), ta); unpack8(*(const u32x4*)(zp - 3072 + 2048), tb);
#pragma unroll
      for (int j = 0; j < 8; ++j) prev[j] = ta[j] * tb[j]; }
    unpack8(*(const u32x4*)(zp + 1024), ta); unpack8(*(const u32x4*)(zp + 2048), tb);
#pragma unroll
    for (int j = 0; j < 8; ++j) cur[j] = ta[j] * tb[j];
#pragma unroll 4
    for (int r = 0; r < R; ++r) {
      if (s0 + r + 1 < SEQ) { unpack8(*(const u32x4*)(zp + (size_t)(r + 1) * 3072 + 1024), ta); unpack8(*(const u32x4*)(zp + (size_t)(r + 1) * 3072 + 2048), tb);
#pragma unroll
        for (int j = 0; j < 8; ++j) nxt[j] = ta[j] * tb[j]; }
      else {
#pragma unroll
        for (int j = 0; j < 8; ++j) nxt[j] = 0.f;
      }
      float gb[8]; unpack8(*(const u32x4*)(zp + (size_t)r * 3072), gb);
      float a[8];
#pragma unroll
      for (int j = 0; j < 8; ++j) a[j] = gb[j] * (w0[j] * prev[j] + w1[j] * cur[j] + w2[j] * nxt[j]);
      u32x4 w; w.x = cvt_pk_bf16(a[0], a[1]); w.y = cvt_pk_bf16(a[2], a[3]); w.z = cvt_pk_bf16(a[4], a[5]); w.w = cvt_pk_bf16(a[6], a[7]);
      *(u32x4*)(Y + (t0 + r) * 1024 + c) = w;
#pragma unroll
      for (int j = 0; j < 8; ++j) { prev[j] = cur[j]; cur[j] = nxt[j]; }
    }
  }
}

#define XB_TMO      128
#define XB_XCNT(j)  (256  + 64 * (j))
#define XB_XSUB(j)  (1280 + 64 * (j))
#define XB_XGEN(j)  (2304 + 64 * (j))
#define XB_TOP      3328
#define XB_TOPGEN   3392
#define XCD_BAR_WORDS 3456
#define XB_SPIN_CAP (1u << 18)
__device__ __forceinline__ unsigned xb_ld(unsigned* p)              { return __hip_atomic_load(p, __ATOMIC_RELAXED, __HIP_MEMORY_SCOPE_AGENT); }
__device__ __forceinline__ unsigned xb_add(unsigned* p, unsigned v) { return __hip_atomic_fetch_add(p, v, __ATOMIC_RELAXED, __HIP_MEMORY_SCOPE_AGENT); }
__device__ __forceinline__ unsigned xb_xcc_id() { return (unsigned)__builtin_amdgcn_s_getreg((3 << 11) | 20) & 0xFu; }
#define XB_SPIN(cond, bar) do { unsigned _sp = 0; while (cond) { __builtin_amdgcn_s_sleep(1); \
    if ((++_sp & 255u) == 0u) { if (xb_ld(&(bar)[XB_TMO])) break; if (_sp > XB_SPIN_CAP) { atomicAdd(&(bar)[XB_TMO], 1u); break; } } } } while (0)
__device__ __forceinline__ void xcd_barrier_complete(unsigned* bar, unsigned x, unsigned& nloc, unsigned& nx) {
  const unsigned G = gridDim.x * gridDim.y * gridDim.z;
  unsigned sum, cnt, mine, sp = 0u;
  for (;;) {
    sum = 0u; cnt = 0u; mine = 0u;
#pragma unroll
    for (unsigned j = 0; j < 16; ++j) { const unsigned c = xb_ld(&bar[XB_XCNT(j)]); sum += c; cnt += (c > 0u) ? 1u : 0u; mine = (j == x) ? c : mine; }
    if (sum == G) break;
    __builtin_amdgcn_s_sleep(1);
    if ((++sp & 255u) == 0u) { if (xb_ld(&bar[XB_TMO])) break; if (sp > XB_SPIN_CAP) { atomicAdd(&bar[XB_TMO], 1u); break; } }
  }
  nloc = mine > 0u ? mine : 1u; nx = cnt > 0u ? cnt : 1u;
}
__device__ __forceinline__ void xcd_barrier(volatile LAS unsigned* st) {
  asm volatile("s_waitcnt vmcnt(0)" ::: "memory");
  __syncthreads();
  if (threadIdx.x == 0) {
    unsigned* bar = (unsigned*)kws();
    const unsigned x = xb_xcc_id();
    __builtin_amdgcn_s_waitcnt(0);
    unsigned nloc = st[0], nx = st[1];
    if (nloc == 0u) { xcd_barrier_complete(bar, x, nloc, nx); st[0] = nloc; st[1] = nx; }
    const unsigned old = xb_add(&bar[XB_XSUB(x)], 1u);
    const unsigned gen = old / nloc;
    if (old + 1u == (gen + 1u) * nloc) {
      __builtin_amdgcn_fence(__ATOMIC_RELEASE, "agent");
      asm volatile("s_waitcnt vmcnt(0)" ::: "memory");
      const unsigned og = xb_add(&bar[XB_TOP], 1u);
      const unsigned tg = og / nx;
      if (og + 1u == (tg + 1u) * nx) xb_add(&bar[XB_TOPGEN], 1u);
      else XB_SPIN(xb_ld(&bar[XB_TOPGEN]) == tg, bar);
      __builtin_amdgcn_fence(__ATOMIC_ACQUIRE, "agent");
      xb_add(&bar[XB_XGEN(x)], 1u);
      asm volatile("s_waitcnt vmcnt(0)" ::: "memory");
    } else {
      XB_SPIN(xb_ld(&bar[XB_XGEN(x)]) == gen, bar);
      __builtin_amdgcn_fence(__ATOMIC_ACQUIRE, "agent");
      asm volatile("s_waitcnt vmcnt(0)" ::: "memory");
    }
  }
  __syncthreads();
}

__device__ __forceinline__ Job job_kv(unsigned char* ws, int l) {
  bf16_t* wl = (bf16_t*)(ws + WS_W) + W_LAY + (size_t)l * W_LAY_SZ;
  return job_std((bf16_t*)(ws + WS_MB), DM, wl + (size_t)1024 * DM, DM, DM, 16, 8, (bf16_t*)(ws + WS_KV), 2048);
}
__device__ __forceinline__ Job job_qk(unsigned char* ws, int l) {
  bf16_t* wl = (bf16_t*)(ws + WS_W) + W_LAY + (size_t)l * W_LAY_SZ;
  Job j = job_std((bf16_t*)(ws + WS_KV), 2048, wl, DM, 256, 64, 4, (bf16_t*)(ws + WS_WQK), DM);
  j.adiv = 4; j.a1 = 256 * 2048; j.a0 = 256; j.bdiv = 4; j.b1 = 0; j.b0 = 256; j.b2 = 256 * DM;
  return j;
}
__device__ __forceinline__ Job job_vo(unsigned char* ws, int l) {
  bf16_t* wl = (bf16_t*)(ws + WS_W) + W_LAY + (size_t)l * W_LAY_SZ;
  Job j = job_std(wl + (size_t)3072 * DM, DM, (bf16_t*)(ws + WS_KV) + 1024, 2048, 256, 16, 16, (bf16_t*)(ws + WS_VWO), DM);
  j.adiv = 4; j.a0 = 256 * DM; j.a1 = 256; j.bdiv = 4; j.b1 = 256; j.b0 = 0; j.b2 = 256 * 2048;
  j.odiv = 4; j.r1 = 0; j.r0 = 256; j.r2 = 1024; j.c1 = 256; j.c0 = 0; j.c2 = 0;
  return j;
}

__global__ void __launch_bounds__(512, 2) fwd_megakernel(Params p) {
  extern __shared__ __attribute__((aligned(16))) unsigned char lds_raw[];
  LAS unsigned char* lds = (LAS unsigned char*)lds_raw;
  cg::grid_group grid = cg::this_grid();
  const int G = gridDim.x, bx = blockIdx.x;

  volatile LAS unsigned* barst = (volatile LAS unsigned*)(lds + BARST_OFF);
  if (threadIdx.x < 4) barst[threadIdx.x] = 0u;
  if (bx == 0) { unsigned* bar = (unsigned*)kws(); for (int i = threadIdx.x; i < XCD_BAR_WORDS; i += 512) bar[i] = 0u; }
#ifndef NO_PRO
  prologue(lds);
#endif
  grid.sync();
  if (threadIdx.x == 0) (void)xb_add(&((unsigned*)kws())[XB_XCNT(xb_xcc_id())], 1u);
#define GRID_SYNC() xcd_barrier(barst)

#pragma unroll 1
  for (int l = 0; l < DEPTH; ++l) {
    const int jx = l >> 1;
    if ((l & 1) == 0) {
      { unsigned char* ws = kws(); bf16_t* we = (bf16_t*)(ws + WS_W) + W_EVEN + (size_t)jx * W_EVEN_SZ;
        Job js = job_std(we, DM, (bf16_t*)(ws + WS_HB), DM, DM, 4, 256, (bf16_t*)(ws + WS_Z + Z_DT), 0); js.ssp = (float*)(ws + WS_SSP); js.O2 = (bf16_t*)(ws + WS_Z + Z_VT);
        gemm_phase<EPI_SWAP>(lds, js, G, bx); }
      { unsigned char* ws = kws(); bf16_t* we = (bf16_t*)(ws + WS_W) + W_EVEN + (size_t)jx * W_EVEN_SZ;
        Job jq = job_std((bf16_t*)(ws + WS_HB), DM, we + (size_t)1024 * DM, DM, DM, 256, 4, (bf16_t*)(ws + WS_Z + Z_QK), DM); jq.ssp = (float*)(ws + WS_SSP);
        gemm_phase<EPI_SCALE>(lds, jq, G, bx); }
      { const Job jkv = job_kv(kws(), l); gemm_phase<EPI_SCALE>(lds, jkv, G, bx); }
      GRID_SYNC();
      { unsigned char* ws = kws();
        Job jd = job_std((bf16_t*)(ws + WS_FCAT), 8192, (bf16_t*)(ws + WS_Z + Z_DT), 8192, 8192, 128, 2, (bf16_t*)(ws + WS_Z + Z_YE), DM);
        jd.adiv = 8; jd.a0 = 256 * 8192; jd.a1 = 0; jd.a2 = 2048 * 8192;     jd.bdiv = 8; jd.b1 = 512 * 8192; jd.b0 = 0; jd.b2 = 256 * 8192; jd.cscale = 0.0013810679320049757f;
        jd.chain = 4;
        gemm_phase<EPI_DFT>(lds, jd, G, bx);
        dft_mid_row((bf16_t*)(ws + WS_Z + Z_DT), (bf16_t*)(ws + WS_Z + Z_YE), 0.0013810679320049757f); }
      { const Job jqk = job_qk(kws(), l); gemm_phase<EPI_SCALE>(lds, jqk, G, bx); }
      { const Job jvo = job_vo(kws(), l); gemm_phase<EPI_SCALE>(lds, jvo, G, bx); }
#ifndef NO_NATTEN
      { unsigned char* ws = kws();
        natten_phase((bf16_t*)(ws + WS_Z + Z_QK), (bf16_t*)(ws + WS_Z + Z_VT), (bf16_t*)(ws + WS_Z + Z_YE), kin(5) + (size_t)jx * 4 * 15 * 31, (LAS float*)(lds + XCH_OFF)); }
#endif
      GRID_SYNC();
    } else {
      { unsigned char* ws = kws(); bf16_t* wo = (bf16_t*)(ws + WS_W) + W_ODD + (size_t)jx * W_ODD_SZ;
        Job ji = job_std((bf16_t*)(ws + WS_HB), DM, wo, DM, DM, 256, 4, (bf16_t*)(ws + WS_Z), DM); ji.ssp = (float*)(ws + WS_SSP);
        gemm_phase<EPI_SCALE>(lds, ji, G, bx); }
      { const Job jkv = job_kv(kws(), l); gemm_phase<EPI_SCALE>(lds, jkv, G, bx); }
      GRID_SYNC();
      { unsigned char* ws = kws(); bf16_t* wo = (bf16_t*)(ws + WS_W) + W_ODD + (size_t)jx * W_ODD_SZ;
        Job jc = job_std((bf16_t*)(ws + WS_HB) - DM, DM, wo + (size_t)1024 * DM, DM, DM, 272, 8, (bf16_t*)(ws + WS_Z + Z_YO), DM); jc.ssp = (float*)(ws + WS_SSP);
        jc.adiv = 17; jc.a1 = SEQ * DM; jc.a0 = 254 * DM; jc.cw = kin(8) + (size_t)jx * 3 * DM; jc.GB = (const bf16_t*)(ws + WS_Z);
        gemm_phase<EPI_GCONV>(lds, jc, G, bx); }
      { const Job jqk = job_qk(kws(), l); gemm_phase<EPI_SCALE>(lds, jqk, G, bx); }
      { const Job jvo = job_vo(kws(), l); gemm_phase<EPI_SCALE>(lds, jvo, G, bx); }
      GRID_SYNC();
    }
    { unsigned char* ws = kws(); bf16_t* wb = (bf16_t*)(ws + WS_W);
      const bf16_t* wout = ((l & 1) == 0) ? wb + W_EVEN + (size_t)jx * W_EVEN_SZ + (size_t)2048 * DM : wb + W_ODD + (size_t)jx * W_ODD_SZ + (size_t)3072 * DM;
      const bf16_t* Ymix = (bf16_t*)(ws + WS_Z + (((l & 1) == 0) ? Z_YE : Z_YO));
      Job jo = job_std(Ymix, DM, wout, DM, DM, 256, 4, (bf16_t*)(ws + WS_HB), DM); jo.sspw = (float*)(ws + WS_SSP);
      gemm_phase<EPI_RES>(lds, jo, G, bx); }
    GRID_SYNC();
    { unsigned char* ws = kws();
      Job jx1 = job_std((bf16_t*)(ws + WS_HB), DM, (bf16_t*)(ws + WS_WQK), DM, DM, 256, 4, (bf16_t*)(ws + WS_Z), DM); jx1.bdiv = 16; jx1.b1 = DM * DM; jx1.ssp = (float*)(ws + WS_SSP);
      gemm_phase<EPI_SOFTMAX>(lds, jx1, G, bx); }
    GRID_SYNC();
    { unsigned char* ws = kws();
      Job jx2 = job_std((bf16_t*)(ws + WS_Z), DM, (bf16_t*)(ws + WS_VWO), DM, DM, 256, 4, (bf16_t*)(ws + WS_HB), DM); jx2.bdiv = 16; jx2.b1 = DM * DM; jx2.sspw = (float*)(ws + WS_SSP);
      gemm_phase<EPI_RES>(lds, jx2, G, bx); }
    GRID_SYNC();
    { unsigned char* ws = kws(); bf16_t* wl = (bf16_t*)(ws + WS_W) + W_LAY + (size_t)l * W_LAY_SZ;
      Job ju = job_std((bf16_t*)(ws + WS_HB), DM, wl + (size_t)4096 * DM, DM, DM, 256, 16, (bf16_t*)(ws + WS_Z), DFF); ju.ssp = (float*)(ws + WS_SSP);
      ju.chain = 1; ju.cw = kin(16) + (size_t)l * 3 * DFF; ju.cb = kin(17) + (size_t)l * DFF;
      gemm_phase<EPI_FFN>(lds, ju, G, bx); }
    GRID_SYNC();
    { unsigned char* ws = kws(); bf16_t* wl = (bf16_t*)(ws + WS_W) + W_LAY + (size_t)l * W_LAY_SZ;
      Job jd2 = job_std((bf16_t*)(ws + WS_Z), DFF, wl + (size_t)8192 * DM, DFF, DFF, 256, 4, (bf16_t*)(ws + WS_HB), DM); jd2.sspw = (float*)(ws + WS_SSP);
      gemm_phase<EPI_RES>(lds, jd2, G, bx); }
    GRID_SYNC();
  }
  {
    int tid = threadIdx.x; asm volatile("" : "+v"(tid));
    const int lane = tid & 63, gwave = bx * 8 + (tid >> 6), ngw = G * 8;
    float* H = kout(); unsigned char* ws = kws(); const float* ssp = (const float*)(ws + WS_SSP); const bf16_t* HB = (const bf16_t*)(ws + WS_HB); const float* gf = kin(19);
    f32x4 gg[4];
#pragma unroll
    for (int j = 0; j < 4; ++j) gg[j] = *((const f32x4*)gf + lane + 64 * j);
    for (int r = gwave; r < NTOK; r += 2 * ngw) {
      u32x2 hv[2][4]; float rs[2];
#pragma unroll
      for (int q = 0; q < 2; ++q) { const int rq = min(r + q * ngw, NTOK - 1); rs[q] = rstd_of(ssp, (size_t)rq);
#pragma unroll
        for (int j = 0; j < 4; ++j) hv[q][j] = *((const u32x2*)(HB + (size_t)rq * DM) + lane + 64 * j); }
#pragma unroll
      for (int q = 0; q < 2; ++q) { if (r + q * ngw >= NTOK) continue;
        f32x4* orow = (f32x4*)(H + (size_t)(r + q * ngw) * DM) + lane;
#pragma unroll
        for (int j = 0; j < 4; ++j) { const f32x4 v = (f32x4){bf_lo(hv[q][j].x), bf_hi(hv[q][j].x), bf_lo(hv[q][j].y), bf_hi(hv[q][j].y)}; orow[64 * j] = v * rs[q] * gg[j]; } }
    }
  }
}

extern "C" void kernel_launch(void* const* d_in, const int* in_sizes, int n_in, void* d_out, int out_size, void* d_ws, size_t ws_size, hipStream_t stream) {
  static int grid_blocks = 0;
  if (!grid_blocks) {
    int dev = 0, cus = 0, per_cu = 0;
    (void)hipGetDevice(&dev);
    (void)hipDeviceGetAttribute(&cus, hipDeviceAttributeMultiprocessorCount, dev);
    (void)hipFuncSetAttribute((const void*)fwd_megakernel, hipFuncAttributeMaxDynamicSharedMemorySize, LDS_BYTES);
    (void)hipOccupancyMaxActiveBlocksPerMultiprocessor(&per_cu, (const void*)fwd_megakernel, 512, LDS_BYTES);
    if (per_cu < 1) per_cu = 1;
    grid_blocks = cus * per_cu;
    if (n_in != 20 || out_size != NTOK * DM || ws_size < WS_END) { fprintf(stderr, "kernel_launch: unexpected shapes/workspace (n_in %d out %d ws %zu)\n", n_in, out_size, ws_size); grid_blocks = -1; }
  }
  if (grid_blocks < 0) return;
  Params p{};
  for (int i = 0; i < 20; ++i) p.in[i] = (const float*)d_in[i];
  p.out = (float*)d_out; p.ws = (unsigned char*)d_ws;
  void* args[] = {&p};
  hipError_t e = hipLaunchCooperativeKernel((void*)fwd_megakernel, dim3(grid_blocks), dim3(512), args, LDS_BYTES, stream);
  if (e != hipSuccess) fprintf(stderr, "cooperative launch failed: %s (grid %d)\n", hipGetErrorString(e), grid_blocks);
}
#ifdef TEST_EPI
__global__ void __launch_bounds__(512, 2) test_kernel(Job j, int G) {
  extern __shared__ __attribute__((aligned(16))) unsigned char lds_raw[];
  gemm_phase<TEST_EPI>((LAS unsigned char*)lds_raw, j, G, blockIdx.x);
}
#endif
```

```cpp
#include <hip/hip_runtime.h>
#include <hip/hip_cooperative_groups.h>
#include <cstdio>
#include <cstdint>
namespace cg = cooperative_groups;

#define LAS __attribute__((address_space(3)))
typedef unsigned short bf16_t;
typedef short bf16x8 __attribute__((ext_vector_type(8)));
typedef float f32x4 __attribute__((ext_vector_type(4)));
typedef float f32x2 __attribute__((ext_vector_type(2)));
typedef unsigned u32x4 __attribute__((ext_vector_type(4)));
typedef unsigned u32x2 __attribute__((ext_vector_type(2)));

constexpr int DM = 1024, NB = 16, SEQ = 4096, NTOK = NB * SEQ, DEPTH = 4, NMEM = 256, DFF = 2048;
constexpr float EPS = 1e-6f;
constexpr float LOG2E = 1.4426950408889634f;

constexpr size_t MiB = 1u << 20;
constexpr size_t WS_SSP = 1 * MiB;
constexpr size_t WS_W = 2 * MiB;
constexpr size_t WS_FCAT = 112 * MiB;
constexpr size_t WS_MB = 176 * MiB;
constexpr size_t WS_KV = 184 * MiB;
constexpr size_t WS_WQK = 200 * MiB;
constexpr size_t WS_VWO = 232 * MiB;
constexpr size_t WS_HB = 264 * MiB;
constexpr size_t WS_Z = 392 * MiB;
constexpr size_t WS_END = 904 * MiB;
constexpr size_t Z_DT = 0, Z_QK = 128 * MiB, Z_VT = 256 * MiB, Z_YE = 320 * MiB, Z_YO = 384 * MiB;

constexpr size_t W_EVEN = 0;
constexpr size_t W_EVEN_SZ = (size_t)(1024 + 1024 + 1024) * 1024;
constexpr size_t W_ODD = W_EVEN + 2 * W_EVEN_SZ;
constexpr size_t W_ODD_SZ = (size_t)(3072 + 1024) * 1024;
constexpr size_t W_LAY = W_ODD + 2 * W_ODD_SZ;
constexpr size_t W_LAY_SZ = (size_t)(1024 + 2048 + 1024 + 4096 + 2048) * 1024;
static_assert((W_LAY + 4 * W_LAY_SZ) * 2 <= 110 * MiB, "weights fit");

constexpr int RING_BYTES = 131072, XCH_OFF = RING_BYTES, XCH_BYTES = 8192, BARST_OFF = XCH_OFF + XCH_BYTES, LDS_BYTES = BARST_OFF + 16;

struct Params {
  const float* in[20]; float* out; unsigned char* ws;
};

#define CAS __attribute__((address_space(4)))
__device__ __forceinline__ CAS const char* ka_ptr() { CAS const char* ka = (CAS const char*)__builtin_amdgcn_kernarg_segment_ptr(); asm volatile("" : "+s"(ka)); return ka; }
__device__ __forceinline__ unsigned long long ka_u64(int off) { return *(CAS const unsigned long long*)(ka_ptr() + off); }
__device__ __forceinline__ const float* kin(int i) { return (const float*)(__attribute__((address_space(1))) const float*)ka_u64(8 * i); }
__device__ __forceinline__ float* kout() { return (float*)(__attribute__((address_space(1))) float*)ka_u64(160); }
__device__ __forceinline__ unsigned char* kws() { return (unsigned char*)(__attribute__((address_space(1))) unsigned char*)ka_u64(168); }
#define GAS __attribute__((address_space(1)))
template <class T> __device__ __forceinline__ T* uni(T* p) { const unsigned long long v = (unsigned long long)p; const unsigned lo = __builtin_amdgcn_readfirstlane((unsigned)v), hi = __builtin_amdgcn_readfirstlane((unsigned)(v >> 32)); return (T*)(GAS T*)(((unsigned long long)hi << 32) | lo); }
__device__ __forceinline__ int uni(int v) { return __builtin_amdgcn_readfirstlane(v); }
__device__ __forceinline__ unsigned cvt_pk_bf16(float lo, float hi) { unsigned r; asm volatile("v_cvt_pk_bf16_f32 %0, %1, %2" : "=v"(r) : "v"(lo), "v"(hi)); return r; }
__device__ __forceinline__ float bf_lo(unsigned u) { return __uint_as_float(u << 16); }
__device__ __forceinline__ float bf_hi(unsigned u) { return __uint_as_float(u & 0xffff0000u); }
__device__ __forceinline__ float wave_sum(float v) {
#pragma unroll
  for (int o = 1; o < 64; o <<= 1) v += __shfl_xor(v, o);
  return v;
}
__device__ __forceinline__ f32x2 gelu_pk(f32x2 v) {
  const f32x2 av = __builtin_elementwise_abs(v), d = av * 0.2316418882f + 1.0f;
  f32x2 t; t.x = __builtin_amdgcn_rcpf(d.x); t.y = __builtin_amdgcn_rcpf(d.y);
  f32x2 q = t * 0.5307027145f + (-0.7265760135f); q = q * t + 0.7107068705f; q = q * t + (-0.142248368f); q = q * t + 0.127414796f; q = q * t;
  const f32x2 s = (v * v) * (-0.72134752044f);
  f32x2 e; e.x = __builtin_amdgcn_exp2f(s.x); e.y = __builtin_amdgcn_exp2f(s.y);
  const f32x2 m = v * (q * e), r = v - m;
  f32x2 o; o.x = v.x < 0.f ? m.x : r.x; o.y = v.y < 0.f ? m.y : r.y; return o;
}
__device__ __forceinline__ float rstd_of(const float* ssp, size_t row) {
  const f32x4 s = *(const f32x4*)(ssp + row * 4);
  return rsqrtf(((s.x + s.y) + (s.z + s.w)) * (1.0f / DM) + EPS);
}

__device__ __forceinline__ void unpack8(const u32x4 w, float (&f)[8]) {
  f[0] = bf_lo(w.x); f[1] = bf_hi(w.x); f[2] = bf_lo(w.y); f[3] = bf_hi(w.y); f[4] = bf_lo(w.z); f[5] = bf_hi(w.z); f[6] = bf_lo(w.w); f[7] = bf_hi(w.w);
}

constexpr int BM = 256, BK = 64, HALF = 128, HTB = HALF * BK * 2, NXCD = 8, WGM = 8;
__device__ __forceinline__ int lds_byte(int r, int c) { const int st = (r >> 4) * 2 + (c >> 5), rr = r & 15, cc = c & 31, ob = rr * 64 + cc * 2; return st * 1024 + (ob ^ (((ob >> 9) & 1) << 5)); }
__device__ __forceinline__ void stage_rc(int b, int& R, int& C) { const int st = b / 1024, sb = b % 1024, swz = sb ^ (((sb >> 9) & 1) << 5); R = (st >> 1) * 16 + swz / 64; C = (st & 1) * 32 + (swz % 64) / 2; }
__device__ __forceinline__ int perm32(int rho) { const int n = rho >> 4, i = rho & 15; return 8 * (i >> 2) + 4 * n + (i & 3); }

struct Unit { int pm, pn; };
struct Job {
  const bf16_t* A; const bf16_t* Bt;
  int lda, ldb, K, nM, nN;
  int adiv, bdiv, odiv;
  int a0, a1, a2, b0, b1, b2;
  int r0, r1, r2, c0, c1, c2;
  bf16_t* O; int ldc;
  const float* ssp; float cscale;
  const float* base; float* H; float* sspw;
  bf16_t* O2;
  const float* cw; const float* cb;
  const bf16_t* GB;
  int chain;
};
__device__ __forceinline__ Job job_std(const bf16_t* A, int lda, const bf16_t* Bt, int ldb, int K, int nM, int nN, bf16_t* O, int ldc) {
  Job j; j.A = A; j.Bt = Bt; j.lda = lda; j.ldb = ldb; j.K = K; j.nM = nM; j.nN = nN;
  j.adiv = 1 << 20; j.bdiv = 1 << 20; j.odiv = 1 << 20;
  j.a0 = 256 * lda; j.a1 = 0; j.a2 = 0; j.b0 = 0; j.b1 = 0; j.b2 = 256 * ldb;
  j.r0 = 256; j.r1 = 0; j.r2 = 0; j.c0 = 0; j.c1 = 0; j.c2 = 256;
  j.O = O; j.ldc = ldc; j.ssp = nullptr; j.cscale = 1.0f; j.base = nullptr; j.H = nullptr; j.sspw = nullptr; j.O2 = nullptr; j.cw = nullptr; j.cb = nullptr; j.GB = nullptr; j.chain = 0;
  return j;
}
struct StaticOrder {
  int nM, nN, nwg, G, c, chain;
  __device__ __forceinline__ void init(int nM_, int nN_, int G_, int c_, int chain_) { nM = nM_; nN = nN_; nwg = nM * nN; G = G_; c = c_; chain = chain_; }
  __device__ __forceinline__ bool next(int i, Unit& u) const {
    if (chain == 4) {
      if (G != 256) { const int L = i * G + c; if (L >= nwg) return false; u.pm = uni(L >> 1); u.pn = uni(L & 1); return true; }
      if (i > 0) return false; const int x = c & 7, j = c >> 3; u.pn = uni(x >> 2); u.pm = uni((4 * (x & 3) + (j >> 3)) * 8 + (j & 7)); return true; }
    if (chain) {
      int bq, pq;
      if (G == 256) { if (i >= 16) return false; const int x = c & 7, j = c >> 3; bq = 8 * (x >> 2) + (j >> 2); pq = 4 * (x & 3) + (j & 3); }
      else { const int ch = c + (i >> 4) * G; if (ch >= 256) return false; bq = ch >> 4; pq = ch & 15; }
      u.pm = uni(bq * 16 + (i & 15)); u.pn = uni(pq); return true; }
    const int L = i * G + c; if (L >= nwg) return false;
    int wgid = L; { const int q = nwg / NXCD, r = nwg % NXCD, xcd = wgid % NXCD, off = wgid / NXCD; wgid = (xcd < r ? xcd * (q + 1) : r * (q + 1) + (xcd - r) * q) + off; }
    const int nig = WGM * nN, gid = wgid / nig, fm = gid * WGM, gsz = (nM - fm) < WGM ? (nM - fm) : WGM;
    u.pm = uni(fm + ((wgid % nig) % gsz)); u.pn = uni((wgid % nig) / gsz); return true;
  }
};
__device__ __forceinline__ size_t job_aoff(const Job& g, const Unit& u) { return (size_t)(u.pm / g.adiv) * g.a1 + (size_t)(u.pm % g.adiv) * g.a0 + (size_t)u.pn * g.a2; }
__device__ __forceinline__ size_t job_boff(const Job& g, const Unit& u) { return (size_t)(u.pm / g.bdiv) * g.b1 + (size_t)(u.pm % g.bdiv) * g.b0 + (size_t)u.pn * g.b2; }

#define RSTD_BATCH8(dst, sb, ROWOF) do { f32x4 _t[8]; _Pragma("unroll") for (int _q = 0; _q < 8; ++_q) _t[_q] = *(const f32x4*)((sb) + (size_t)(unsigned)(ROWOF(_q)) * 4); \
    __builtin_amdgcn_sched_barrier(0); _Pragma("unroll") for (int _q = 0; _q < 8; ++_q) (dst)[_q] = rsqrtf(((_t[_q].x + _t[_q].y) + (_t[_q].z + _t[_q].w)) * (1.0f / DM) + EPS); } while (0)
#define ROW8(q) (((q) >> 2) * HALF + rl + ((q) & 3) * 16)
enum { EPI_SCALE = 0, EPI_SWAP = 1, EPI_RES = 2, EPI_SOFTMAX = 3, EPI_FFN = 4, EPI_DFT = 5, EPI_GCONV = 6 };
template <int CTRL> __device__ __forceinline__ float dppf(float old, float src) { return __builtin_bit_cast(float, __builtin_amdgcn_update_dpp(__builtin_bit_cast(int, old), __builtin_bit_cast(int, src), CTRL, 0xF, 0xF, false)); }

template <int EPI>
__device__ __forceinline__ void epilogue(f32x4 (&acc)[2][2][4][2], const Job& g, const Unit& u, int wr, int wc, int fr, int fq, LAS unsigned char* xch) {
  const int rl = wr * 64 + fr, cl = wc * 32 + 8 * fq;
  if constexpr (EPI == EPI_SCALE) {
    const size_t orow0 = (size_t)(u.pm / g.odiv) * g.r1 + (size_t)(u.pm % g.odiv) * g.r0 + (size_t)u.pn * g.r2;
    const int ocol0 = (u.pm / g.odiv) * g.c1 + (u.pm % g.odiv) * g.c0 + u.pn * g.c2;
    bf16_t* obase = uni(g.O + orow0 * g.ldc + ocol0);
    const float* sbase = uni(g.ssp + (size_t)u.pm * BM * 4);
    float scr8[8];
    { const float* sb = g.ssp ? sbase : (const float*)uni(g.A);
      RSTD_BATCH8(scr8, sb, ROW8);
#pragma unroll
      for (int q = 0; q < 8; ++q) scr8[q] = g.ssp ? scr8[q] * g.cscale : g.cscale; }
#pragma unroll
    for (int ai = 0; ai < 2; ++ai)
#pragma unroll
      for (int m = 0; m < 4; ++m) {
        const int lr = ai * HALF + rl + m * 16;
        const float sc = scr8[ai * 4 + m];
        bf16_t* rowp = (bf16_t*)((char*)obase + (unsigned)(lr * g.ldc + cl) * 2u);
#pragma unroll
        for (int bj = 0; bj < 2; ++bj) {
          const f32x4 v0 = acc[ai][bj][m][0] * sc, v1 = acc[ai][bj][m][1] * sc;
          u32x4 w; w.x = cvt_pk_bf16(v0[0], v0[1]); w.y = cvt_pk_bf16(v0[2], v0[3]); w.z = cvt_pk_bf16(v1[0], v1[1]); w.w = cvt_pk_bf16(v1[2], v1[3]);
          __builtin_nontemporal_store(w, (u32x4*)(rowp + bj * HALF));
        }
      }
  } else if constexpr (EPI == EPI_SWAP) {
    float rs[2][8];
    const size_t tokt = (size_t)u.pn * BM;
    const float* sbase = uni(g.ssp + tokt * 4);
#define COL8A(q) (cl + (q))
#define COL8B(q) (cl + HALF + (q))
    RSTD_BATCH8(rs[0], sbase, COL8A);
    RSTD_BATCH8(rs[1], sbase, COL8B);
    __builtin_amdgcn_sched_barrier(0);
    const size_t bq = tokt >> 12, sq = tokt & 4095;
    bf16_t* dtb = uni(g.O + bq * 512 * 8192 + sq);
    bf16_t* vtb = uni(g.O2 + (size_t)((u.pm >= 2 ? u.pm - 2 : 0) * BM) * NTOK + tokt);
#pragma unroll
    for (int ai = 0; ai < 2; ++ai)
#pragma unroll
      for (int m = 0; m < 4; ++m) {
        const int lr = ai * HALF + rl + m * 16;
        int r1, r2, half;
        if (u.pm == 0) { const int gg = lr >> 6, cp = lr & 63; r1 = gg * 64 + cp; r2 = cp ? 256 + gg * 64 + 64 - cp : -1; half = 0; }
        else if (lr < 4) { r1 = 256 + lr * 64; r2 = -1; half = 0; }
        else { const int mm = lr - 4, gg = mm / 63, cp = 1 + mm % 63; r1 = gg * 64 + cp; r2 = 256 + gg * 64 + 64 - cp; half = 1; }
        bf16_t* p1 = (u.pm < 2) ? (bf16_t*)((char*)dtb + ((unsigned)(r1 * 8192 + half * 4096) + (unsigned)cl) * 2u) : (bf16_t*)((char*)vtb + ((unsigned)lr * (unsigned)NTOK + (unsigned)cl) * 2u);
        bf16_t* p2 = (bf16_t*)((char*)dtb + ((unsigned)((r2 < 0 ? 0 : r2) * 8192 + half * 4096) + (unsigned)cl) * 2u);
#pragma unroll
        for (int bj = 0; bj < 2; ++bj) {
          const f32x4 v0 = acc[ai][bj][m][0], v1 = acc[ai][bj][m][1];
          u32x4 w; w.x = cvt_pk_bf16(v0[0] * rs[bj][0], v0[1] * rs[bj][1]); w.y = cvt_pk_bf16(v0[2] * rs[bj][2], v0[3] * rs[bj][3]);
          w.z = cvt_pk_bf16(v1[0] * rs[bj][4], v1[1] * rs[bj][5]); w.w = cvt_pk_bf16(v1[2] * rs[bj][6], v1[3] * rs[bj][7]);
          __builtin_nontemporal_store(w, (u32x4*)(p1 + bj * HALF));
          if (u.pm < 2 && r2 >= 0) __builtin_nontemporal_store(w, (u32x4*)(p2 + bj * HALF));
          if (u.pm == 1 && lr < 4) {
            const u32x4 z = (u32x4){0u, 0u, 0u, 0u};
            __builtin_nontemporal_store(z, (u32x4*)((char*)dtb + ((unsigned)((256 + lr * 64) * 8192 + 4096) + (unsigned)(cl + bj * HALF)) * 2u));
            __builtin_nontemporal_store(z, (u32x4*)((char*)dtb + ((unsigned)((lr * 64) * 8192 + 4096) + (unsigned)(cl + bj * HALF)) * 2u));
          }
        }
      }
  } else if constexpr (EPI == EPI_RES) {
    LAS float* part = (LAS float*)xch;
    const size_t toff = (size_t)u.pm * BM * DM + (size_t)u.pn * BM;
    bf16_t* rO = uni(g.O + toff);
    u32x4 hbv[8][2];
#pragma unroll
    for (int q = 0; q < 8; ++q)
#pragma unroll
      for (int bj = 0; bj < 2; ++bj) hbv[q][bj] = *(const u32x4*)((const char*)rO + ((unsigned)(((q >> 2) * HALF + rl + (q & 3) * 16) * DM + cl) + bj * HALF) * 2u);
    __builtin_amdgcn_sched_barrier(0);
#pragma unroll
    for (int ai = 0; ai < 2; ++ai)
#pragma unroll
      for (int m = 0; m < 4; ++m) {
        const int lr = ai * HALF + rl + m * 16;
        const unsigned off = (unsigned)(lr * DM + cl);
        float ss = 0.f;
#pragma unroll
        for (int bj = 0; bj < 2; ++bj) {
          const u32x4 hb = hbv[ai * 4 + m][bj];
          f32x4 v0 = acc[ai][bj][m][0], v1 = acc[ai][bj][m][1];
          v0[0] += bf_lo(hb.x); v0[1] += bf_hi(hb.x); v0[2] += bf_lo(hb.y); v0[3] += bf_hi(hb.y);
          v1[0] += bf_lo(hb.z); v1[1] += bf_hi(hb.z); v1[2] += bf_lo(hb.w); v1[3] += bf_hi(hb.w);
          ss += (v0[0] * v0[0] + v0[1] * v0[1]) + (v0[2] * v0[2] + v0[3] * v0[3]) + (v1[0] * v1[0] + v1[1] * v1[1]) + (v1[2] * v1[2] + v1[3] * v1[3]);
          u32x4 w; w.x = cvt_pk_bf16(v0[0], v0[1]); w.y = cvt_pk_bf16(v0[2], v0[3]); w.z = cvt_pk_bf16(v1[0], v1[1]); w.w = cvt_pk_bf16(v1[2], v1[3]);
          *(u32x4*)((char*)rO + (off + bj * HALF) * 2u) = w;
        }
        ss += __shfl_xor(ss, 16); ss += __shfl_xor(ss, 32);
        if (fq == 0) part[lr * 4 + wc] = ss;
      }
    asm volatile("s_waitcnt lgkmcnt(0)" ::: "memory"); __builtin_amdgcn_s_barrier(); asm volatile("" ::: "memory");
    const int tix = (wr * 4 + wc) * 64 + fq * 16 + fr;
    if (tix < 256) {
      const f32x4 p = *(const LAS f32x4*)(part + tix * 4);
      float* sw = uni(g.sspw + (size_t)u.pm * BM * 4 + u.pn);
      *(float*)((char*)sw + (unsigned)tix * 16u) = (p.x + p.y) + (p.z + p.w);
    }
  } else if constexpr (EPI == EPI_DFT) {
    const int b = u.pm >> 3, st = u.pm & 7;
    bf16_t* obase = uni(g.O + ((size_t)b * SEQ + st * 256) * DM);
    bf16_t* mbase = uni(g.O + ((size_t)b * SEQ + SEQ - st * 256) * DM);
    const float sc = g.cscale;
#pragma unroll
    for (int ai = 0; ai < 2; ++ai)
#pragma unroll
      for (int m = 0; m < 4; ++m) {
        const int lr = ai * HALF + rl + m * 16;
        bf16_t* rowp = (bf16_t*)((char*)obase + (unsigned)(lr * DM) * 2u);
        bf16_t* mrow = mbase - (size_t)lr * DM;
        const bool mir = (st * 256 + lr) != 0;
#pragma unroll
        for (int bj = 0; bj < 2; ++bj) {
          const f32x4 v0 = acc[ai][bj][m][0] * sc, v1 = acc[ai][bj][m][1] * sc;
          u32x4 w; w.x = cvt_pk_bf16(v0[0], v0[1]); w.y = cvt_pk_bf16(v0[2], v0[3]); w.z = cvt_pk_bf16(v1[0], v1[1]); w.w = cvt_pk_bf16(v1[2], v1[3]);
          const int lc = bj * HALF + cl; const int c = 128 * (lc >> 6) + 64 * u.pn + (lc & 63);
          __builtin_nontemporal_store(w, (u32x4*)(rowp + c));
          if (mir) {
            const int gb = c & ~127, cp = c & 127;
            const unsigned ww[4] = {w.x, w.y, w.z, w.w};
#pragma unroll
            for (int j = 0; j < 8; ++j) mrow[gb + ((128 - (cp + j)) & 127)] = (bf16_t)((j & 1) ? (ww[j >> 1] >> 16) : (ww[j >> 1] & 0xffffu));
          }
        }
      }
  } else if constexpr (EPI == EPI_FFN || EPI == EPI_GCONV) {
    constexpr bool GC = (EPI == EPI_GCONV);
    constexpr int CSTR = GC ? DM : DFF;
    constexpr bool CH = !GC;
    LAS float* X = (LAS float*)xch;
    const int b = CH ? (u.pm >> 4) : u.pm / 17, ti = CH ? (u.pm & 15) : u.pm % 17, s0 = CH ? 256 * ti : 254 * ti - 1;
    LAS float* CYW = X + 1024 + (ti & 1) * 384;
    const LAS float* CYR = X + 1024 + ((ti + 1) & 1) * 384;
    const long row0 = (long)b * SEQ + s0;
    const float* sbase = uni(g.ssp + row0 * 4);
    const int ch0 = u.pn * 128 + cl;
    float rs8[8];
    RSTD_BATCH8(rs8, sbase, ROW8);
    __builtin_amdgcn_sched_barrier(0);
#pragma unroll
    for (int ai = 0; ai < 2; ++ai)
#pragma unroll
      for (int m = 0; m < 4; ++m) {
        const int lr = ai * HALF + rl + m * 16;
        const float sc = rs8[ai * 4 + m];
        const bool inb = CH ? true : ((unsigned)(s0 + lr) < (unsigned)SEQ);
#pragma unroll
        for (int n = 0; n < 2; ++n) {
          if constexpr (GC) { const f32x4 gv = (acc[ai][0][m][n] * sc) * (acc[ai][1][m][n] * sc); acc[ai][1][m][n] = inb ? gv : (f32x4){0.f, 0.f, 0.f, 0.f}; }
          else { acc[ai][0][m][n] = acc[ai][0][m][n] * sc; const f32x4 gv = acc[ai][1][m][n] * sc; acc[ai][1][m][n] = inb ? gv : (f32x4){0.f, 0.f, 0.f, 0.f}; } }
      }
#pragma unroll
    for (int ai = 0; ai < 2; ++ai) {
      const int seg = 2 * ai + wr;
      if (fr == 0) { *(LAS f32x4*)(X + (seg * 2 + 0) * 128 + cl) = acc[ai][1][0][0]; *(LAS f32x4*)(X + (seg * 2 + 0) * 128 + cl + 4) = acc[ai][1][0][1]; }
      if (fr == 15) { *(LAS f32x4*)(X + (seg * 2 + 1) * 128 + cl) = acc[ai][1][3][0]; *(LAS f32x4*)(X + (seg * 2 + 1) * 128 + cl + 4) = acc[ai][1][3][1]; }
    }
    if constexpr (CH) {
      if (wr == 1 && fr == 14) { *(LAS f32x4*)(CYW + cl) = acc[1][1][3][0]; *(LAS f32x4*)(CYW + cl + 4) = acc[1][1][3][1]; }
      if (wr == 1 && fr == 15) { *(LAS f32x4*)(CYW + 128 + cl) = acc[1][1][3][0]; *(LAS f32x4*)(CYW + 128 + cl + 4) = acc[1][1][3][1];
                                 *(LAS f32x4*)(CYW + 256 + cl) = acc[1][0][3][0]; *(LAS f32x4*)(CYW + 256 + cl + 4) = acc[1][0][3][1]; }
    }
    asm volatile("s_waitcnt lgkmcnt(0)" ::: "memory"); __builtin_amdgcn_s_barrier(); asm volatile("" ::: "memory");
    bf16_t* obase = uni(g.O + row0 * CSTR + u.pn * 128);
    const bf16_t* gbase = GC ? uni(g.GB + row0 * DM + u.pn * 128) : nullptr;
    u32x4 gbv[8];
    if constexpr (GC) {
#pragma unroll
      for (int q = 0; q < 8; ++q) gbv[q] = *(const u32x4*)((const char*)gbase + ((unsigned)(ROW8(q) < 1 ? 1 : ROW8(q)) * DM + (unsigned)cl) * 2u);
      __builtin_amdgcn_sched_barrier(0);
    }
    float w0[8], w1[8], w2[8], bb[8];
    { const f32x4 a0 = *(const f32x4*)(g.cw + ch0), a1 = *(const f32x4*)(g.cw + ch0 + 4), b0 = *(const f32x4*)(g.cw + CSTR + ch0), b1 = *(const f32x4*)(g.cw + CSTR + ch0 + 4);
      const f32x4 c0 = *(const f32x4*)(g.cw + 2 * CSTR + ch0), c1 = *(const f32x4*)(g.cw + 2 * CSTR + ch0 + 4);
      f32x4 d0 = (f32x4){0.f, 0.f, 0.f, 0.f}, d1 = d0; if constexpr (!GC) { d0 = *(const f32x4*)(g.cb + ch0); d1 = *(const f32x4*)(g.cb + ch0 + 4); }
#pragma unroll
      for (int j = 0; j < 4; ++j) { w0[j] = a0[j]; w0[4 + j] = a1[j]; w1[j] = b0[j]; w1[4 + j] = b1[j]; w2[j] = c0[j]; w2[4 + j] = c1[j]; bb[j] = d0[j]; bb[4 + j] = d1[j]; } }
#pragma unroll
    for (int ai = 0; ai < 2; ++ai) {
      const int seg = 2 * ai + wr;
      f32x4 pl[2], nl[2];
      const int sp = seg > 0 ? seg - 1 : 0, sn = seg < 3 ? seg + 1 : 3;
      pl[0] = *(const LAS f32x4*)(X + (sp * 2 + 1) * 128 + cl); pl[1] = *(const LAS f32x4*)(X + (sp * 2 + 1) * 128 + cl + 4);
      nl[0] = *(const LAS f32x4*)(X + (sn * 2 + 0) * 128 + cl); nl[1] = *(const LAS f32x4*)(X + (sn * 2 + 0) * 128 + cl + 4);
      if constexpr (CH) {
        if (seg == 0) { if (ti > 0) { pl[0] = *(const LAS f32x4*)(CYR + 128 + cl); pl[1] = *(const LAS f32x4*)(CYR + 128 + cl + 4); } else { pl[0] = (f32x4){0.f, 0.f, 0.f, 0.f}; pl[1] = pl[0]; } }
        if (seg == 3) { nl[0] = (f32x4){0.f, 0.f, 0.f, 0.f}; nl[1] = nl[0]; }
      }
#pragma unroll
      for (int m = 0; m < 4; ++m) {
        const int lr = ai * HALF + rl + m * 16;
        float a[8];
#pragma unroll
        for (int n = 0; n < 2; ++n)
#pragma unroll
          for (int v = 0; v < 4; ++v) {
            const float cur = acc[ai][1][m][n][v];
            float oldp, oldn;
            if (m > 0) { const float t = acc[ai][1][m > 0 ? m - 1 : 0][n][v]; oldp = dppf<0x121>(t, t); } else oldp = pl[n][v];
            if (m < 3) { const float t = acc[ai][1][m < 3 ? m + 1 : 3][n][v]; oldn = dppf<0x12F>(t, t); } else oldn = nl[n][v];
            const float prev = dppf<0x111>(oldp, cur), next = dppf<0x101>(oldn, cur);
            a[4 * n + v] = w0[4 * n + v] * prev + w1[4 * n + v] * cur + w2[4 * n + v] * next + bb[4 * n + v];
          }
        if constexpr (!GC) {
#pragma unroll
          for (int j = 0; j < 8; j += 2) { const f32x2 ge = gelu_pk((f32x2){a[j], a[j + 1]}); a[j] = ge.x * acc[ai][0][m][j >> 2][j & 3]; a[j + 1] = ge.y * acc[ai][0][m][(j + 1) >> 2][(j + 1) & 3]; }
        }
        if (CH ? (lr != 255 || ti == 15) : (lr >= 1 && lr <= 254 && s0 + lr < SEQ)) {
          if constexpr (GC) { float gb[8]; unpack8(gbv[ai * 4 + m], gb);
#pragma unroll
            for (int j = 0; j < 8; ++j) a[j] *= gb[j]; }
          u32x4 w; w.x = cvt_pk_bf16(a[0], a[1]); w.y = cvt_pk_bf16(a[2], a[3]); w.z = cvt_pk_bf16(a[4], a[5]); w.w = cvt_pk_bf16(a[6], a[7]);
          __builtin_nontemporal_store(w, (u32x4*)((char*)obase + ((unsigned)lr * CSTR + (unsigned)cl) * 2u));
        }
      }
    }
    if constexpr (CH) {
      const int tix = (wr * 4 + wc) * 64 + fq * 16 + fr;
      if (ti > 0 && tix < 16) {
        const int ch = tix * 8, gch = u.pn * 128 + ch;
        const f32x4 ga0 = *(const LAS f32x4*)(CYR + ch), ga1 = *(const LAS f32x4*)(CYR + ch + 4), gb0 = *(const LAS f32x4*)(CYR + 128 + ch), gb1 = *(const LAS f32x4*)(CYR + 128 + ch + 4);
        const f32x4 uu0 = *(const LAS f32x4*)(CYR + 256 + ch), uu1 = *(const LAS f32x4*)(CYR + 256 + ch + 4), gn0 = *(const LAS f32x4*)(X + ch), gn1 = *(const LAS f32x4*)(X + ch + 4);
        const f32x4 p0 = *(const f32x4*)(g.cw + gch), p1 = *(const f32x4*)(g.cw + gch + 4), q0 = *(const f32x4*)(g.cw + CSTR + gch), q1 = *(const f32x4*)(g.cw + CSTR + gch + 4);
        const f32x4 r0 = *(const f32x4*)(g.cw + 2 * CSTR + gch), r1 = *(const f32x4*)(g.cw + 2 * CSTR + gch + 4), e0 = *(const f32x4*)(g.cb + gch), e1 = *(const f32x4*)(g.cb + gch + 4);
        const f32x4 x0 = p0 * ga0 + q0 * gb0 + r0 * gn0 + e0, x1 = p1 * ga1 + q1 * gb1 + r1 * gn1 + e1;
        const f32x2 y0 = gelu_pk((f32x2){x0[0], x0[1]}), y1 = gelu_pk((f32x2){x0[2], x0[3]}), y2 = gelu_pk((f32x2){x1[0], x1[1]}), y3 = gelu_pk((f32x2){x1[2], x1[3]});
        u32x4 w; w.x = cvt_pk_bf16(y0.x * uu0[0], y0.y * uu0[1]); w.y = cvt_pk_bf16(y1.x * uu0[2], y1.y * uu0[3]); w.z = cvt_pk_bf16(y2.x * uu1[0], y2.y * uu1[1]); w.w = cvt_pk_bf16(y3.x * uu1[2], y3.y * uu1[3]);
        __builtin_nontemporal_store(w, (u32x4*)(g.O + (row0 - 1) * CSTR + gch));
      }
    }
  } else {
    LAS float* mx = (LAS float*)xch;
    LAS float* sm = (LAS float*)(xch + 4096);
    const float* sbase = uni(g.ssp + (size_t)u.pm * BM * 4);
    bf16_t* obase = uni(g.O + (size_t)u.pm * BM * g.ldc + (size_t)u.pn * BM);
    float rs8[8];
    RSTD_BATCH8(rs8, sbase, ROW8);
    __builtin_amdgcn_sched_barrier(0);
#pragma unroll
    for (int ai = 0; ai < 2; ++ai)
#pragma unroll
      for (int m = 0; m < 4; ++m) {
        const int lr = ai * HALF + rl + m * 16;
        const float sc = rs8[ai * 4 + m];
        float mv = -3.0e38f;
#pragma unroll
        for (int bj = 0; bj < 2; ++bj)
#pragma unroll
          for (int n = 0; n < 2; ++n) { f32x4 v = acc[ai][bj][m][n] * sc; acc[ai][bj][m][n] = v; mv = fmaxf(mv, fmaxf(fmaxf(v[0], v[1]), fmaxf(v[2], v[3]))); }
        mv = fmaxf(mv, __shfl_xor(mv, 16)); mv = fmaxf(mv, __shfl_xor(mv, 32));
        if (fq == 0) mx[lr * 4 + wc] = mv;
      }
    asm volatile("s_waitcnt lgkmcnt(0)" ::: "memory"); __builtin_amdgcn_s_barrier(); asm volatile("" ::: "memory");
#pragma unroll
    for (int ai = 0; ai < 2; ++ai)
#pragma unroll
      for (int m = 0; m < 4; ++m) {
        const int lr = ai * HALF + rl + m * 16;
        const f32x4 m4 = *(const LAS f32x4*)(mx + lr * 4);
        const float M = fmaxf(fmaxf(m4.x, m4.y), fmaxf(m4.z, m4.w));
        float s = 0.f;
#pragma unroll
        for (int bj = 0; bj < 2; ++bj)
#pragma unroll
          for (int n = 0; n < 2; ++n) { f32x4 v = acc[ai][bj][m][n];
            v[0] = __builtin_amdgcn_exp2f(v[0] - M); v[1] = __builtin_amdgcn_exp2f(v[1] - M); v[2] = __builtin_amdgcn_exp2f(v[2] - M); v[3] = __builtin_amdgcn_exp2f(v[3] - M);
            acc[ai][bj][m][n] = v; s += (v[0] + v[1]) + (v[2] + v[3]); }
        s += __shfl_xor(s, 16); s += __shfl_xor(s, 32);
        if (fq == 0) sm[lr * 4 + wc] = s;
      }
    asm volatile("s_waitcnt lgkmcnt(0)" ::: "memory"); __builtin_amdgcn_s_barrier(); asm volatile("" ::: "memory");
#pragma unroll
    for (int ai = 0; ai < 2; ++ai)
#pragma unroll
      for (int m = 0; m < 4; ++m) {
        const int lr = ai * HALF + rl + m * 16;
        const f32x4 s4 = *(const LAS f32x4*)(sm + lr * 4);
        const float inv = 1.0f / ((s4.x + s4.y) + (s4.z + s4.w));
        bf16_t* rowp = (bf16_t*)((char*)obase + (unsigned)(lr * g.ldc + cl) * 2u);
#pragma unroll
        for (int bj = 0; bj < 2; ++bj) {
          const f32x4 v0 = acc[ai][bj][m][0] * inv, v1 = acc[ai][bj][m][1] * inv;
          u32x4 w; w.x = cvt_pk_bf16(v0[0], v0[1]); w.y = cvt_pk_bf16(v0[2], v0[3]); w.z = cvt_pk_bf16(v1[0], v1[1]); w.w = cvt_pk_bf16(v1[2], v1[3]);
          __builtin_nontemporal_store(w, (u32x4*)(rowp + bj * HALF));
        }
      }
  }
}

template <int EPI>
__device__ __forceinline__ void gemm_phase(LAS unsigned char* lds, const Job& g, int G, int c) {
  int tid = threadIdx.x; asm volatile("" : "+v"(tid));
  const int wid = __builtin_amdgcn_readfirstlane(tid >> 6), lane = tid & 63, wr = wid >> 2, wc = wid & 3, fr = lane & 15, fq = lane >> 4;
  const int nt = g.K / BK;
  int c_ = c; asm volatile("" : "+s"(c_));
  StaticOrder S; S.init(g.nM, g.nN, G, c_, g.chain);
  unsigned voffA, voffB;
  { int R, C; stage_rc(tid * 16, R, C); const int Rb = (R & ~31) + perm32(R & 31); voffA = (unsigned)(R * g.lda + C) * 2u; voffB = (unsigned)(Rb * g.ldb + C) * 2u; }
  const size_t rsA = (size_t)64 * g.lda * 2, rsB = (size_t)64 * g.ldb * 2, hA = 2 * rsA, hB = 2 * rsB;
  const size_t kstep = (size_t)(BK * 2);
  const unsigned ldsw = (unsigned)wid * 1024u;
  const int aoff = lds_byte(wr * 64 + fr, fq * 8), boff = lds_byte(wc * 32 + fr, fq * 8);
#define PG8_SA(b, h) (((b) * 2 + (h)) * HTB)
#define PG8_SB(b, h) ((4 + (b) * 2 + (h)) * HTB)
#define PG8_STAGE(bufoff, gbase, voff, rs) do { _Pragma("unroll") for (int _i = 0; _i < 2; ++_i) \
        __builtin_amdgcn_global_load_lds((const unsigned*)((const char*)(gbase) + (size_t)_i * (rs) + (voff)), (LAS unsigned*)(lds + (bufoff) + ldsw + _i * 8192), 16, 0, 0); } while (0)
#define PG8_LDA(dst, b, h) do { _Pragma("unroll") for (int m = 0; m < 4; ++m) _Pragma("unroll") for (int k = 0; k < 2; ++k) dst[m][k] = *(const LAS bf16x8*)(lds + PG8_SA(b, h) + aoff + m * 2048 + k * 1024); } while (0)
#define PG8_LDB(dst, b, h) do { _Pragma("unroll") for (int n = 0; n < 2; ++n) _Pragma("unroll") for (int k = 0; k < 2; ++k) dst[n][k] = *(const LAS bf16x8*)(lds + PG8_SB(b, h) + boff + n * 2048 + k * 1024); } while (0)
#define PG8_MMA(ai, bj, At, Bt) do { __builtin_amdgcn_s_setprio(1); _Pragma("unroll") for (int m = 0; m < 4; ++m) _Pragma("unroll") for (int n = 0; n < 2; ++n) _Pragma("unroll") for (int k = 0; k < 2; ++k) \
        acc[ai][bj][m][n] = __builtin_amdgcn_mfma_f32_16x16x32_bf16(Bt[n][k], At[m][k], acc[ai][bj][m][n], 0, 0, 0); __builtin_amdgcn_s_setprio(0); } while (0)
#define PG8_WAIT_V(n) asm volatile("s_waitcnt vmcnt(" #n ")" ::: "memory")
#define PG8_WAIT_L(n) asm volatile("s_waitcnt lgkmcnt(" #n ")" ::: "memory")
#define PG8_BAR __builtin_amdgcn_s_barrier()
#define PG8_SCHED __builtin_amdgcn_sched_barrier(0)
  Unit cur, nxt; int ui = 0;
  if (!S.next(0, cur)) return;
  const char* gA = uni((const char*)g.A); const char* gB = uni((const char*)g.Bt);
  f32x4 acc[2][2][4][2];
#pragma unroll
  for (int a = 0; a < 2; ++a)
#pragma unroll
    for (int b = 0; b < 2; ++b)
#pragma unroll
      for (int m = 0; m < 4; ++m)
#pragma unroll
        for (int n = 0; n < 2; ++n) acc[a][b][m][n] = (f32x4){0.f, 0.f, 0.f, 0.f};
  bf16x8 At[4][2], B0[2][2], B1[2][2];
  const char* cA = uni(gA + job_aoff(g, cur) * 2); const char* cB = uni(gB + job_boff(g, cur) * 2);
  PG8_STAGE(PG8_SB(0, 0), cB, voffB, rsB); PG8_STAGE(PG8_SB(0, 1), cB + hB, voffB, rsB); PG8_STAGE(PG8_SA(0, 0), cA, voffA, rsA); PG8_STAGE(PG8_SA(0, 1), cA + hA, voffA, rsA);
  if (wr == 1) PG8_BAR;
  PG8_WAIT_V(2); PG8_BAR;
  PG8_STAGE(PG8_SB(1, 0), cB + kstep, voffB, rsB); PG8_STAGE(PG8_SA(1, 0), cA + kstep, voffA, rsA); PG8_STAGE(PG8_SB(1, 1), cB + hB + kstep, voffB, rsB);
  PG8_WAIT_V(6); PG8_BAR;
  for (;;) {
    const bool has_next = S.next(ui + 1, nxt);
    const char* nA = has_next ? uni(gA + job_aoff(g, nxt) * 2) : cA; const char* nB = has_next ? uni(gB + job_boff(g, nxt) * 2) : cB;
    for (int t = 0; t < nt; t += 2) {
      const bool last = (t == nt - 2);
      const char* a1 = cA + (size_t)(t + 1) * kstep;
      const char* a2 = last ? nA : cA + (size_t)(t + 2) * kstep; const char* b2 = last ? nB : cB + (size_t)(t + 2) * kstep;
      const char* a3 = a2 + kstep; const char* b3 = b2 + kstep;
      PG8_LDB(B0, 0, 0); PG8_LDB(B1, 0, 1); PG8_SCHED; PG8_LDA(At, 0, 0); PG8_STAGE(PG8_SA(1, 1), a1 + hA, voffA, rsA);
      PG8_WAIT_V(8); PG8_WAIT_L(0); PG8_BAR; PG8_MMA(0, 0, At, B0); PG8_MMA(0, 1, At, B1); PG8_BAR; PG8_SCHED;
      PG8_LDA(At, 0, 1); PG8_STAGE(PG8_SB(0, 0), b2, voffB, rsB); PG8_STAGE(PG8_SB(0, 1), b2 + hB, voffB, rsB); PG8_STAGE(PG8_SA(0, 0), a2, voffA, rsA);
      PG8_WAIT_V(8); PG8_WAIT_L(0); PG8_BAR; PG8_MMA(1, 0, At, B0); PG8_MMA(1, 1, At, B1); PG8_BAR; PG8_SCHED;
      PG8_LDB(B0, 1, 0); PG8_LDB(B1, 1, 1); PG8_SCHED; PG8_LDA(At, 1, 0); PG8_STAGE(PG8_SA(0, 1), a2 + hA, voffA, rsA);
      PG8_WAIT_V(8); PG8_WAIT_L(0); PG8_BAR; PG8_MMA(0, 0, At, B0); PG8_MMA(0, 1, At, B1); PG8_BAR; PG8_SCHED;
      PG8_LDA(At, 1, 1); PG8_STAGE(PG8_SB(1, 0), b3, voffB, rsB); PG8_STAGE(PG8_SB(1, 1), b3 + hB, voffB, rsB); PG8_STAGE(PG8_SA(1, 0), a3, voffA, rsA);
      PG8_WAIT_V(8); PG8_WAIT_L(0); PG8_BAR; PG8_MMA(1, 0, At, B0); PG8_MMA(1, 1, At, B1); PG8_BAR; PG8_SCHED;
    }
    if (wr == 0) PG8_BAR;
    { int e_fr = fr, e_fq = fq; asm volatile("" : "+v"(e_fr), "+v"(e_fq));
      epilogue<EPI>(acc, g, cur, wr, wc, e_fr, e_fq, lds + XCH_OFF); }
    if (!has_next) break;
#pragma unroll
    for (int a = 0; a < 2; ++a)
#pragma unroll
      for (int b = 0; b < 2; ++b)
#pragma unroll
        for (int m = 0; m < 4; ++m)
#pragma unroll
          for (int n = 0; n < 2; ++n) acc[a][b][m][n] = (f32x4){0.f, 0.f, 0.f, 0.f};
    cur = nxt; cA = nA; cB = nB; ++ui;
    if (wr == 1) PG8_BAR;
  }
  PG8_WAIT_V(0);
  PG8_BAR;
#undef PG8_SA
#undef PG8_SB
#undef PG8_STAGE
#undef PG8_LDA
#undef PG8_LDB
#undef PG8_MMA
#undef PG8_WAIT_V
#undef PG8_WAIT_L
#undef PG8_BAR
#undef PG8_SCHED
}

__device__ __forceinline__ void transpose_item(const float* W, int ldw, int col0, int K, int N, bf16_t* WT, const float* gain, float cs, LAS float* scr, int item, int lane, int permup) {
  const int nblk = N / 32, kb = item / nblk, nb = item % nblk, k0 = 64 * kb, n0 = 32 * nb;
  f32x4 tv[8]; float tg[8];
#pragma unroll
  for (int i = 0; i < 8; ++i) { const int kk = 8 * i + (lane >> 3), nn = (lane & 7) * 4; tv[i] = *(const f32x4*)(W + (size_t)(k0 + kk) * ldw + col0 + n0 + nn); tg[i] = gain ? gain[k0 + kk] : 1.0f; }
  __builtin_amdgcn_sched_barrier(0);
#pragma unroll
  for (int i = 0; i < 8; ++i) { const int kk = 8 * i + (lane >> 3), nn = (lane & 7) * 4; const float gv = tg[i] * cs; const f32x4 v = tv[i];
    LAS float* d = scr + kk * 33 + nn; d[0] = v.x * gv; d[1] = v.y * gv; d[2] = v.z * gv; d[3] = v.w * gv; }
  asm volatile("s_waitcnt lgkmcnt(0)" ::: "memory");
  const int c = lane & 7;
#pragma unroll
  for (int j = 0; j < 4; ++j) { const int n = (lane >> 3) + 8 * j; const LAS float* s = scr + (8 * c) * 33 + n;
    u32x4 o; o.x = cvt_pk_bf16(s[0 * 33], s[1 * 33]); o.y = cvt_pk_bf16(s[2 * 33], s[3 * 33]); o.z = cvt_pk_bf16(s[4 * 33], s[5 * 33]); o.w = cvt_pk_bf16(s[6 * 33], s[7 * 33]);
    const int nn = n0 + n; const int nr = (permup == 1) ? (((nn & 2047) >> 7) * 256 + (nn >> 11) * 128 + (nn & 127)) : (permup == 2) ? (((nn & 1023) >> 7) * 256 + (nn >> 10) * 128 + (nn & 127)) : nn;
    *(u32x4*)(WT + (size_t)nr * K + k0 + 8 * c) = o; }
  asm volatile("s_waitcnt lgkmcnt(0)" ::: "memory");
}
struct TrDesc { const float* W; int ldw, col0, K, N; bf16_t* WT; const float* gain; float cs; int nitems; int permup; };
__device__ __forceinline__ TrDesc tr_desc(bf16_t* wb, int d) {
  TrDesc t; t.cs = 1.0f; t.gain = nullptr; t.col0 = 0; t.permup = 0;
  if (d < 8) {
    const int j = d >> 2, w = d & 3; bf16_t* e = wb + W_EVEN + (size_t)j * W_EVEN_SZ;
    if (w < 3) { t.W = kin(4) + (size_t)j * DM * 2048; t.ldw = 2048; t.col0 = 512 + 512 * w; t.K = DM; t.N = 512; t.gain = kin(3) + (size_t)(2 * j) * DM;
      t.WT = (w == 0) ? e + (size_t)1024 * DM : (w == 1) ? e + (size_t)1536 * DM : e + (size_t)512 * DM;
      if (w == 0) t.cs = 0.08838834764831845f * LOG2E; }
    else { t.W = kin(6) + (size_t)j * DM * DM; t.ldw = DM; t.K = DM; t.N = DM; t.WT = e + (size_t)2048 * DM; }
  } else if (d < 14) {
    const int j = (d - 8) / 3, w = (d - 8) % 3; bf16_t* o = wb + W_ODD + (size_t)j * W_ODD_SZ;
    if (w == 0) { t.W = kin(7) + (size_t)j * DM * 3072; t.ldw = 3072; t.K = DM; t.N = 1024; t.gain = kin(3) + (size_t)(2 * j + 1) * DM; t.WT = o; }
    else if (w == 2) { t.W = kin(7) + (size_t)j * DM * 3072; t.ldw = 3072; t.col0 = 1024; t.K = DM; t.N = 2048; t.gain = kin(3) + (size_t)(2 * j + 1) * DM; t.WT = o + (size_t)1024 * DM; t.permup = 2; }
    else { t.W = kin(9) + (size_t)j * DM * DM; t.ldw = DM; t.K = DM; t.N = DM; t.WT = o + (size_t)3072 * DM; }
  } else {
    const int l = (d - 14) >> 2, w = (d - 14) & 3; bf16_t* y = wb + W_LAY + (size_t)l * W_LAY_SZ;
    if (w == 0) { t.W = kin(12) + (size_t)l * DM * 2048; t.ldw = 2048; t.K = DM; t.N = 2048; t.WT = y + (size_t)1024 * DM; }
    else if (w == 1) { t.W = kin(13) + (size_t)l * DM * DM; t.ldw = DM; t.K = DM; t.N = DM; t.WT = y + (size_t)3072 * DM; }
    else if (w == 2) { t.W = kin(15) + (size_t)l * DM * 4096; t.ldw = 4096; t.K = DM; t.N = 4096; t.gain = kin(14) + (size_t)l * DM; t.WT = y + (size_t)4096 * DM; t.permup = 1; }
    else { t.W = kin(18) + (size_t)l * DFF * DM; t.ldw = DM; t.K = DFF; t.N = DM; t.WT = y + (size_t)8192 * DM; }
  }
  t.nitems = (t.K / 64) * (t.N / 32);
  return t;
}

__device__ __forceinline__ void prologue(LAS unsigned char* lds) {
  int tid_ = threadIdx.x; asm volatile("" : "+v"(tid_));
  const int lane = tid_ & 63, wave = __builtin_amdgcn_readfirstlane(tid_ >> 6), gwave = (int)blockIdx.x * 8 + wave, ngw = (int)gridDim.x * 8;
  unsigned char* ws = kws();
  bf16_t* wb = (bf16_t*)(ws + WS_W);
  LAS float* scr = (LAS float*)(lds + wave * 16384);
  for (int d = 0; d < 30; ++d) {
    const TrDesc t = tr_desc(wb, d);
    for (int it = (gwave + d * 293) % ngw; it < t.nitems; it += ngw) transpose_item(t.W, t.ldw, t.col0, t.K, t.N, t.WT, t.gain, t.cs, scr, it, lane, t.permup);
  }
  {
    const size_t n4 = (size_t)DEPTH * DM * DM / 4;
    for (size_t i = (size_t)gwave * 64 + lane; i < n4; i += (size_t)ngw * 64) {
      const size_t e = i * 4; const int l = (int)(e / ((size_t)DM * DM)); const size_t r = e % ((size_t)DM * DM); const int k = (int)(r / DM);
      const f32x4 v = *(const f32x4*)(kin(11) + e); const float gv = kin(10)[l * DM + k] * (0.0625f * LOG2E);
      u32x2 w; w.x = cvt_pk_bf16(v[0] * gv, v[1] * gv); w.y = cvt_pk_bf16(v[2] * gv, v[3] * gv);
      *(u32x2*)(wb + W_LAY + (size_t)l * W_LAY_SZ + r) = w;
    }
  }
  LAS float* T = (LAS float*)(lds + RING_BYTES - 16384);
  __syncthreads();
  LAS float* T128 = (LAS float*)(lds + XCH_OFF);
  for (int i = tid_; i < 4096; i += 512) T[i] = cospif((float)i * (1.0f / 2048.0f));
  if (tid_ < 128) T128[tid_] = cospif((float)tid_ * (1.0f / 64.0f));
  __syncthreads();
  {
    bf16_t* F = (bf16_t*)(ws + WS_FCAT);
    const size_t nchunk = (size_t)4096 * 8192 / 8;
    for (size_t ci = (size_t)gwave * 64 + lane; ci < nchunk; ci += (size_t)ngw * 64) {
      const int s = (int)(ci >> 10), k0 = (int)(ci & 1023) * 8;
      float v[8];
#pragma unroll
      for (int j = 0; j < 8; ++j) { const int k = k0 + j; const int sr = s & 2047; const int idx = (k < 4096) ? ((sr * k) & 4095) : ((sr * (k - 4096) + ((s < 2048) ? 1024 : 3072)) & 4095); v[j] = T[idx]; }
      u32x4 w; w.x = cvt_pk_bf16(v[0], v[1]); w.y = cvt_pk_bf16(v[2], v[3]); w.z = cvt_pk_bf16(v[4], v[5]); w.w = cvt_pk_bf16(v[6], v[7]);
      *(u32x4*)(F + ci * 8) = w;
    }
  }
  for (int it = gwave; it < 2 * 1024 * 4; it += ngw) {
    const int j = it >> 12, k = (it >> 2) & 1023, gq = it & 3;
    const float* wrow = kin(4) + ((size_t)j * DM + k) * 2048 + gq * 128;
    const float gv = kin(3)[(2 * j) * DM + k];
    const float w0 = wrow[lane] * gv, w1 = wrow[64 + lane] * gv;
    float ac0 = 0.f, ac1 = 0.f, as0 = 0.f;
#pragma unroll 8
    for (int c = 0; c < 128; ++c) {
      const float wv = (c < 64) ? __shfl(w0, c) : __shfl(w1, c - 64);
      const int i0 = (c * lane) & 127, i1 = (c * (lane + 64)) & 127;
      ac0 += wv * T128[i0]; as0 += wv * T128[(i0 + 96) & 127];
      ac1 += wv * T128[i1];
    }
    bf16_t* e = wb + W_EVEN + (size_t)j * W_EVEN_SZ;
    e[(size_t)(gq * 64 + lane) * DM + k] = (bf16_t)(cvt_pk_bf16(ac0, 0.f) & 0xffff);
    if (lane == 0) e[(size_t)(256 + gq) * DM + k] = (bf16_t)(cvt_pk_bf16(ac1, 0.f) & 0xffff);
    else e[(size_t)(260 + gq * 63 + lane - 1) * DM + k] = (bf16_t)(cvt_pk_bf16(as0, 0.f) & 0xffff);
  }
  for (int r = gwave; r < NB * NMEM; r += ngw) {
    const f32x4* xr = (const f32x4*)(kin(1) + (size_t)r * DM) + lane; f32x4 v[4]; float s = 0.f;
#pragma unroll
    for (int j = 0; j < 4; ++j) { v[j] = xr[64 * j]; s += (v[j].x * v[j].x + v[j].y * v[j].y) + (v[j].z * v[j].z + v[j].w * v[j].w); }
    const float rs = rsqrtf(wave_sum(s) * (1.0f / DM) + EPS);
    u32x2* o = (u32x2*)((bf16_t*)(ws + WS_MB) + (size_t)r * DM) + lane;
#pragma unroll
    for (int j = 0; j < 4; ++j) { const f32x4 gg = *((const f32x4*)kin(2) + lane + 64 * j);
      u32x2 w; w.x = cvt_pk_bf16(v[j].x * rs * gg.x, v[j].y * rs * gg.y); w.y = cvt_pk_bf16(v[j].z * rs * gg.z, v[j].w * rs * gg.w); o[64 * j] = w; }
  }
  {
    const float* xin = kin(0); bf16_t* hbp = (bf16_t*)(ws + WS_HB); float* sspp = (float*)(ws + WS_SSP);
    for (int r = gwave; r < NTOK; r += 4 * ngw) {
      f32x4 v[4][4];
#pragma unroll
      for (int q = 0; q < 4; ++q) { const int rq = min(r + q * ngw, NTOK - 1); const f32x4* xr = (const f32x4*)(xin + (size_t)rq * DM) + lane;
#pragma unroll
        for (int j = 0; j < 4; ++j) v[q][j] = xr[64 * j]; }
#pragma unroll
      for (int q = 0; q < 4; ++q) { float sq = 0.f;
#pragma unroll
        for (int j = 0; j < 4; ++j) sq += (v[q][j].x * v[q][j].x + v[q][j].y * v[q][j].y) + (v[q][j].z * v[q][j].z + v[q][j].w * v[q][j].w);
        sq = wave_sum(sq);
        if (r + q * ngw >= NTOK) continue;
        u32x2* o = (u32x2*)(hbp + (size_t)(r + q * ngw) * DM) + lane;
#pragma unroll
        for (int j = 0; j < 4; ++j) { u32x2 w; w.x = cvt_pk_bf16(v[q][j].x, v[q][j].y); w.y = cvt_pk_bf16(v[q][j].z, v[q][j].w); o[64 * j] = w; }
        if (lane == 0) *(f32x4*)(sspp + (size_t)(r + q * ngw) * 4) = (f32x4){sq, 0.f, 0.f, 0.f}; }
    }
  }
}

__device__ __forceinline__ void natten_phase(const bf16_t* QK, const bf16_t* VT, bf16_t* Y, const float* rpb, LAS float* rpbs) {
  int tid_ = threadIdx.x; asm volatile("" : "+v"(tid_));
  const int lane = tid_ & 63, wave = __builtin_amdgcn_readfirstlane(tid_ >> 6);
  for (int i = tid_; i < 4 * 15 * 31; i += 512) rpbs[i] = rpb[i] * LOG2E;
  __syncthreads();
  const int n = lane & 15, g = lane >> 4;
  const int keyl = 8 * (n >> 2) + (n & 3);
  for (int slot = (int)blockIdx.x; slot < 256; slot += (int)gridDim.x)
  for (int it = 0; it < 4; ++it) {
    const int u = (slot * 4 + it) * 8 + wave;
    const int jb = u & 3, ip = (u >> 2) & 31, h = (u >> 7) & 3, b = u >> 9;
    const int i0 = 2 * ip;
    const int rs0 = min(max(i0 - 4, 0), 56), d1 = min(max(i0 - 3, 0), 56) - rs0;
    const int c0 = (jb == 0) ? 0 : (jb == 1) ? 8 : (jb == 2) ? 24 : 32;
    const int j = jb * 16 + n; const int cs = min(max(j - 8, 0), 48);
    const size_t tq = (size_t)b * SEQ + i0 * 64 + j;
    bf16x8 qf[2][4];
#pragma unroll
    for (int q = 0; q < 2; ++q)
#pragma unroll
      for (int ks = 0; ks < 4; ++ks) qf[q][ks] = *(const bf16x8*)(QK + (tq + q * 64) * 1024 + h * 128 + ks * 32 + 8 * g);
    f32x4 sc[2][9][2];
#pragma unroll
    for (int ur = 0; ur < 9; ++ur) {
      const int krow = min(rs0 + ur, 63);
      const size_t tk0 = (size_t)b * SEQ + (size_t)krow * 64 + c0;
      bf16x8 kf[2][4];
#pragma unroll
      for (int t = 0; t < 2; ++t) {
        const bf16_t* kp = QK + (tk0 + keyl + 4 * t) * 1024 + 512 + h * 128 + 8 * g;
#pragma unroll
        for (int ks = 0; ks < 4; ++ks) kf[t][ks] = *(const bf16x8*)(kp + ks * 32);
      }
      __builtin_amdgcn_sched_barrier(0);
#pragma unroll
      for (int t = 0; t < 2; ++t) {
        f32x4 a0 = (f32x4){0.f, 0.f, 0.f, 0.f}, a1 = a0;
#pragma unroll
        for (int ks = 0; ks < 4; ++ks) { a0 = __builtin_amdgcn_mfma_f32_16x16x32_bf16(kf[t][ks], qf[0][ks], a0, 0, 0, 0); a1 = __builtin_amdgcn_mfma_f32_16x16x32_bf16(kf[t][ks], qf[1][ks], a1, 0, 0, 0); }
        sc[0][ur][t] = a0; sc[1][ur][t] = a1;
      }
      __builtin_amdgcn_sched_barrier(0);
    }
    float inv[2];
#pragma unroll
    for (int q = 0; q < 2; ++q) {
      const int dq = q ? d1 : 0, iq = i0 + q;
      float mx = -3.0e38f;
#pragma unroll
      for (int ur = 0; ur < 9; ++ur) {
        const bool rowv = (unsigned)(ur - dq) < 8u;
        const LAS float* brow = rpbs + h * 465 + min(max(rs0 + ur - iq + 7, 0), 14) * 31;
#pragma unroll
        for (int t = 0; t < 2; ++t)
#pragma unroll
          for (int v = 0; v < 4; ++v) {
            const int kc = c0 + 8 * g + 4 * t + v;
            const bool valid = rowv && (kc >= cs) && (kc < cs + 16);
            const int co = min(max(kc - j + 15, 0), 30);
            const float s = valid ? sc[q][ur][t][v] + brow[co] : -3.0e38f;
            sc[q][ur][t][v] = s; mx = fmaxf(mx, s);
          }
      }
      mx = fmaxf(mx, __shfl_xor(mx, 16)); mx = fmaxf(mx, __shfl_xor(mx, 32));
      float sum = 0.f;
#pragma unroll
      for (int ur = 0; ur < 9; ++ur)
#pragma unroll
        for (int t = 0; t < 2; ++t)
#pragma unroll
          for (int v = 0; v < 4; ++v) { const float e = __builtin_amdgcn_exp2f(sc[q][ur][t][v] - mx); sc[q][ur][t][v] = e; sum += e; }
      sum += __shfl_xor(sum, 16); sum += __shfl_xor(sum, 32);
      inv[q] = 1.0f / sum;
    }
    f32x4 o[2][8];
#pragma unroll
    for (int q = 0; q < 2; ++q)
#pragma unroll
      for (int dt = 0; dt < 8; ++dt) o[q][dt] = (f32x4){0.f, 0.f, 0.f, 0.f};
    bf16x8 pf[2][9];
#pragma unroll
    for (int ur = 0; ur < 9; ++ur)
#pragma unroll
      for (int q = 0; q < 2; ++q) { u32x4 pw; pw.x = cvt_pk_bf16(sc[q][ur][0][0], sc[q][ur][0][1]); pw.y = cvt_pk_bf16(sc[q][ur][0][2], sc[q][ur][0][3]); pw.z = cvt_pk_bf16(sc[q][ur][1][0], sc[q][ur][1][1]); pw.w = cvt_pk_bf16(sc[q][ur][1][2], sc[q][ur][1][3]);
        pf[q][ur] = __builtin_bit_cast(bf16x8, pw); }
    bf16x8 vf[2][8];
    { const bf16_t* vp = VT + (size_t)(h * 128 + n) * NTOK + (size_t)b * SEQ + (size_t)min(rs0, 63) * 64 + c0 + 8 * g;
#pragma unroll
      for (int dt = 0; dt < 8; ++dt) vf[0][dt] = *(const bf16x8*)(vp + (size_t)dt * 16 * NTOK); }
#pragma unroll
    for (int ur = 0; ur < 9; ++ur) {
      if (ur + 1 < 9) { const bf16_t* vp = VT + (size_t)(h * 128 + n) * NTOK + (size_t)b * SEQ + (size_t)min(rs0 + ur + 1, 63) * 64 + c0 + 8 * g;
#pragma unroll
        for (int dt = 0; dt < 8; ++dt) vf[(ur + 1) & 1][dt] = *(const bf16x8*)(vp + (size_t)dt * 16 * NTOK); }
      __builtin_amdgcn_sched_barrier(0);
#pragma unroll
      for (int dt = 0; dt < 8; ++dt) { o[0][dt] = __builtin_amdgcn_mfma_f32_16x16x32_bf16(vf[ur & 1][dt], pf[0][ur], o[0][dt], 0, 0, 0); o[1][dt] = __builtin_amdgcn_mfma_f32_16x16x32_bf16(vf[ur & 1][dt], pf[1][ur], o[1][dt], 0, 0, 0); }
      __builtin_amdgcn_sched_barrier(0);
    }
#pragma unroll
    for (int q = 0; q < 2; ++q) {
      bf16_t* yp = Y + (tq + q * 64) * 1024 + 512 + h * 128 + 4 * g;
#pragma unroll
      for (int dt = 0; dt < 8; ++dt) { u32x2 w; w.x = cvt_pk_bf16(o[q][dt][0] * inv[q], o[q][dt][1] * inv[q]); w.y = cvt_pk_bf16(o[q][dt][2] * inv[q], o[q][dt][3] * inv[q]); *(u32x2*)(yp + dt * 16) = w; }
    }
  }
}

__device__ __forceinline__ void dft_mid_row(const bf16_t* DT, bf16_t* Y, float scale) {
  int tid_ = threadIdx.x; asm volatile("" : "+v"(tid_));
  const int lane = tid_ & 63, gwave = (int)blockIdx.x * 8 + (tid_ >> 6), ngw = (int)gridDim.x * 8;
  for (int it = gwave; it < NB * 512; it += ngw) {
    const bf16_t* row = DT + (size_t)it * 8192;
    float s = 0.f; u32x4 rv[8];
#pragma unroll
    for (int i = 0; i < 8; ++i) rv[i] = *(const u32x4*)(row + (i * 64 + lane) * 8);
    __builtin_amdgcn_sched_barrier(0);
#pragma unroll
    for (int i = 0; i < 8; ++i) { float f[8]; unpack8(rv[i], f); s += (f[0] - f[1]) + (f[2] - f[3]) + (f[4] - f[5]) + (f[6] - f[7]); }
    s = wave_sum(s);
    if (lane == 0) { const int b = it >> 9, r = it & 511, c = 128 * ((r >> 6) & 3) + 64 * (r >> 8) + (r & 63); Y[((size_t)b * SEQ + 2048) * DM + c] = (bf16_t)(cvt_pk_bf16(s * scale, 0.f) & 0xffffu); }
  }
}
__device__ __forceinline__ void ffn_conv_phase(bf16_t* Z, const float* cw, const float* cb) {
  constexpr int R = 32;
  int tid_ = threadIdx.x; asm volatile("" : "+v"(tid_));
  const int gthread = (int)blockIdx.x * 512 + tid_, nthreads = (int)gridDim.x * 512;
  for (int item = gthread; item < (NTOK / R) * 256; item += nthreads) {
    const int cgp = item & 255, run = item >> 8, c = cgp * 8;
    float w0[8], w1[8], w2[8], bb[8];
#pragma unroll
    for (int j = 0; j < 8; ++j) { w0[j] = cw[c + j]; w1[j] = cw[DFF + c + j]; w2[j] = cw[2 * DFF + c + j]; bb[j] = cb[c + j]; }
    const size_t t0 = (size_t)run * R; const int s0 = (int)(t0 & (SEQ - 1));
    bf16_t* zp = Z + t0 * 4096 + c;
    float prev[8], cur[8], nxt[8];
    if (s0 == 0) {
#pragma unroll
      for (int j = 0; j < 8; ++j) prev[j] = 0.f;
    } else unpack8(*(const u32x4*)(zp - 4096 + DFF), prev);
    unpack8(*(const u32x4*)(zp + DFF), cur);
#pragma unroll 4
    for (int r = 0; r < R; ++r) {
      if (s0 + r + 1 < SEQ) unpack8(*(const u32x4*)(zp + (size_t)(r + 1) * 4096 + DFF), nxt);
      else {
#pragma unroll
        for (int j = 0; j < 8; ++j) nxt[j] = 0.f;
      }
      float uu[8]; unpack8(*(const u32x4*)(zp + (size_t)r * 4096), uu);
      float a[8];
#pragma unroll
      for (int j = 0; j < 8; j += 2) {
        f32x2 gv; gv.x = w0[j] * prev[j] + w1[j] * cur[j] + w2[j] * nxt[j] + bb[j]; gv.y = w0[j + 1] * prev[j + 1] + w1[j + 1] * cur[j + 1] + w2[j + 1] * nxt[j + 1] + bb[j + 1];
        const f32x2 ge = gelu_pk(gv); a[j] = ge.x * uu[j]; a[j + 1] = ge.y * uu[j + 1];
      }
      u32x4 w; w.x = cvt_pk_bf16(a[0], a[1]); w.y = cvt_pk_bf16(a[2], a[3]); w.z = cvt_pk_bf16(a[4], a[5]); w.w = cvt_pk_bf16(a[6], a[7]);
      *(u32x4*)(zp + (size_t)r * 4096) = w;
#pragma unroll
      for (int j = 0; j < 8; ++j) { prev[j] = cur[j]; cur[j] = nxt[j]; }
    }
  }
}
__device__ __forceinline__ void gconv_phase(const bf16_t* ZC, bf16_t* Y, const float* cw) {
  constexpr int R = 32;
  int tid_ = threadIdx.x; asm volatile("" : "+v"(tid_));
  const int gthread = (int)blockIdx.x * 512 + tid_, nthreads = (int)gridDim.x * 512;
  for (int item = gthread; item < (NTOK / R) * 128; item += nthreads) {
    const int cgp = item & 127, run = item >> 7, c = cgp * 8;
    float w0[8], w1[8], w2[8];
#pragma unroll
    for (int j = 0; j < 8; ++j) { w0[j] = cw[c + j]; w1[j] = cw[DM + c + j]; w2[j] = cw[2 * DM + c + j]; }
    const size_t t0 = (size_t)run * R; const int s0 = (int)(t0 & (SEQ - 1));
    const bf16_t* zp = ZC + t0 * 3072 + c;
    float prev[8], cur[8], nxt[8], ta[8], tb[8];
    if (s0 == 0) {
#pragma unroll
      for (int j = 0; j < 8; ++j) prev[j] = 0.f;
    } else { unpack8(*(const u32x4*)(zp - 3072 + 1024), ta); unpack8(*(const u32x4*)(zp - 3072 + 2048), tb);
#pragma unroll
      for (int j = 0; j < 8; ++j) prev[j] = ta[j] * tb[j]; }
    unpack8(*(const u32x4*)(zp + 1024), ta); unpack8(*(const u32x4*)(zp + 2048), tb);
#pragma unroll
    for (int j = 0; j < 8; ++j) cur[j] = ta[j] * tb[j];
#pragma unroll 4
    for (int r = 0; r < R; ++r) {
      if (s0 + r + 1 < SEQ) { unpack8(*(const u32x4*)(zp + (size_t)(r + 1) * 3072 + 1024), ta); unpack8(*(const u32x4*)(zp + (size_t)(r + 1) * 3072 + 2048), tb);
#pragma unroll
        for (int j = 0; j < 8; ++j) nxt[j] = ta[j] * tb[j]; }
      else {
#pragma unroll
        for (int j = 0; j < 8; ++j) nxt[j] = 0.f;
      }
      float gb[8]; unpack8(*(const u32x4*)(zp + (size_t)r * 3072), gb);
      float a[8];
#pragma unroll
      for (int j = 0; j < 8; ++j) a[j] = gb[j] * (w0[j] * prev[j] + w1[j] * cur[j] + w2[j] * nxt[j]);
      u32x4 w; w.x = cvt_pk_bf16(a[0], a[1]); w.y = cvt_pk_bf16(a[2], a[3]); w.z = cvt_pk_bf16(a[4], a[5]); w.w = cvt_pk_bf16(a[6], a[7]);
      *(u32x4*)(Y + (t0 + r) * 1024 + c) = w;
#pragma unroll
      for (int j = 0; j < 8; ++j) { prev[j] = cur[j]; cur[j] = nxt[j]; }
    }
  }
}

#define XB_TMO      128
#define XB_XCNT(j)  (256  + 64 * (j))
#define XB_XSUB(j)  (1280 + 64 * (j))
#define XB_XGEN(j)  (2304 + 64 * (j))
#define XB_TOP      3328
#define XB_TOPGEN   3392
#define XCD_BAR_WORDS 3456
#define XB_SPIN_CAP (1u << 18)
__device__ __forceinline__ unsigned xb_ld(unsigned* p)              { return __hip_atomic_load(p, __ATOMIC_RELAXED, __HIP_MEMORY_SCOPE_AGENT); }
__device__ __forceinline__ unsigned xb_add(unsigned* p, unsigned v) { return __hip_atomic_fetch_add(p, v, __ATOMIC_RELAXED, __HIP_MEMORY_SCOPE_AGENT); }
__device__ __forceinline__ unsigned xb_xcc_id() { return (unsigned)__builtin_amdgcn_s_getreg((3 << 11) | 20) & 0xFu; }
#define XB_SPIN(cond, bar) do { unsigned _sp = 0; while (cond) { __builtin_amdgcn_s_sleep(1); \
    if ((++_sp & 255u) == 0u) { if (xb_ld(&(bar)[XB_TMO])) break; if (_sp > XB_SPIN_CAP) { atomicAdd(&(bar)[XB_TMO], 1u); break; } } } } while (0)
__device__ __forceinline__ void xcd_barrier_complete(unsigned* bar, unsigned x, unsigned& nloc, unsigned& nx) {
  const unsigned G = gridDim.x * gridDim.y * gridDim.z;
  unsigned sum, cnt, mine, sp = 0u;
  for (;;) {
    sum = 0u; cnt = 0u; mine = 0u;
#pragma unroll
    for (unsigned j = 0; j < 16; ++j) { const unsigned c = xb_ld(&bar[XB_XCNT(j)]); sum += c; cnt += (c > 0u) ? 1u : 0u; mine = (j == x) ? c : mine; }
    if (sum == G) break;
    __builtin_amdgcn_s_sleep(1);
    if ((++sp & 255u) == 0u) { if (xb_ld(&bar[XB_TMO])) break; if (sp > XB_SPIN_CAP) { atomicAdd(&bar[XB_TMO], 1u); break; } }
  }
  nloc = mine > 0u ? mine : 1u; nx = cnt > 0u ? cnt : 1u;
}
__device__ __forceinline__ void xcd_barrier(volatile LAS unsigned* st) {
  asm volatile("s_waitcnt vmcnt(0)" ::: "memory");
  __syncthreads();
  if (threadIdx.x == 0) {
    unsigned* bar = (unsigned*)kws();
    const unsigned x = xb_xcc_id();
    __builtin_amdgcn_s_waitcnt(0);
    unsigned nloc = st[0], nx = st[1];
    if (nloc == 0u) { xcd_barrier_complete(bar, x, nloc, nx); st[0] = nloc; st[1] = nx; }
    const unsigned old = xb_add(&bar[XB_XSUB(x)], 1u);
    const unsigned gen = old / nloc;
    if (old + 1u == (gen + 1u) * nloc) {
      __builtin_amdgcn_fence(__ATOMIC_RELEASE, "agent");
      asm volatile("s_waitcnt vmcnt(0)" ::: "memory");
      const unsigned og = xb_add(&bar[XB_TOP], 1u);
      const unsigned tg = og / nx;
      if (og + 1u == (tg + 1u) * nx) xb_add(&bar[XB_TOPGEN], 1u);
      else XB_SPIN(xb_ld(&bar[XB_TOPGEN]) == tg, bar);
      __builtin_amdgcn_fence(__ATOMIC_ACQUIRE, "agent");
      xb_add(&bar[XB_XGEN(x)], 1u);
      asm volatile("s_waitcnt vmcnt(0)" ::: "memory");
    } else {
      XB_SPIN(xb_ld(&bar[XB_XGEN(x)]) == gen, bar);
      __builtin_amdgcn_fence(__ATOMIC_ACQUIRE, "agent");
      asm volatile("s_waitcnt vmcnt(0)" ::: "memory");
    }
  }
  __syncthreads();
}

__device__ __forceinline__ Job job_kv(unsigned char* ws, int l) {
  bf16_t* wl = (bf16_t*)(ws + WS_W) + W_LAY + (size_t)l * W_LAY_SZ;
  return job_std((bf16_t*)(ws + WS_MB), DM, wl + (size_t)1024 * DM, DM, DM, 16, 8, (bf16_t*)(ws + WS_KV), 2048);
}
__device__ __forceinline__ Job job_qk(unsigned char* ws, int l) {
  bf16_t* wl = (bf16_t*)(ws + WS_W) + W_LAY + (size_t)l * W_LAY_SZ;
  Job j = job_std((bf16_t*)(ws + WS_KV), 2048, wl, DM, 256, 64, 4, (bf16_t*)(ws + WS_WQK), DM);
  j.adiv = 4; j.a1 = 256 * 2048; j.a0 = 256; j.bdiv = 4; j.b1 = 0; j.b0 = 256; j.b2 = 256 * DM;
  return j;
}
__device__ __forceinline__ Job job_vo(unsigned char* ws, int l) {
  bf16_t* wl = (bf16_t*)(ws + WS_W) + W_LAY + (size_t)l * W_LAY_SZ;
  Job j = job_std(wl + (size_t)3072 * DM, DM, (bf16_t*)(ws + WS_KV) + 1024, 2048, 256, 16, 16, (bf16_t*)(ws + WS_VWO), DM);
  j.adiv = 4; j.a0 = 256 * DM; j.a1 = 256; j.bdiv = 4; j.b1 = 256; j.b0 = 0; j.b2 = 256 * 2048;
  j.odiv = 4; j.r1 = 0; j.r0 = 256; j.r2 = 1024; j.c1 = 256; j.c0 = 0; j.c2 = 0;
  return j;
}

__global__ void __launch_bounds__(512, 2) fwd_megakernel(Params p) {
  extern __shared__ __attribute__((aligned(16))) unsigned char lds_raw[];
  LAS unsigned char* lds = (LAS unsigned char*)lds_raw;
  cg::grid_group grid = cg::this_grid();
  const int G = gridDim.x, bx = blockIdx.x;

  volatile LAS unsigned* barst = (volatile LAS unsigned*)(lds + BARST_OFF);
  if (threadIdx.x < 4) barst[threadIdx.x] = 0u;
  if (bx == 0) { unsigned* bar = (unsigned*)kws(); for (int i = threadIdx.x; i < XCD_BAR_WORDS; i += 512) bar[i] = 0u; }
#ifndef NO_PRO
  prologue(lds);
#endif
  grid.sync();
  if (threadIdx.x == 0) (void)xb_add(&((unsigned*)kws())[XB_XCNT(xb_xcc_id())], 1u);
#define GRID_SYNC() xcd_barrier(barst)

#pragma unroll 1
  for (int l = 0; l < DEPTH; ++l) {
    const int jx = l >> 1;
    if ((l & 1) == 0) {
      { unsigned char* ws = kws(); bf16_t* we = (bf16_t*)(ws + WS_W) + W_EVEN + (size_t)jx * W_EVEN_SZ;
        Job js = job_std(we, DM, (bf16_t*)(ws + WS_HB), DM, DM, 4, 256, (bf16_t*)(ws + WS_Z + Z_DT), 0); js.ssp = (float*)(ws + WS_SSP); js.O2 = (bf16_t*)(ws + WS_Z + Z_VT);
        gemm_phase<EPI_SWAP>(lds, js, G, bx); }
      { unsigned char* ws = kws(); bf16_t* we = (bf16_t*)(ws + WS_W) + W_EVEN + (size_t)jx * W_EVEN_SZ;
        Job jq = job_std((bf16_t*)(ws + WS_HB), DM, we + (size_t)1024 * DM, DM, DM, 256, 4, (bf16_t*)(ws + WS_Z + Z_QK), DM); jq.ssp = (float*)(ws + WS_SSP);
        gemm_phase<EPI_SCALE>(lds, jq, G, bx); }
      { const Job jkv = job_kv(kws(), l); gemm_phase<EPI_SCALE>(lds, jkv, G, bx); }
      GRID_SYNC();
      { unsigned char* ws = kws();
        Job jd = job_std((bf16_t*)(ws + WS_FCAT), 8192, (bf16_t*)(ws + WS_Z + Z_DT), 8192, 8192, 128, 2, (bf16_t*)(ws + WS_Z + Z_YE), DM);
        jd.adiv = 8; jd.a0 = 256 * 8192; jd.a1 = 0; jd.a2 = 2048 * 8192;     jd.bdiv = 8; jd.b1 = 512 * 8192; jd.b0 = 0; jd.b2 = 256 * 8192; jd.cscale = 0.0013810679320049757f;
        jd.chain = 4;
        gemm_phase<EPI_DFT>(lds, jd, G, bx);
        dft_mid_row((bf16_t*)(ws + WS_Z + Z_DT), (bf16_t*)(ws + WS_Z + Z_YE), 0.0013810679320049757f); }
      { const Job jqk = job_qk(kws(), l); gemm_phase<EPI_SCALE>(lds, jqk, G, bx); }
      { const Job jvo = job_vo(kws(), l); gemm_phase<EPI_SCALE>(lds, jvo, G, bx); }
#ifndef NO_NATTEN
      { unsigned char* ws = kws();
        natten_phase((bf16_t*)(ws + WS_Z + Z_QK), (bf16_t*)(ws + WS_Z + Z_VT), (bf16_t*)(ws + WS_Z + Z_YE), kin(5) + (size_t)jx * 4 * 15 * 31, (LAS float*)(lds + XCH_OFF)); }
#endif
      GRID_SYNC();
    } else {
      { unsigned char* ws = kws(); bf16_t* wo = (bf16_t*)(ws + WS_W) + W_ODD + (size_t)jx * W_ODD_SZ;
        Job ji = job_std((bf16_t*)(ws + WS_HB), DM, wo, DM, DM, 256, 4, (bf16_t*)(ws + WS_Z), DM); ji.ssp = (float*)(ws + WS_SSP);
        gemm_phase<EPI_SCALE>(lds, ji, G, bx); }
      { const Job jkv = job_kv(kws(), l); gemm_phase<EPI_SCALE>(lds, jkv, G, bx); }
      GRID_SYNC();
      { unsigned char* ws = kws(); bf16_t* wo = (bf16_t*)(ws + WS_W) + W_ODD + (size_t)jx * W_ODD_SZ;
        Job jc = job_std((bf16_t*)(ws + WS_HB) - DM, DM, wo + (size_t)1024 * DM, DM, DM, 272, 8, (bf16_t*)(ws + WS_Z + Z_YO), DM); jc.ssp = (float*)(ws + WS_SSP);
        jc.adiv = 17; jc.a1 = SEQ * DM; jc.a0 = 254 * DM; jc.cw = kin(8) + (size_t)jx * 3 * DM; jc.GB = (const bf16_t*)(ws + WS_Z);
        gemm_phase<EPI_GCONV>(lds, jc, G, bx); }
      { const Job jqk = job_qk(kws(), l); gemm_phase<EPI_SCALE>(lds, jqk, G, bx); }
      { const Job jvo = job_vo(kws(), l); gemm_phase<EPI_SCALE>(lds, jvo, G, bx); }
      GRID_SYNC();
    }
    { unsigned char* ws = kws(); bf16_t* wb = (bf16_t*)(ws + WS_W);
      const bf16_t* wout = ((l & 1) == 0) ? wb + W_EVEN + (size_t)jx * W_EVEN_SZ + (size_t)2048 * DM : wb + W_ODD + (size_t)jx * W_ODD_SZ + (size_t)3072 * DM;
      const bf16_t* Ymix = (bf16_t*)(ws + WS_Z + (((l & 1) == 0) ? Z_YE : Z_YO));
      Job jo = job_std(Ymix, DM, wout, DM, DM, 256, 4, (bf16_t*)(ws + WS_HB), DM); jo.sspw = (float*)(ws + WS_SSP);
      gemm_phase<EPI_RES>(lds, jo, G, bx); }
    GRID_SYNC();
    { unsigned char* ws = kws();
      Job jx1 = job_std((bf16_t*)(ws + WS_HB), DM, (bf16_t*)(ws + WS_WQK), DM, DM, 256, 4, (bf16_t*)(ws + WS_Z), DM); jx1.bdiv = 16; jx1.b1 = DM * DM; jx1.ssp = (float*)(ws + WS_SSP);
      gemm_phase<EPI_SOFTMAX>(lds, jx1, G, bx); }
    GRID_SYNC();
    { unsigned char* ws = kws();
      Job jx2 = job_std((bf16_t*)(ws + WS_Z), DM, (bf16_t*)(ws + WS_VWO), DM, DM, 256, 4, (bf16_t*)(ws + WS_HB), DM); jx2.bdiv = 16; jx2.b1 = DM * DM; jx2.sspw = (float*)(ws + WS_SSP);
      gemm_phase<EPI_RES>(lds, jx2, G, bx); }
    GRID_SYNC();
    { unsigned char* ws = kws(); bf16_t* wl = (bf16_t*)(ws + WS_W) + W_LAY + (size_t)l * W_LAY_SZ;
      Job ju = job_std((bf16_t*)(ws + WS_HB), DM, wl + (size_t)4096 * DM, DM, DM, 256, 16, (bf16_t*)(ws + WS_Z), DFF); ju.ssp = (float*)(ws + WS_SSP);
      ju.chain = 1; ju.cw = kin(16) + (size_t)l * 3 * DFF; ju.cb = kin(17) + (size_t)l * DFF;
      gemm_phase<EPI_FFN>(lds, ju, G, bx); }
    GRID_SYNC();
    { unsigned char* ws = kws(); bf16_t* wl = (bf16_t*)(ws + WS_W) + W_LAY + (size_t)l * W_LAY_SZ;
      Job jd2 = job_std((bf16_t*)(ws + WS_Z), DFF, wl + (size_t)8192 * DM, DFF, DFF, 256, 4, (bf16_t*)(ws + WS_HB), DM); jd2.sspw = (float*)(ws + WS_SSP);
      gemm_phase<EPI_RES>(lds, jd2, G, bx); }
    GRID_SYNC();
  }
  {
    int tid = threadIdx.x; asm volatile("" : "+v"(tid));
    const int lane = tid & 63, gwave = bx * 8 + (tid >> 6), ngw = G * 8;
    float* H = kout(); unsigned char* ws = kws(); const float* ssp = (const float*)(ws + WS_SSP); const bf16_t* HB = (const bf16_t*)(ws + WS_HB); const float* gf = kin(19);
    f32x4 gg[4];
#pragma unroll
    for (int j = 0; j < 4; ++j) gg[j] = *((const f32x4*)gf + lane + 64 * j);
    for (int r = gwave; r < NTOK; r += 2 * ngw) {
      u32x2 hv[2][4]; float rs[2];
#pragma unroll
      for (int q = 0; q < 2; ++q) { const int rq = min(r + q * ngw, NTOK - 1); rs[q] = rstd_of(ssp, (size_t)rq);
#pragma unroll
        for (int j = 0; j < 4; ++j) hv[q][j] = *((const u32x2*)(HB + (size_t)rq * DM) + lane + 64 * j); }
#pragma unroll
      for (int q = 0; q < 2; ++q) { if (r + q * ngw >= NTOK) continue;
        f32x4* orow = (f32x4*)(H + (size_t)(r + q * ngw) * DM) + lane;
#pragma unroll
        for (int j = 0; j < 4; ++j) { const f32x4 v = (f32x4){bf_lo(hv[q][j].x), bf_hi(hv[q][j].x), bf_lo(hv[q][j].y), bf_hi(hv[q][j].y)}; orow[64 * j] = v * rs[q] * gg[j]; } }
    }
  }
}

extern "C" void kernel_launch(void* const* d_in, const int* in_sizes, int n_in, void* d_out, int out_size, void* d_ws, size_t ws_size, hipStream_t stream) {
  static int grid_blocks = 0;
  if (!grid_blocks) {
    int dev = 0, cus = 0, per_cu = 0;
    (void)hipGetDevice(&dev);
    (void)hipDeviceGetAttribute(&cus, hipDeviceAttributeMultiprocessorCount, dev);
    (void)hipFuncSetAttribute((const void*)fwd_megakernel, hipFuncAttributeMaxDynamicSharedMemorySize, LDS_BYTES);
    (void)hipOccupancyMaxActiveBlocksPerMultiprocessor(&per_cu, (const void*)fwd_megakernel, 512, LDS_BYTES);
    if (per_cu < 1) per_cu = 1;
    grid_blocks = cus * per_cu;
    if (n_in != 20 || out_size != NTOK * DM || ws_size < WS_END) { fprintf(stderr, "kernel_launch: unexpected shapes/workspace (n_in %d out %d ws %zu)\n", n_in, out_size, ws_size); grid_blocks = -1; }
  }
  if (grid_blocks < 0) return;
  Params p{};
  for (int i = 0; i < 20; ++i) p.in[i] = (const float*)d_in[i];
  p.out = (float*)d_out; p.ws = (unsigned char*)d_ws;
  void* args[] = {&p};
  hipError_t e = hipLaunchCooperativeKernel((void*)fwd_megakernel, dim3(grid_blocks), dim3(512), args, LDS_BYTES, stream);
  if (e != hipSuccess) fprintf(stderr, "cooperative launch failed: %s (grid %d)\n", hipGetErrorString(e), grid_blocks);
}
#ifdef TEST_EPI
__global__ void __launch_bounds__(512, 2) test_kernel(Job j, int G) {
  extern __shared__ __attribute__((aligned(16))) unsigned char lds_raw[];
  gemm_phase<TEST_EPI>((LAS unsigned char*)lds_raw, j, G, blockIdx.x);
}
#endif
```

```cpp
#include <hip/hip_runtime.h>
#include <hip/hip_cooperative_groups.h>
#include <cstdio>
#include <cstdint>
namespace cg = cooperative_groups;

#define LAS __attribute__((address_space(3)))
typedef unsigned short bf16_t;
typedef short bf16x8 __attribute__((ext_vector_type(8)));
typedef float f32x4 __attribute__((ext_vector_type(4)));
typedef float f32x2 __attribute__((ext_vector_type(2)));
typedef unsigned u32x4 __attribute__((ext_vector_type(4)));
typedef unsigned u32x2 __attribute__((ext_vector_type(2)));

constexpr int DM = 1024, NB = 16, SEQ = 4096, NTOK = NB * SEQ, DEPTH = 4, NMEM = 256, DFF = 2048;
constexpr float EPS = 1e-6f;
constexpr float LOG2E = 1.4426950408889634f;

constexpr size_t MiB = 1u << 20;
constexpr size_t WS_SSP = 1 * MiB;
constexpr size_t WS_W = 2 * MiB;
constexpr size_t WS_FCAT = 112 * MiB;
constexpr size_t WS_MB = 176 * MiB;
constexpr size_t WS_KV = 184 * MiB;
constexpr size_t WS_WQK = 200 * MiB;
constexpr size_t WS_VWO = 232 * MiB;
constexpr size_t WS_HB = 264 * MiB;
constexpr size_t WS_Z = 392 * MiB;
constexpr size_t WS_END = 904 * MiB;
constexpr size_t Z_DT = 0, Z_QK = 128 * MiB, Z_VT = 256 * MiB, Z_YE = 320 * MiB, Z_YO = 384 * MiB;

constexpr size_t W_EVEN = 0;
constexpr size_t W_EVEN_SZ = (size_t)(1024 + 1024 + 1024) * 1024;
constexpr size_t W_ODD = W_EVEN + 2 * W_EVEN_SZ;
constexpr size_t W_ODD_SZ = (size_t)(3072 + 1024) * 1024;
constexpr size_t W_LAY = W_ODD + 2 * W_ODD_SZ;
constexpr size_t W_LAY_SZ = (size_t)(1024 + 2048 + 1024 + 4096 + 2048) * 1024;
static_assert((W_LAY + 4 * W_LAY_SZ) * 2 <= 110 * MiB, "weights fit");

constexpr int RING_BYTES = 131072, XCH_OFF = RING_BYTES, XCH_BYTES = 8192, BARST_OFF = XCH_OFF + XCH_BYTES, LDS_BYTES = BARST_OFF + 16;

struct Params {
  const float* in[20]; float* out; unsigned char* ws;
};

#define CAS __attribute__((address_space(4)))
__device__ __forceinline__ CAS const char* ka_ptr() { CAS const char* ka = (CAS const char*)__builtin_amdgcn_kernarg_segment_ptr(); asm volatile("" : "+s"(ka)); return ka; }
__device__ __forceinline__ unsigned long long ka_u64(int off) { return *(CAS const unsigned long long*)(ka_ptr() + off); }
__device__ __forceinline__ const float* kin(int i) { return (const float*)(__attribute__((address_space(1))) const float*)ka_u64(8 * i); }
__device__ __forceinline__ float* kout() { return (float*)(__attribute__((address_space(1))) float*)ka_u64(160); }
__device__ __forceinline__ unsigned char* kws() { return (unsigned char*)(__attribute__((address_space(1))) unsigned char*)ka_u64(168); }
#define GAS __attribute__((address_space(1)))
template <class T> __device__ __forceinline__ T* uni(T* p) { const unsigned long long v = (unsigned long long)p; const unsigned lo = __builtin_amdgcn_readfirstlane((unsigned)v), hi = __builtin_amdgcn_readfirstlane((unsigned)(v >> 32)); return (T*)(GAS T*)(((unsigned long long)hi << 32) | lo); }
__device__ __forceinline__ int uni(int v) { return __builtin_amdgcn_readfirstlane(v); }
__device__ __forceinline__ unsigned cvt_pk_bf16(float lo, float hi) { unsigned r; asm volatile("v_cvt_pk_bf16_f32 %0, %1, %2" : "=v"(r) : "v"(lo), "v"(hi)); return r; }
__device__ __forceinline__ float bf_lo(unsigned u) { return __uint_as_float(u << 16); }
__device__ __forceinline__ float bf_hi(unsigned u) { return __uint_as_float(u & 0xffff0000u); }
__device__ __forceinline__ float wave_sum(float v) {
#pragma unroll
  for (int o = 1; o < 64; o <<= 1) v += __shfl_xor(v, o);
  return v;
}
__device__ __forceinline__ f32x2 gelu_pk(f32x2 v) {
  const f32x2 av = __builtin_elementwise_abs(v), d = av * 0.2316418882f + 1.0f;
  f32x2 t; t.x = __builtin_amdgcn_rcpf(d.x); t.y = __builtin_amdgcn_rcpf(d.y);
  f32x2 q = t * 0.5307027145f + (-0.7265760135f); q = q * t + 0.7107068705f; q = q * t + (-0.142248368f); q = q * t + 0.127414796f; q = q * t;
  const f32x2 s = (v * v) * (-0.72134752044f);
  f32x2 e; e.x = __builtin_amdgcn_exp2f(s.x); e.y = __builtin_amdgcn_exp2f(s.y);
  const f32x2 m = v * (q * e), r = v - m;
  f32x2 o; o.x = v.x < 0.f ? m.x : r.x; o.y = v.y < 0.f ? m.y : r.y; return o;
}
__device__ __forceinline__ float rstd_of(const float* ssp, size_t row) {
  const f32x4 s = *(const f32x4*)(ssp + row * 4);
  return rsqrtf(((s.x + s.y) + (s.z + s.w)) * (1.0f / DM) + EPS);
}

__device__ __forceinline__ void unpack8(const u32x4 w, float (&f)[8]) {
  f[0] = bf_lo(w.x); f[1] = bf_hi(w.x); f[2] = bf_lo(w.y); f[3] = bf_hi(w.y); f[4] = bf_lo(w.z); f[5] = bf_hi(w.z); f[6] = bf_lo(w.w); f[7] = bf_hi(w.w);
}

constexpr int BM = 256, BK = 64, HALF = 128, HTB = HALF * BK * 2, NXCD = 8, WGM = 8;
__device__ __forceinline__ int lds_byte(int r, int c) { const int st = (r >> 4) * 2 + (c >> 5), rr = r & 15, cc = c & 31, ob = rr * 64 + cc * 2; return st * 1024 + (ob ^ (((ob >> 9) & 1) << 5)); }
__device__ __forceinline__ void stage_rc(int b, int& R, int& C) { const int st = b / 1024, sb = b % 1024, swz = sb ^ (((sb >> 9) & 1) << 5); R = (st >> 1) * 16 + swz / 64; C = (st & 1) * 32 + (swz % 64) / 2; }
__device__ __forceinline__ int perm32(int rho) { const int n = rho >> 4, i = rho & 15; return 8 * (i >> 2) + 4 * n + (i & 3); }

struct Unit { int pm, pn; };
struct Job {
  const bf16_t* A; const bf16_t* Bt;
  int lda, ldb, K, nM, nN;
  int adiv, bdiv, odiv;
  int a0, a1, a2, b0, b1, b2;
  int r0, r1, r2, c0, c1, c2;
  bf16_t* O; int ldc;
  const float* ssp; float cscale;
  const float* base; float* H; float* sspw;
  bf16_t* O2;
  const float* cw; const float* cb;
  const bf16_t* GB;
  int chain;
};
__device__ __forceinline__ Job job_std(const bf16_t* A, int lda, const bf16_t* Bt, int ldb, int K, int nM, int nN, bf16_t* O, int ldc) {
  Job j; j.A = A; j.Bt = Bt; j.lda = lda; j.ldb = ldb; j.K = K; j.nM = nM; j.nN = nN;
  j.adiv = 1 << 20; j.bdiv = 1 << 20; j.odiv = 1 << 20;
  j.a0 = 256 * lda; j.a1 = 0; j.a2 = 0; j.b0 = 0; j.b1 = 0; j.b2 = 256 * ldb;
  j.r0 = 256; j.r1 = 0; j.r2 = 0; j.c0 = 0; j.c1 = 0; j.c2 = 256;
  j.O = O; j.ldc = ldc; j.ssp = nullptr; j.cscale = 1.0f; j.base = nullptr; j.H = nullptr; j.sspw = nullptr; j.O2 = nullptr; j.cw = nullptr; j.cb = nullptr; j.GB = nullptr; j.chain = 0;
  return j;
}
struct StaticOrder {
  int nM, nN, nwg, G, c, chain;
  __device__ __forceinline__ void init(int nM_, int nN_, int G_, int c_, int chain_) { nM = nM_; nN = nN_; nwg = nM * nN; G = G_; c = c_; chain = chain_; }
  __device__ __forceinline__ bool next(int i, Unit& u) const {
    if (chain == 4) {
      if (G != 256) { const int L = i * G + c; if (L >= nwg) return false; u.pm = uni(L >> 1); u.pn = uni(L & 1); return true; }
      if (i > 0) return false; const int x = c & 7, j = c >> 3; u.pn = uni(x >> 2); u.pm = uni((4 * (x & 3) + (j >> 3)) * 8 + (j & 7)); return true; }
    if (chain) {
      int bq, pq;
      if (G == 256) { if (i >= 16) return false; const int x = c & 7, j = c >> 3; bq = 8 * (x >> 2) + (j >> 2); pq = 4 * (x & 3) + (j & 3); }
      else { const int ch = c + (i >> 4) * G; if (ch >= 256) return false; bq = ch >> 4; pq = ch & 15; }
      u.pm = uni(bq * 16 + (i & 15)); u.pn = uni(pq); return true; }
    const int L = i * G + c; if (L >= nwg) return false;
    int wgid = L; { const int q = nwg / NXCD, r = nwg % NXCD, xcd = wgid % NXCD, off = wgid / NXCD; wgid = (xcd < r ? xcd * (q + 1) : r * (q + 1) + (xcd - r) * q) + off; }
    const int nig = WGM * nN, gid = wgid / nig, fm = gid * WGM, gsz = (nM - fm) < WGM ? (nM - fm) : WGM;
    u.pm = uni(fm + ((wgid % nig) % gsz)); u.pn = uni((wgid % nig) / gsz); return true;
  }
};
__device__ __forceinline__ size_t job_aoff(const Job& g, const Unit& u) { return (size_t)(u.pm / g.adiv) * g.a1 + (size_t)(u.pm % g.adiv) * g.a0 + (size_t)u.pn * g.a2; }
__device__ __forceinline__ size_t job_boff(const Job& g, const Unit& u) { return (size_t)(u.pm / g.bdiv) * g.b1 + (size_t)(u.pm % g.bdiv) * g.b0 + (size_t)u.pn * g.b2; }

#define RSTD_BATCH8(dst, sb, ROWOF) do { f32x4 _t[8]; _Pragma("unroll") for (int _q = 0; _q < 8; ++_q) _t[_q] = *(const f32x4*)((sb) + (size_t)(unsigned)(ROWOF(_q)) * 4); \
    __builtin_amdgcn_sched_barrier(0); _Pragma("unroll") for (int _q = 0; _q < 8; ++_q) (dst)[_q] = rsqrtf(((_t[_q].x + _t[_q].y) + (_t[_q].z + _t[_q].w)) * (1.0f / DM) + EPS); } while (0)
#define ROW8(q) (((q) >> 2) * HALF + rl + ((q) & 3) * 16)
enum { EPI_SCALE = 0, EPI_SWAP = 1, EPI_RES = 2, EPI_SOFTMAX = 3, EPI_FFN = 4, EPI_DFT = 5, EPI_GCONV = 6 };
template <int CTRL> __device__ __forceinline__ float dppf(float old, float src) { return __builtin_bit_cast(float, __builtin_amdgcn_update_dpp(__builtin_bit_cast(int, old), __builtin_bit_cast(int, src), CTRL, 0xF, 0xF, false)); }

template <int EPI>
__device__ __forceinline__ void epilogue(f32x4 (&acc)[2][2][4][2], const Job& g, const Unit& u, int wr, int wc, int fr, int fq, LAS unsigned char* xch) {
  const int rl = wr * 64 + fr, cl = wc * 32 + 8 * fq;
  if constexpr (EPI == EPI_SCALE) {
    const size_t orow0 = (size_t)(u.pm / g.odiv) * g.r1 + (size_t)(u.pm % g.odiv) * g.r0 + (size_t)u.pn * g.r2;
    const int ocol0 = (u.pm / g.odiv) * g.c1 + (u.pm % g.odiv) * g.c0 + u.pn * g.c2;
    bf16_t* obase = uni(g.O + orow0 * g.ldc + ocol0);
    const float* sbase = uni(g.ssp + (size_t)u.pm * BM * 4);
    float scr8[8];
    { const float* sb = g.ssp ? sbase : (const float*)uni(g.A);
      RSTD_BATCH8(scr8, sb, ROW8);
#pragma unroll
      for (int q = 0; q < 8; ++q) scr8[q] = g.ssp ? scr8[q] * g.cscale : g.cscale; }
#pragma unroll
    for (int ai = 0; ai < 2; ++ai)
#pragma unroll
      for (int m = 0; m < 4; ++m) {
        const int lr = ai * HALF + rl + m * 16;
        const float sc = scr8[ai * 4 + m];
        bf16_t* rowp = (bf16_t*)((char*)obase + (unsigned)(lr * g.ldc + cl) * 2u);
#pragma unroll
        for (int bj = 0; bj < 2; ++bj) {
          const f32x4 v0 = acc[ai][bj][m][0] * sc, v1 = acc[ai][bj][m][1] * sc;
          u32x4 w; w.x = cvt_pk_bf16(v0[0], v0[1]); w.y = cvt_pk_bf16(v0[2], v0[3]); w.z = cvt_pk_bf16(v1[0], v1[1]); w.w = cvt_pk_bf16(v1[2], v1[3]);
          __builtin_nontemporal_store(w, (u32x4*)(rowp + bj * HALF));
        }
      }
  } else if constexpr (EPI == EPI_SWAP) {
    float rs[2][8];
    const size_t tokt = (size_t)u.pn * BM;
    const float* sbase = uni(g.ssp + tokt * 4);
#define COL8A(q) (cl + (q))
#define COL8B(q) (cl + HALF + (q))
    RSTD_BATCH8(rs[0], sbase, COL8A);
    RSTD_BATCH8(rs[1], sbase, COL8B);
    __builtin_amdgcn_sched_barrier(0);
    const size_t bq = tokt >> 12, sq = tokt & 4095;
    bf16_t* dtb = uni(g.O + bq * 512 * 8192 + sq);
    bf16_t* vtb = uni(g.O2 + (size_t)((u.pm >= 2 ? u.pm - 2 : 0) * BM) * NTOK + tokt);
#pragma unroll
    for (int ai = 0; ai < 2; ++ai)
#pragma unroll
      for (int m = 0; m < 4; ++m) {
        const int lr = ai * HALF + rl + m * 16;
        int r1, r2, half;
        if (u.pm == 0) { const int gg = lr >> 6, cp = lr & 63; r1 = gg * 64 + cp; r2 = cp ? 256 + gg * 64 + 64 - cp : -1; half = 0; }
        else if (lr < 4) { r1 = 256 + lr * 64; r2 = -1; half = 0; }
        else { const int mm = lr - 4, gg = mm / 63, cp = 1 + mm % 63; r1 = gg * 64 + cp; r2 = 256 + gg * 64 + 64 - cp; half = 1; }
        bf16_t* p1 = (u.pm < 2) ? (bf16_t*)((char*)dtb + ((unsigned)(r1 * 8192 + half * 4096) + (unsigned)cl) * 2u) : (bf16_t*)((char*)vtb + ((unsigned)lr * (unsigned)NTOK + (unsigned)cl) * 2u);
        bf16_t* p2 = (bf16_t*)((char*)dtb + ((unsigned)((r2 < 0 ? 0 : r2) * 8192 + half * 4096) + (unsigned)cl) * 2u);
#pragma unroll
        for (int bj = 0; bj < 2; ++bj) {
          const f32x4 v0 = acc[ai][bj][m][0], v1 = acc[ai][bj][m][1];
          u32x4 w; w.x = cvt_pk_bf16(v0[0] * rs[bj][0], v0[1] * rs[bj][1]); w.y = cvt_pk_bf16(v0[2] * rs[bj][2], v0[3] * rs[bj][3]);
          w.z = cvt_pk_bf16(v1[0] * rs[bj][4], v1[1] * rs[bj][5]); w.w = cvt_pk_bf16(v1[2] * rs[bj][6], v1[3] * rs[bj][7]);
          __builtin_nontemporal_store(w, (u32x4*)(p1 + bj * HALF));
          if (u.pm < 2 && r2 >= 0) __builtin_nontemporal_store(w, (u32x4*)(p2 + bj * HALF));
          if (u.pm == 1 && lr < 4) {
            const u32x4 z = (u32x4){0u, 0u, 0u, 0u};
            __builtin_nontemporal_store(z, (u32x4*)((char*)dtb + ((unsigned)((256 + lr * 64) * 8192 + 4096) + (unsigned)(cl + bj * HALF)) * 2u));
            __builtin_nontemporal_store(z, (u32x4*)((char*)dtb + ((unsigned)((lr * 64) * 8192 + 4096) + (unsigned)(cl + bj * HALF)) * 2u));
          }
        }
      }
  } else if constexpr (EPI == EPI_RES) {
    LAS float* part = (LAS float*)xch;
    const size_t toff = (size_t)u.pm * BM * DM + (size_t)u.pn * BM;
    bf16_t* rO = uni(g.O + toff);
    u32x4 hbv[8][2];
#pragma unroll
    for (int q = 0; q < 8; ++q)
#pragma unroll
      for (int bj = 0; bj < 2; ++bj) hbv[q][bj] = *(const u32x4*)((const char*)rO + ((unsigned)(((q >> 2) * HALF + rl + (q & 3) * 16) * DM + cl) + bj * HALF) * 2u);
    __builtin_amdgcn_sched_barrier(0);
#pragma unroll
    for (int ai = 0; ai < 2; ++ai)
#pragma unroll
      for (int m = 0; m < 4; ++m) {
        const int lr = ai * HALF + rl + m * 16;
        const unsigned off = (unsigned)(lr * DM + cl);
        float ss = 0.f;
#pragma unroll
        for (int bj = 0; bj < 2; ++bj) {
          const u32x4 hb = hbv[ai * 4 + m][bj];
          f32x4 v0 = acc[ai][bj][m][0], v1 = acc[ai][bj][m][1];
          v0[0] += bf_lo(hb.x); v0[1] += bf_hi(hb.x); v0[2] += bf_lo(hb.y); v0[3] += bf_hi(hb.y);
          v1[0] += bf_lo(hb.z); v1[1] += bf_hi(hb.z); v1[2] += bf_lo(hb.w); v1[3] += bf_hi(hb.w);
          ss += (v0[0] * v0[0] + v0[1] * v0[1]) + (v0[2] * v0[2] + v0[3] * v0[3]) + (v1[0] * v1[0] + v1[1] * v1[1]) + (v1[2] * v1[2] + v1[3] * v1[3]);
          u32x4 w; w.x = cvt_pk_bf16(v0[0], v0[1]); w.y = cvt_pk_bf16(v0[2], v0[3]); w.z = cvt_pk_bf16(v1[0], v1[1]); w.w = cvt_pk_bf16(v1[2], v1[3]);
          *(u32x4*)((char*)rO + (off + bj * HALF) * 2u) = w;
        }
        ss += __shfl_xor(ss, 16); ss += __shfl_xor(ss, 32);
        if (fq == 0) part[lr * 4 + wc] = ss;
      }
    asm volatile("s_waitcnt lgkmcnt(0)" ::: "memory"); __builtin_amdgcn_s_barrier(); asm volatile("" ::: "memory");
    const int tix = (wr * 4 + wc) * 64 + fq * 16 + fr;
    if (tix < 256) {
      const f32x4 p = *(const LAS f32x4*)(part + tix * 4);
      float* sw = uni(g.sspw + (size_t)u.pm * BM * 4 + u.pn);
      *(float*)((char*)sw + (unsigned)tix * 16u) = (p.x + p.y) + (p.z + p.w);
    }
  } else if constexpr (EPI == EPI_DFT) {
    const int b = u.pm >> 3, st = u.pm & 7;
    bf16_t* obase = uni(g.O + ((size_t)b * SEQ + st * 256) * DM);
    bf16_t* mbase = uni(g.O + ((size_t)b * SEQ + SEQ - st * 256) * DM);
    const float sc = g.cscale;
#pragma unroll
    for (int ai = 0; ai < 2; ++ai)
#pragma unroll
      for (int m = 0; m < 4; ++m) {
        const int lr = ai * HALF + rl + m * 16;
        bf16_t* rowp = (bf16_t*)((char*)obase + (unsigned)(lr * DM) * 2u);
        bf16_t* mrow = mbase - (size_t)lr * DM;
        const bool mir = (st * 256 + lr) != 0;
#pragma unroll
        for (int bj = 0; bj < 2; ++bj) {
          const f32x4 v0 = acc[ai][bj][m][0] * sc, v1 = acc[ai][bj][m][1] * sc;
          u32x4 w; w.x = cvt_pk_bf16(v0[0], v0[1]); w.y = cvt_pk_bf16(v0[2], v0[3]); w.z = cvt_pk_bf16(v1[0], v1[1]); w.w = cvt_pk_bf16(v1[2], v1[3]);
          const int lc = bj * HALF + cl; const int c = 128 * (lc >> 6) + 64 * u.pn + (lc & 63);
          __builtin_nontemporal_store(w, (u32x4*)(rowp + c));
          if (mir) {
            const int gb = c & ~127, cp = c & 127;
            const unsigned ww[4] = {w.x, w.y, w.z, w.w};
#pragma unroll
            for (int j = 0; j < 8; ++j) mrow[gb + ((128 - (cp + j)) & 127)] = (bf16_t)((j & 1) ? (ww[j >> 1] >> 16) : (ww[j >> 1] & 0xffffu));
          }
        }
      }
  } else if constexpr (EPI == EPI_FFN || EPI == EPI_GCONV) {
    constexpr bool GC = (EPI == EPI_GCONV);
    constexpr int CSTR = GC ? DM : DFF;
    constexpr bool CH = !GC;
    LAS float* X = (LAS float*)xch;
    const int b = CH ? (u.pm >> 4) : u.pm / 17, ti = CH ? (u.pm & 15) : u.pm % 17, s0 = CH ? 256 * ti : 254 * ti - 1;
    LAS float* CYW = X + 1024 + (ti & 1) * 384;
    const LAS float* CYR = X + 1024 + ((ti + 1) & 1) * 384;
    const long row0 = (long)b * SEQ + s0;
    const float* sbase = uni(g.ssp + row0 * 4);
    const int ch0 = u.pn * 128 + cl;
    float rs8[8];
    RSTD_BATCH8(rs8, sbase, ROW8);
    __builtin_amdgcn_sched_barrier(0);
#pragma unroll
    for (int ai = 0; ai < 2; ++ai)
#pragma unroll
      for (int m = 0; m < 4; ++m) {
        const int lr = ai * HALF + rl + m * 16;
        const float sc = rs8[ai * 4 + m];
        const bool inb = CH ? true : ((unsigned)(s0 + lr) < (unsigned)SEQ);
#pragma unroll
        for (int n = 0; n < 2; ++n) {
          if constexpr (GC) { const f32x4 gv = (acc[ai][0][m][n] * sc) * (acc[ai][1][m][n] * sc); acc[ai][1][m][n] = inb ? gv : (f32x4){0.f, 0.f, 0.f, 0.f}; }
          else { acc[ai][0][m][n] = acc[ai][0][m][n] * sc; const f32x4 gv = acc[ai][1][m][n] * sc; acc[ai][1][m][n] = inb ? gv : (f32x4){0.f, 0.f, 0.f, 0.f}; } }
      }
#pragma unroll
    for (int ai = 0; ai < 2; ++ai) {
      const int seg = 2 * ai + wr;
      if (fr == 0) { *(LAS f32x4*)(X + (seg * 2 + 0) * 128 + cl) = acc[ai][1][0][0]; *(LAS f32x4*)(X + (seg * 2 + 0) * 128 + cl + 4) = acc[ai][1][0][1]; }
      if (fr == 15) { *(LAS f32x4*)(X + (seg * 2 + 1) * 128 + cl) = acc[ai][1][3][0]; *(LAS f32x4*)(X + (seg * 2 + 1) * 128 + cl + 4) = acc[ai][1][3][1]; }
    }
    if constexpr (CH) {
      if (wr == 1 && fr == 14) { *(LAS f32x4*)(CYW + cl) = acc[1][1][3][0]; *(LAS f32x4*)(CYW + cl + 4) = acc[1][1][3][1]; }
      if (wr == 1 && fr == 15) { *(LAS f32x4*)(CYW + 128 + cl) = acc[1][1][3][0]; *(LAS f32x4*)(CYW + 128 + cl + 4) = acc[1][1][3][1];
                                 *(LAS f32x4*)(CYW + 256 + cl) = acc[1][0][3][0]; *(LAS f32x4*)(CYW + 256 + cl + 4) = acc[1][0][3][1]; }
    }
    asm volatile("s_waitcnt lgkmcnt(0)" ::: "memory"); __builtin_amdgcn_s_barrier(); asm volatile("" ::: "memory");
    bf16_t* obase = uni(g.O + row0 * CSTR + u.pn * 128);
    const bf16_t* gbase = GC ? uni(g.GB + row0 * DM + u.pn * 128) : nullptr;
    u32x4 gbv[8];
    if constexpr (GC) {
#pragma unroll
      for (int q = 0; q < 8; ++q) gbv[q] = *(const u32x4*)((const char*)gbase + ((unsigned)(ROW8(q) < 1 ? 1 : ROW8(q)) * DM + (unsigned)cl) * 2u);
      __builtin_amdgcn_sched_barrier(0);
    }
    float w0[8], w1[8], w2[8], bb[8];
    { const f32x4 a0 = *(const f32x4*)(g.cw + ch0), a1 = *(const f32x4*)(g.cw + ch0 + 4), b0 = *(const f32x4*)(g.cw + CSTR + ch0), b1 = *(const f32x4*)(g.cw + CSTR + ch0 + 4);
      const f32x4 c0 = *(const f32x4*)(g.cw + 2 * CSTR + ch0), c1 = *(const f32x4*)(g.cw + 2 * CSTR + ch0 + 4);
      f32x4 d0 = (f32x4){0.f, 0.f, 0.f, 0.f}, d1 = d0; if constexpr (!GC) { d0 = *(const f32x4*)(g.cb + ch0); d1 = *(const f32x4*)(g.cb + ch0 + 4); }
#pragma unroll
      for (int j = 0; j < 4; ++j) { w0[j] = a0[j]; w0[4 + j] = a1[j]; w1[j] = b0[j]; w1[4 + j] = b1[j]; w2[j] = c0[j]; w2[4 + j] = c1[j]; bb[j] = d0[j]; bb[4 + j] = d1[j]; } }
#pragma unroll
    for (int ai = 0; ai < 2; ++ai) {
      const int seg = 2 * ai + wr;
      f32x4 pl[2], nl[2];
      const int sp = seg > 0 ? seg - 1 : 0, sn = seg < 3 ? seg + 1 : 3;
      pl[0] = *(const LAS f32x4*)(X + (sp * 2 + 1) * 128 + cl); pl[1] = *(const LAS f32x4*)(X + (sp * 2 + 1) * 128 + cl + 4);
      nl[0] = *(const LAS f32x4*)(X + (sn * 2 + 0) * 128 + cl); nl[1] = *(const LAS f32x4*)(X + (sn * 2 + 0) * 128 + cl + 4);
      if constexpr (CH) {
        if (seg == 0) { if (ti > 0) { pl[0] = *(const LAS f32x4*)(CYR + 128 + cl); pl[1] = *(const LAS f32x4*)(CYR + 128 + cl + 4); } else { pl[0] = (f32x4){0.f, 0.f, 0.f, 0.f}; pl[1] = pl[0]; } }
        if (seg == 3) { nl[0] = (f32x4){0.f, 0.f, 0.f, 0.f}; nl[1] = nl[0]; }
      }
#pragma unroll
      for (int m = 0; m < 4; ++m) {
        const int lr = ai * HALF + rl + m * 16;
        float a[8];
#pragma unroll
        for (int n = 0; n < 2; ++n)
#pragma unroll
          for (int v = 0; v < 4; ++v) {
            const float cur = acc[ai][1][m][n][v];
            float oldp, oldn;
            if (m > 0) { const float t = acc[ai][1][m > 0 ? m - 1 : 0][n][v]; oldp = dppf<0x121>(t, t); } else oldp = pl[n][v];
            if (m < 3) { const float t = acc[ai][1][m < 3 ? m + 1 : 3][n][v]; oldn = dppf<0x12F>(t, t); } else oldn = nl[n][v];
            const float prev = dppf<0x111>(oldp, cur), next = dppf<0x101>(oldn, cur);
            a[4 * n + v] = w0[4 * n + v] * prev + w1[4 * n + v] * cur + w2[4 * n + v] * next + bb[4 * n + v];
          }
        if constexpr (!GC) {
#pragma unroll
          for (int j = 0; j < 8; j += 2) { const f32x2 ge = gelu_pk((f32x2){a[j], a[j + 1]}); a[j] = ge.x * acc[ai][0][m][j >> 2][j & 3]; a[j + 1] = ge.y * acc[ai][0][m][(j + 1) >> 2][(j + 1) & 3]; }
        }
        if (CH ? (lr != 255 || ti == 15) : (lr >= 1 && lr <= 254 && s0 + lr < SEQ)) {
          if constexpr (GC) { float gb[8]; unpack8(gbv[ai * 4 + m], gb);
#pragma unroll
            for (int j = 0; j < 8; ++j) a[j] *= gb[j]; }
          u32x4 w; w.x = cvt_pk_bf16(a[0], a[1]); w.y = cvt_pk_bf16(a[2], a[3]); w.z = cvt_pk_bf16(a[4], a[5]); w.w = cvt_pk_bf16(a[6], a[7]);
          __builtin_nontemporal_store(w, (u32x4*)((char*)obase + ((unsigned)lr * CSTR + (unsigned)cl) * 2u));
        }
      }
    }
    if constexpr (CH) {
      const int tix = (wr * 4 + wc) * 64 + fq * 16 + fr;
      if (ti > 0 && tix < 16) {
        const int ch = tix * 8, gch = u.pn * 128 + ch;
        const f32x4 ga0 = *(const LAS f32x4*)(CYR + ch), ga1 = *(const LAS f32x4*)(CYR + ch + 4), gb0 = *(const LAS f32x4*)(CYR + 128 + ch), gb1 = *(const LAS f32x4*)(CYR + 128 + ch + 4);
        const f32x4 uu0 = *(const LAS f32x4*)(CYR + 256 + ch), uu1 = *(const LAS f32x4*)(CYR + 256 + ch + 4), gn0 = *(const LAS f32x4*)(X + ch), gn1 = *(const LAS f32x4*)(X + ch + 4);
        const f32x4 p0 = *(const f32x4*)(g.cw + gch), p1 = *(const f32x4*)(g.cw + gch + 4), q0 = *(const f32x4*)(g.cw + CSTR + gch), q1 = *(const f32x4*)(g.cw + CSTR + gch + 4);
        const f32x4 r0 = *(const f32x4*)(g.cw + 2 * CSTR + gch), r1 = *(const f32x4*)(g.cw + 2 * CSTR + gch + 4), e0 = *(const f32x4*)(g.cb + gch), e1 = *(const f32x4*)(g.cb + gch + 4);
        const f32x4 x0 = p0 * ga0 + q0 * gb0 + r0 * gn0 + e0, x1 = p1 * ga1 + q1 * gb1 + r1 * gn1 + e1;
        const f32x2 y0 = gelu_pk((f32x2){x0[0], x0[1]}), y1 = gelu_pk((f32x2){x0[2], x0[3]}), y2 = gelu_pk((f32x2){x1[0], x1[1]}), y3 = gelu_pk((f32x2){x1[2], x1[3]});
        u32x4 w; w.x = cvt_pk_bf16(y0.x * uu0[0], y0.y * uu0[1]); w.y = cvt_pk_bf16(y1.x * uu0[2], y1.y * uu0[3]); w.z = cvt_pk_bf16(y2.x * uu1[0], y2.y * uu1[1]); w.w = cvt_pk_bf16(y3.x * uu1[2], y3.y * uu1[3]);
        __builtin_nontemporal_store(w, (u32x4*)(g.O + (row0 - 1) * CSTR + gch));
      }
    }
  } else {
    LAS float* mx = (LAS float*)xch;
    LAS float* sm = (LAS float*)(xch + 4096);
    const float* sbase = uni(g.ssp + (size_t)u.pm * BM * 4);
    bf16_t* obase = uni(g.O + (size_t)u.pm * BM * g.ldc + (size_t)u.pn * BM);
    float rs8[8];
    RSTD_BATCH8(rs8, sbase, ROW8);
    __builtin_amdgcn_sched_barrier(0);
#pragma unroll
    for (int ai = 0; ai < 2; ++ai)
#pragma unroll
      for (int m = 0; m < 4; ++m) {
        const int lr = ai * HALF + rl + m * 16;
        const float sc = rs8[ai * 4 + m];
        float mv = -3.0e38f;
#pragma unroll
        for (int bj = 0; bj < 2; ++bj)
#pragma unroll
          for (int n = 0; n < 2; ++n) { f32x4 v = acc[ai][bj][m][n] * sc; acc[ai][bj][m][n] = v; mv = fmaxf(mv, fmaxf(fmaxf(v[0], v[1]), fmaxf(v[2], v[3]))); }
        mv = fmaxf(mv, __shfl_xor(mv, 16)); mv = fmaxf(mv, __shfl_xor(mv, 32));
        if (fq == 0) mx[lr * 4 + wc] = mv;
      }
    asm volatile("s_waitcnt lgkmcnt(0)" ::: "memory"); __builtin_amdgcn_s_barrier(); asm volatile("" ::: "memory");
#pragma unroll
    for (int ai = 0; ai < 2; ++ai)
#pragma unroll
      for (int m = 0; m < 4; ++m) {
        const int lr = ai * HALF + rl + m * 16;
        const f32x4 m4 = *(const LAS f32x4*)(mx + lr * 4);
        const float M = fmaxf(fmaxf(m4.x, m4.y), fmaxf(m4.z, m4.w));
        float s = 0.f;
#pragma unroll
        for (int bj = 0; bj < 2; ++bj)
#pragma unroll
          for (int n = 0; n < 2; ++n) { f32x4 v = acc[ai][bj][m][n];
            v[0] = __builtin_amdgcn_exp2f(v[0] - M); v[1] = __builtin_amdgcn_exp2f(v[1] - M); v[2] = __builtin_amdgcn_exp2f(v[2] - M); v[3] = __builtin_amdgcn_exp2f(v[3] - M);
            acc[ai][bj][m][n] = v; s += (v[0] + v[1]) + (v[2] + v[3]); }
        s += __shfl_xor(s, 16); s += __shfl_xor(s, 32);
        if (fq == 0) sm[lr * 4 + wc] = s;
      }
    asm volatile("s_waitcnt lgkmcnt(0)" ::: "memory"); __builtin_amdgcn_s_barrier(); asm volatile("" ::: "memory");
#pragma unroll
    for (int ai = 0; ai < 2; ++ai)
#pragma unroll
      for (int m = 0; m < 4; ++m) {
        const int lr = ai * HALF + rl + m * 16;
        const f32x4 s4 = *(const LAS f32x4*)(sm + lr * 4);
        const float inv = 1.0f / ((s4.x + s4.y) + (s4.z + s4.w));
        bf16_t* rowp = (bf16_t*)((char*)obase + (unsigned)(lr * g.ldc + cl) * 2u);
#pragma unroll
        for (int bj = 0; bj < 2; ++bj) {
          const f32x4 v0 = acc[ai][bj][m][0] * inv, v1 = acc[ai][bj][m][1] * inv;
          u32x4 w; w.x = cvt_pk_bf16(v0[0], v0[1]); w.y = cvt_pk_bf16(v0[2], v0[3]); w.z = cvt_pk_bf16(v1[0], v1[1]); w.w = cvt_pk_bf16(v1[2], v1[3]);
          __builtin_nontemporal_store(w, (u32x4*)(rowp + bj * HALF));
        }
      }
  }
}

template <int EPI>
__device__ __forceinline__ void gemm_phase(LAS unsigned char* lds, const Job& g, int G, int c) {
  int tid = threadIdx.x; asm volatile("" : "+v"(tid));
  const int wid = __builtin_amdgcn_readfirstlane(tid >> 6), lane = tid & 63, wr = wid >> 2, wc = wid & 3, fr = lane & 15, fq = lane >> 4;
  const int nt = g.K / BK;
  int c_ = c; asm volatile("" : "+s"(c_));
  StaticOrder S; S.init(g.nM, g.nN, G, c_, g.chain);
  unsigned voffA, voffB;
  { int R, C; stage_rc(tid * 16, R, C); const int Rb = (R & ~31) + perm32(R & 31); voffA = (unsigned)(R * g.lda + C) * 2u; voffB = (unsigned)(Rb * g.ldb + C) * 2u; }
  const size_t rsA = (size_t)64 * g.lda * 2, rsB = (size_t)64 * g.ldb * 2, hA = 2 * rsA, hB = 2 * rsB;
  const size_t kstep = (size_t)(BK * 2);
  const unsigned ldsw = (unsigned)wid * 1024u;
  const int aoff = lds_byte(wr * 64 + fr, fq * 8), boff = lds_byte(wc * 32 + fr, fq * 8);
#define PG8_SA(b, h) (((b) * 2 + (h)) * HTB)
#define PG8_SB(b, h) ((4 + (b) * 2 + (h)) * HTB)
#define PG8_STAGE(bufoff, gbase, voff, rs) do { _Pragma("unroll") for (int _i = 0; _i < 2; ++_i) \
        __builtin_amdgcn_global_load_lds((const unsigned*)((const char*)(gbase) + (size_t)_i * (rs) + (voff)), (LAS unsigned*)(lds + (bufoff) + ldsw + _i * 8192), 16, 0, 0); } while (0)
#define PG8_LDA(dst, b, h) do { _Pragma("unroll") for (int m = 0; m < 4; ++m) _Pragma("unroll") for (int k = 0; k < 2; ++k) dst[m][k] = *(const LAS bf16x8*)(lds + PG8_SA(b, h) + aoff + m * 2048 + k * 1024); } while (0)
#define PG8_LDB(dst, b, h) do { _Pragma("unroll") for (int n = 0; n < 2; ++n) _Pragma("unroll") for (int k = 0; k < 2; ++k) dst[n][k] = *(const LAS bf16x8*)(lds + PG8_SB(b, h) + boff + n * 2048 + k * 1024); } while (0)
#define PG8_MMA(ai, bj, At, Bt) do { __builtin_amdgcn_s_setprio(1); _Pragma("unroll") for (int m = 0; m < 4; ++m) _Pragma("unroll") for (int n = 0; n < 2; ++n) _Pragma("unroll") for (int k = 0; k < 2; ++k) \
        acc[ai][bj][m][n] = __builtin_amdgcn_mfma_f32_16x16x32_bf16(Bt[n][k], At[m][k], acc[ai][bj][m][n], 0, 0, 0); __builtin_amdgcn_s_setprio(0); } while (0)
#define PG8_WAIT_V(n) asm volatile("s_waitcnt vmcnt(" #n ")" ::: "memory")
#define PG8_WAIT_L(n) asm volatile("s_waitcnt lgkmcnt(" #n ")" ::: "memory")
#define PG8_BAR __builtin_amdgcn_s_barrier()
#define PG8_SCHED __builtin_amdgcn_sched_barrier(0)
  Unit cur, nxt; int ui = 0;
  if (!S.next(0, cur)) return;
  const char* gA = uni((const char*)g.A); const char* gB = uni((const char*)g.Bt);
  f32x4 acc[2][2][4][2];
#pragma unroll
  for (int a = 0; a < 2; ++a)
#pragma unroll
    for (int b = 0; b < 2; ++b)
#pragma unroll
      for (int m = 0; m < 4; ++m)
#pragma unroll
        for (int n = 0; n < 2; ++n) acc[a][b][m][n] = (f32x4){0.f, 0.f, 0.f, 0.f};
  bf16x8 At[4][2], B0[2][2], B1[2][2];
  const char* cA = uni(gA + job_aoff(g, cur) * 2); const char* cB = uni(gB + job_boff(g, cur) * 2);
  PG8_STAGE(PG8_SB(0, 0), cB, voffB, rsB); PG8_STAGE(PG8_SB(0, 1), cB + hB, voffB, rsB); PG8_STAGE(PG8_SA(0, 0), cA, voffA, rsA); PG8_STAGE(PG8_SA(0, 1), cA + hA, voffA, rsA);
  if (wr == 1) PG8_BAR;
  PG8_WAIT_V(2); PG8_BAR;
  PG8_STAGE(PG8_SB(1, 0), cB + kstep, voffB, rsB); PG8_STAGE(PG8_SA(1, 0), cA + kstep, voffA, rsA); PG8_STAGE(PG8_SB(1, 1), cB + hB + kstep, voffB, rsB);
  PG8_WAIT_V(6); PG8_BAR;
  for (;;) {
    const bool has_next = S.next(ui + 1, nxt);
    const char* nA = has_next ? uni(gA + job_aoff(g, nxt) * 2) : cA; const char* nB = has_next ? uni(gB + job_boff(g, nxt) * 2) : cB;
    for (int t = 0; t < nt; t += 2) {
      const bool last = (t == nt - 2);
      const char* a1 = cA + (size_t)(t + 1) * kstep;
      const char* a2 = last ? nA : cA + (size_t)(t + 2) * kstep; const char* b2 = last ? nB : cB + (size_t)(t + 2) * kstep;
      const char* a3 = a2 + kstep; const char* b3 = b2 + kstep;
      PG8_LDB(B0, 0, 0); PG8_LDB(B1, 0, 1); PG8_SCHED; PG8_LDA(At, 0, 0); PG8_STAGE(PG8_SA(1, 1), a1 + hA, voffA, rsA);
      PG8_WAIT_V(8); PG8_WAIT_L(0); PG8_BAR; PG8_MMA(0, 0, At, B0); PG8_MMA(0, 1, At, B1); PG8_BAR; PG8_SCHED;
      PG8_LDA(At, 0, 1); PG8_STAGE(PG8_SB(0, 0), b2, voffB, rsB); PG8_STAGE(PG8_SB(0, 1), b2 + hB, voffB, rsB); PG8_STAGE(PG8_SA(0, 0), a2, voffA, rsA);
      PG8_WAIT_V(8); PG8_WAIT_L(0); PG8_BAR; PG8_MMA(1, 0, At, B0); PG8_MMA(1, 1, At, B1); PG8_BAR; PG8_SCHED;
      PG8_LDB(B0, 1, 0); PG8_LDB(B1, 1, 1); PG8_SCHED; PG8_LDA(At, 1, 0); PG8_STAGE(PG8_SA(0, 1), a2 + hA, voffA, rsA);
      PG8_WAIT_V(8); PG8_WAIT_L(0); PG8_BAR; PG8_MMA(0, 0, At, B0); PG8_MMA(0, 1, At, B1); PG8_BAR; PG8_SCHED;
      PG8_LDA(At, 1, 1); PG8_STAGE(PG8_SB(1, 0), b3, voffB, rsB); PG8_STAGE(PG8_SB(1, 1), b3 + hB, voffB, rsB); PG8_STAGE(PG8_SA(1, 0), a3, voffA, rsA);
      PG8_WAIT_V(8); PG8_WAIT_L(0); PG8_BAR; PG8_MMA(1, 0, At, B0); PG8_MMA(1, 1, At, B1); PG8_BAR; PG8_SCHED;
    }
    if (wr == 0) PG8_BAR;
    { int e_fr = fr, e_fq = fq; asm volatile("" : "+v"(e_fr), "+v"(e_fq));
      epilogue<EPI>(acc, g, cur, wr, wc, e_fr, e_fq, lds + XCH_OFF); }
    if (!has_next) break;
#pragma unroll
    for (int a = 0; a < 2; ++a)
#pragma unroll
      for (int b = 0; b < 2; ++b)
#pragma unroll
        for (int m = 0; m < 4; ++m)
#pragma unroll
          for (int n = 0; n < 2; ++n) acc[a][b][m][n] = (f32x4){0.f, 0.f, 0.f, 0.f};
    cur = nxt; cA = nA; cB = nB; ++ui;
    if (wr == 1) PG8_BAR;
  }
  PG8_WAIT_V(0);
  PG8_BAR;
#undef PG8_SA
#undef PG8_SB
#undef PG8_STAGE
#undef PG8_LDA
#undef PG8_LDB
#undef PG8_MMA
#undef PG8_WAIT_V
#undef PG8_WAIT_L
#undef PG8_BAR
#undef PG8_SCHED
}

__device__ __forceinline__ void transpose_item(const float* W, int ldw, int col0, int K, int N, bf16_t* WT, const float* gain, float cs, LAS float* scr, int item, int lane, int permup) {
  const int nblk = N / 32, kb = item / nblk, nb = item % nblk, k0 = 64 * kb, n0 = 32 * nb;
  f32x4 tv[8]; float tg[8];
#pragma unroll
  for (int i = 0; i < 8; ++i) { const int kk = 8 * i + (lane >> 3), nn = (lane & 7) * 4; tv[i] = *(const f32x4*)(W + (size_t)(k0 + kk) * ldw + col0 + n0 + nn); tg[i] = gain ? gain[k0 + kk] : 1.0f; }
  __builtin_amdgcn_sched_barrier(0);
#pragma unroll
  for (int i = 0; i < 8; ++i) { const int kk = 8 * i + (lane >> 3), nn = (lane & 7) * 4; const float gv = tg[i] * cs; const f32x4 v = tv[i];
    LAS float* d = scr + kk * 33 + nn; d[0] = v.x * gv; d[1] = v.y * gv; d[2] = v.z * gv; d[3] = v.w * gv; }
  asm volatile("s_waitcnt lgkmcnt(0)" ::: "memory");
  const int c = lane & 7;
#pragma unroll
  for (int j = 0; j < 4; ++j) { const int n = (lane >> 3) + 8 * j; const LAS float* s = scr + (8 * c) * 33 + n;
    u32x4 o; o.x = cvt_pk_bf16(s[0 * 33], s[1 * 33]); o.y = cvt_pk_bf16(s[2 * 33], s[3 * 33]); o.z = cvt_pk_bf16(s[4 * 33], s[5 * 33]); o.w = cvt_pk_bf16(s[6 * 33], s[7 * 33]);
    const int nn = n0 + n; const int nr = (permup == 1) ? (((nn & 2047) >> 7) * 256 + (nn >> 11) * 128 + (nn & 127)) : (permup == 2) ? (((nn & 1023) >> 7) * 256 + (nn >> 10) * 128 + (nn & 127)) : nn;
    *(u32x4*)(WT + (size_t)nr * K + k0 + 8 * c) = o; }
  asm volatile("s_waitcnt lgkmcnt(0)" ::: "memory");
}
struct TrDesc { const float* W; int ldw, col0, K, N; bf16_t* WT; const float* gain; float cs; int nitems; int permup; };
__device__ __forceinline__ TrDesc tr_desc(bf16_t* wb, int d) {
  TrDesc t; t.cs = 1.0f; t.gain = nullptr; t.col0 = 0; t.permup = 0;
  if (d < 8) {
    const int j = d >> 2, w = d & 3; bf16_t* e = wb + W_EVEN + (size_t)j * W_EVEN_SZ;
    if (w < 3) { t.W = kin(4) + (size_t)j * DM * 2048; t.ldw = 2048; t.col0 = 512 + 512 * w; t.K = DM; t.N = 512; t.gain = kin(3) + (size_t)(2 * j) * DM;
      t.WT = (w == 0) ? e + (size_t)1024 * DM : (w == 1) ? e + (size_t)1536 * DM : e + (size_t)512 * DM;
      if (w == 0) t.cs = 0.08838834764831845f * LOG2E; }
    else { t.W = kin(6) + (size_t)j * DM * DM; t.ldw = DM; t.K = DM; t.N = DM; t.WT = e + (size_t)2048 * DM; }
  } else if (d < 14) {
    const int j = (d - 8) / 3, w = (d - 8) % 3; bf16_t* o = wb + W_ODD + (size_t)j * W_ODD_SZ;
    if (w == 0) { t.W = kin(7) + (size_t)j * DM * 3072; t.ldw = 3072; t.K = DM; t.N = 1024; t.gain = kin(3) + (size_t)(2 * j + 1) * DM; t.WT = o; }
    else if (w == 2) { t.W = kin(7) + (size_t)j * DM * 3072; t.ldw = 3072; t.col0 = 1024; t.K = DM; t.N = 2048; t.gain = kin(3) + (size_t)(2 * j + 1) * DM; t.WT = o + (size_t)1024 * DM; t.permup = 2; }
    else { t.W = kin(9) + (size_t)j * DM * DM; t.ldw = DM; t.K = DM; t.N = DM; t.WT = o + (size_t)3072 * DM; }
  } else {
    const int l = (d - 14) >> 2, w = (d - 14) & 3; bf16_t* y = wb + W_LAY + (size_t)l * W_LAY_SZ;
    if (w == 0) { t.W = kin(12) + (size_t)l * DM * 2048; t.ldw = 2048; t.K = DM; t.N = 2048; t.WT = y + (size_t)1024 * DM; }
    else if (w == 1) { t.W = kin(13) + (size_t)l * DM * DM; t.ldw = DM; t.K = DM; t.N = DM; t.WT = y + (size_t)3072 * DM; }
    else if (w == 2) { t.W = kin(15) + (size_t)l * DM * 4096; t.ldw = 4096; t.K = DM; t.N = 4096; t.gain = kin(14) + (size_t)l * DM; t.WT = y + (size_t)4096 * DM; t.permup = 1; }
    else { t.W = kin(18) + (size_t)l * DFF * DM; t.ldw = DM; t.K = DFF; t.N = DM; t.WT = y + (size_t)8192 * DM; }
  }
  t.nitems = (t.K / 64) * (t.N / 32);
  return t;
}

__device__ __forceinline__ void prologue(LAS unsigned char* lds) {
  int tid_ = threadIdx.x; asm volatile("" : "+v"(tid_));
  const int lane = tid_ & 63, wave = __builtin_amdgcn_readfirstlane(tid_ >> 6), gwave = (int)blockIdx.x * 8 + wave, ngw = (int)gridDim.x * 8;
  unsigned char* ws = kws();
  bf16_t* wb = (bf16_t*)(ws + WS_W);
  LAS float* scr = (LAS float*)(lds + wave * 16384);
  for (int d = 0; d < 30; ++d) {
    const TrDesc t = tr_desc(wb, d);
    for (int it = (gwave + d * 293) % ngw; it < t.nitems; it += ngw) transpose_item(t.W, t.ldw, t.col0, t.K, t.N, t.WT, t.gain, t.cs, scr, it, lane, t.permup);
  }
  {
    const size_t n4 = (size_t)DEPTH * DM * DM / 4;
    for (size_t i = (size_t)gwave * 64 + lane; i < n4; i += (size_t)ngw * 64) {
      const size_t e = i * 4; const int l = (int)(e / ((size_t)DM * DM)); const size_t r = e % ((size_t)DM * DM); const int k = (int)(r / DM);
      const f32x4 v = *(const f32x4*)(kin(11) + e); const float gv = kin(10)[l * DM + k] * (0.0625f * LOG2E);
      u32x2 w; w.x = cvt_pk_bf16(v[0] * gv, v[1] * gv); w.y = cvt_pk_bf16(v[2] * gv, v[3] * gv);
      *(u32x2*)(wb + W_LAY + (size_t)l * W_LAY_SZ + r) = w;
    }
  }
  LAS float* T = (LAS float*)(lds + RING_BYTES - 16384);
  __syncthreads();
  LAS float* T128 = (LAS float*)(lds + XCH_OFF);
  for (int i = tid_; i < 4096; i += 512) T[i] = cospif((float)i * (1.0f / 2048.0f));
  if (tid_ < 128) T128[tid_] = cospif((float)tid_ * (1.0f / 64.0f));
  __syncthreads();
  {
    bf16_t* F = (bf16_t*)(ws + WS_FCAT);
    const size_t nchunk = (size_t)4096 * 8192 / 8;
    for (size_t ci = (size_t)gwave * 64 + lane; ci < nchunk; ci += (size_t)ngw * 64) {
      const int s = (int)(ci >> 10), k0 = (int)(ci & 1023) * 8;
      float v[8];
#pragma unroll
      for (int j = 0; j < 8; ++j) { const int k = k0 + j; const int sr = s & 2047; const int idx = (k < 4096) ? ((sr * k) & 4095) : ((sr * (k - 4096) + ((s < 2048) ? 1024 : 3072)) & 4095); v[j] = T[idx]; }
      u32x4 w; w.x = cvt_pk_bf16(v[0], v[1]); w.y = cvt_pk_bf16(v[2], v[3]); w.z = cvt_pk_bf16(v[4], v[5]); w.w = cvt_pk_bf16(v[6], v[7]);
      *(u32x4*)(F + ci * 8) = w;
    }
  }
  for (int it = gwave; it < 2 * 1024 * 4; it += ngw) {
    const int j = it >> 12, k = (it >> 2) & 1023, gq = it & 3;
    const float* wrow = kin(4) + ((size_t)j * DM + k) * 2048 + gq * 128;
    const float gv = kin(3)[(2 * j) * DM + k];
    const float w0 = wrow[lane] * gv, w1 = wrow[64 + lane] * gv;
    float ac0 = 0.f, ac1 = 0.f, as0 = 0.f;
#pragma unroll 8
    for (int c = 0; c < 128; ++c) {
      const float wv = (c < 64) ? __shfl(w0, c) : __shfl(w1, c - 64);
      const int i0 = (c * lane) & 127, i1 = (c * (lane + 64)) & 127;
      ac0 += wv * T128[i0]; as0 += wv * T128[(i0 + 96) & 127];
      ac1 += wv * T128[i1];
    }
    bf16_t* e = wb + W_EVEN + (size_t)j * W_EVEN_SZ;
    e[(size_t)(gq * 64 + lane) * DM + k] = (bf16_t)(cvt_pk_bf16(ac0, 0.f) & 0xffff);
    if (lane == 0) e[(size_t)(256 + gq) * DM + k] = (bf16_t)(cvt_pk_bf16(ac1, 0.f) & 0xffff);
    else e[(size_t)(260 + gq * 63 + lane - 1) * DM + k] = (bf16_t)(cvt_pk_bf16(as0, 0.f) & 0xffff);
  }
  for (int r = gwave; r < NB * NMEM; r += ngw) {
    const f32x4* xr = (const f32x4*)(kin(1) + (size_t)r * DM) + lane; f32x4 v[4]; float s = 0.f;
#pragma unroll
    for (int j = 0; j < 4; ++j) { v[j] = xr[64 * j]; s += (v[j].x * v[j].x + v[j].y * v[j].y) + (v[j].z * v[j].z + v[j].w * v[j].w); }
    const float rs = rsqrtf(wave_sum(s) * (1.0f / DM) + EPS);
    u32x2* o = (u32x2*)((bf16_t*)(ws + WS_MB) + (size_t)r * DM) + lane;
#pragma unroll
    for (int j = 0; j < 4; ++j) { const f32x4 gg = *((const f32x4*)kin(2) + lane + 64 * j);
      u32x2 w; w.x = cvt_pk_bf16(v[j].x * rs * gg.x, v[j].y * rs * gg.y); w.y = cvt_pk_bf16(v[j].z * rs * gg.z, v[j].w * rs * gg.w); o[64 * j] = w; }
  }
  {
    const float* xin = kin(0); bf16_t* hbp = (bf16_t*)(ws + WS_HB); float* sspp = (float*)(ws + WS_SSP);
    for (int r = gwave; r < NTOK; r += 4 * ngw) {
      f32x4 v[4][4];
#pragma unroll
      for (int q = 0; q < 4; ++q) { const int rq = min(r + q * ngw, NTOK - 1); const f32x4* xr = (const f32x4*)(xin + (size_t)rq * DM) + lane;
#pragma unroll
        for (int j = 0; j < 4; ++j) v[q][j] = xr[64 * j]; }
#pragma unroll
      for (int q = 0; q < 4; ++q) { float sq = 0.f;
#pragma unroll
        for (int j = 0; j < 4; ++j) sq += (v[q][j].x * v[q][j].x + v[q][j].y * v[q][j].y) + (v[q][j].z * v[q][j].z + v[q][j].w * v[q][j].w);
        sq = wave_sum(sq);
        if (r + q * ngw >= NTOK) continue;
        u32x2* o = (u32x2*)(hbp + (size_t)(r + q * ngw) * DM) + lane;
#pragma unroll
        for (int j = 0; j < 4; ++j) { u32x2 w; w.x = cvt_pk_bf16(v[q][j].x, v[q][j].y); w.y = cvt_pk_bf16(v[q][j].z, v[q][j].w); o[64 * j] = w; }
        if (lane == 0) *(f32x4*)(sspp + (size_t)(r + q * ngw) * 4) = (f32x4){sq, 0.f, 0.f, 0.f}; }
    }
  }
}

__device__ __forceinline__ void natten_phase(const bf16_t* QK, const bf16_t* VT, bf16_t* Y, const float* rpb, LAS float* rpbs) {
  int tid_ = threadIdx.x; asm volatile("" : "+v"(tid_));
  const int lane = tid_ & 63, wave = __builtin_amdgcn_readfirstlane(tid_ >> 6);
  for (int i = tid_; i < 4 * 15 * 31; i += 512) rpbs[i] = rpb[i] * LOG2E;
  __syncthreads();
  const int n = lane & 15, g = lane >> 4;
  const int keyl = 8 * (n >> 2) + (n & 3);
  const int vcu0 = ((gridDim.x & 7) == 0) ? ((int)blockIdx.x & 7) * ((int)gridDim.x >> 3) + ((int)blockIdx.x >> 3) : (int)blockIdx.x;
  for (int slot = vcu0; slot < 256; slot += (int)gridDim.x)
  for (int it = 0; it < 4; ++it) {
    const int u = (slot * 4 + it) * 8 + wave;
    const int jb = u & 3, ip = (u >> 2) & 31, h = (u >> 7) & 3, b = u >> 9;
    const int i0 = 2 * ip;
    const int rs0 = min(max(i0 - 4, 0), 56), d1 = min(max(i0 - 3, 0), 56) - rs0;
    const int c0 = (jb == 0) ? 0 : (jb == 1) ? 8 : (jb == 2) ? 24 : 32;
    const int j = jb * 16 + n; const int cs = min(max(j - 8, 0), 48);
    const size_t tq = (size_t)b * SEQ + i0 * 64 + j;
    bf16x8 qf[2][4];
#pragma unroll
    for (int q = 0; q < 2; ++q)
#pragma unroll
      for (int ks = 0; ks < 4; ++ks) qf[q][ks] = *(const bf16x8*)(QK + (tq + q * 64) * 1024 + h * 128 + ks * 32 + 8 * g);
    f32x4 sc[2][9][2];
#pragma unroll
    for (int ur = 0; ur < 9; ++ur) {
      const int krow = min(rs0 + ur, 63);
      const size_t tk0 = (size_t)b * SEQ + (size_t)krow * 64 + c0;
      bf16x8 kf[2][4];
#pragma unroll
      for (int t = 0; t < 2; ++t) {
        const bf16_t* kp = QK + (tk0 + keyl + 4 * t) * 1024 + 512 + h * 128 + 8 * g;
#pragma unroll
        for (int ks = 0; ks < 4; ++ks) kf[t][ks] = *(const bf16x8*)(kp + ks * 32);
      }
      __builtin_amdgcn_sched_barrier(0);
#pragma unroll
      for (int t = 0; t < 2; ++t) {
        f32x4 a0 = (f32x4){0.f, 0.f, 0.f, 0.f}, a1 = a0;
#pragma unroll
        for (int ks = 0; ks < 4; ++ks) { a0 = __builtin_amdgcn_mfma_f32_16x16x32_bf16(kf[t][ks], qf[0][ks], a0, 0, 0, 0); a1 = __builtin_amdgcn_mfma_f32_16x16x32_bf16(kf[t][ks], qf[1][ks], a1, 0, 0, 0); }
        sc[0][ur][t] = a0; sc[1][ur][t] = a1;
      }
      __builtin_amdgcn_sched_barrier(0);
    }
    float inv[2];
#pragma unroll
    for (int q = 0; q < 2; ++q) {
      const int dq = q ? d1 : 0, iq = i0 + q;
      float mx = -3.0e38f;
#pragma unroll
      for (int ur = 0; ur < 9; ++ur) {
        const bool rowv = (unsigned)(ur - dq) < 8u;
        const LAS float* brow = rpbs + h * 465 + min(max(rs0 + ur - iq + 7, 0), 14) * 31;
#pragma unroll
        for (int t = 0; t < 2; ++t)
#pragma unroll
          for (int v = 0; v < 4; ++v) {
            const int kc = c0 + 8 * g + 4 * t + v;
            const bool valid = rowv && (kc >= cs) && (kc < cs + 16);
            const int co = min(max(kc - j + 15, 0), 30);
            const float s = valid ? sc[q][ur][t][v] + brow[co] : -3.0e38f;
            sc[q][ur][t][v] = s; mx = fmaxf(mx, s);
          }
      }
      mx = fmaxf(mx, __shfl_xor(mx, 16)); mx = fmaxf(mx, __shfl_xor(mx, 32));
      float sum = 0.f;
#pragma unroll
      for (int ur = 0; ur < 9; ++ur)
#pragma unroll
        for (int t = 0; t < 2; ++t)
#pragma unroll
          for (int v = 0; v < 4; ++v) { const float e = __builtin_amdgcn_exp2f(sc[q][ur][t][v] - mx); sc[q][ur][t][v] = e; sum += e; }
      sum += __shfl_xor(sum, 16); sum += __shfl_xor(sum, 32);
      inv[q] = 1.0f / sum;
    }
    f32x4 o[2][8];
#pragma unroll
    for (int q = 0; q < 2; ++q)
#pragma unroll
      for (int dt = 0; dt < 8; ++dt) o[q][dt] = (f32x4){0.f, 0.f, 0.f, 0.f};
    bf16x8 pf[2][9];
#pragma unroll
    for (int ur = 0; ur < 9; ++ur)
#pragma unroll
      for (int q = 0; q < 2; ++q) { u32x4 pw; pw.x = cvt_pk_bf16(sc[q][ur][0][0], sc[q][ur][0][1]); pw.y = cvt_pk_bf16(sc[q][ur][0][2], sc[q][ur][0][3]); pw.z = cvt_pk_bf16(sc[q][ur][1][0], sc[q][ur][1][1]); pw.w = cvt_pk_bf16(sc[q][ur][1][2], sc[q][ur][1][3]);
        pf[q][ur] = __builtin_bit_cast(bf16x8, pw); }
    bf16x8 vf[2][8];
    { const bf16_t* vp = VT + (size_t)(h * 128 + n) * NTOK + (size_t)b * SEQ + (size_t)min(rs0, 63) * 64 + c0 + 8 * g;
#pragma unroll
      for (int dt = 0; dt < 8; ++dt) vf[0][dt] = *(const bf16x8*)(vp + (size_t)dt * 16 * NTOK); }
#pragma unroll
    for (int ur = 0; ur < 9; ++ur) {
      if (ur + 1 < 9) { const bf16_t* vp = VT + (size_t)(h * 128 + n) * NTOK + (size_t)b * SEQ + (size_t)min(rs0 + ur + 1, 63) * 64 + c0 + 8 * g;
#pragma unroll
        for (int dt = 0; dt < 8; ++dt) vf[(ur + 1) & 1][dt] = *(const bf16x8*)(vp + (size_t)dt * 16 * NTOK); }
      __builtin_amdgcn_sched_barrier(0);
#pragma unroll
      for (int dt = 0; dt < 8; ++dt) { o[0][dt] = __builtin_amdgcn_mfma_f32_16x16x32_bf16(vf[ur & 1][dt], pf[0][ur], o[0][dt], 0, 0, 0); o[1][dt] = __builtin_amdgcn_mfma_f32_16x16x32_bf16(vf[ur & 1][dt], pf[1][ur], o[1][dt], 0, 0, 0); }
      __builtin_amdgcn_sched_barrier(0);
    }
#pragma unroll
    for (int q = 0; q < 2; ++q) {
      bf16_t* yp = Y + (tq + q * 64) * 1024 + 512 + h * 128 + 4 * g;
#pragma unroll
      for (int dt = 0; dt < 8; ++dt) { u32x2 w; w.x = cvt_pk_bf16(o[q][dt][0] * inv[q], o[q][dt][1] * inv[q]); w.y = cvt_pk_bf16(o[q][dt][2] * inv[q], o[q][dt][3] * inv[q]); *(u32x2*)(yp + dt * 16) = w; }
    }
  }
}

__device__ __forceinline__ void dft_mid_row(const bf16_t* DT, bf16_t* Y, float scale) {
  int tid_ = threadIdx.x; asm volatile("" : "+v"(tid_));
  const int lane = tid_ & 63, gwave = (int)blockIdx.x * 8 + (tid_ >> 6), ngw = (int)gridDim.x * 8;
  for (int it = gwave; it < NB * 512; it += ngw) {
    const bf16_t* row = DT + (size_t)it * 8192;
    float s = 0.f; u32x4 rv[8];
#pragma unroll
    for (int i = 0; i < 8; ++i) rv[i] = *(const u32x4*)(row + (i * 64 + lane) * 8);
    __builtin_amdgcn_sched_barrier(0);
#pragma unroll
    for (int i = 0; i < 8; ++i) { float f[8]; unpack8(rv[i], f); s += (f[0] - f[1]) + (f[2] - f[3]) + (f[4] - f[5]) + (f[6] - f[7]); }
    s = wave_sum(s);
    if (lane == 0) { const int b = it >> 9, r = it & 511, c = 128 * ((r >> 6) & 3) + 64 * (r >> 8) + (r & 63); Y[((size_t)b * SEQ + 2048) * DM + c] = (bf16_t)(cvt_pk_bf16(s * scale, 0.f) & 0xffffu); }
  }
}
__device__ __forceinline__ void ffn_conv_phase(bf16_t* Z, const float* cw, const float* cb) {
  constexpr int R = 32;
  int tid_ = threadIdx.x; asm volatile("" : "+v"(tid_));
  const int gthread = (int)blockIdx.x * 512 + tid_, nthreads = (int)gridDim.x * 512;
  for (int item = gthread; item < (NTOK / R) * 256; item += nthreads) {
    const int cgp = item & 255, run = item >> 8, c = cgp * 8;
    float w0[8], w1[8], w2[8], bb[8];
#pragma unroll
    for (int j = 0; j < 8; ++j) { w0[j] = cw[c + j]; w1[j] = cw[DFF + c + j]; w2[j] = cw[2 * DFF + c + j]; bb[j] = cb[c + j]; }
    const size_t t0 = (size_t)run * R; const int s0 = (int)(t0 & (SEQ - 1));
    bf16_t* zp = Z + t0 * 4096 + c;
    float prev[8], cur[8], nxt[8];
    if (s0 == 0) {
#pragma unroll
      for (int j = 0; j < 8; ++j) prev[j] = 0.f;
    } else unpack8(*(const u32x4*)(zp - 4096 + DFF), prev);
    unpack8(*(const u32x4*)(zp + DFF), cur);
#pragma unroll 4
    for (int r = 0; r < R; ++r) {
      if (s0 + r + 1 < SEQ) unpack8(*(const u32x4*)(zp + (size_t)(r + 1) * 4096 + DFF), nxt);
      else {
#pragma unroll
        for (int j = 0; j < 8; ++j) nxt[j] = 0.f;
      }
      float uu[8]; unpack8(*(const u32x4*)(zp + (size_t)r * 4096), uu);
      float a[8];
#pragma unroll
      for (int j = 0; j < 8; j += 2) {
        f32x2 gv; gv.x = w0[j] * prev[j] + w1[j] * cur[j] + w2[j] * nxt[j] + bb[j]; gv.y = w0[j + 1] * prev[j + 1] + w1[j + 1] * cur[j + 1] + w2[j + 1] * nxt[j + 1] + bb[j + 1];
        const f32x2 ge = gelu_pk(gv); a[j] = ge.x * uu[j]; a[j + 1] = ge.y * uu[j + 1];
      }
      u32x4 w; w.x = cvt_pk_bf16(a[0], a[1]); w.y = cvt_pk_bf16(a[2], a[3]); w.z = cvt_pk_bf16(a[4], a[5]); w.w = cvt_pk_bf16(a[6], a[7]);
      *(u32x4*)(zp + (size_t)r * 4096) = w;
#pragma unroll
      for (int j = 0; j < 8; ++j) { prev[j] = cur[j]; cur[j] = nxt[j]; }
    }
  }
}
__device__ __forceinline__ void gconv_phase(const bf16_t* ZC, bf16_t* Y, const float* cw) {
  constexpr int R = 32;
  int tid_ = threadIdx.x; asm volatile("" : "+v"(tid_));
  const int gthread = (int)blockIdx.x * 512 + tid_, nthreads = (int)gridDim.x * 512;
  for (int item = gthread; item < (NTOK / R) * 128; item += nthreads) {
    const int cgp = item & 127, run = item >> 7, c = cgp * 8;
    float w0[8], w1[8], w2[8];
#pragma unroll
    for (int j = 0; j < 8; ++j) { w0[j] = cw[c + j]; w1[j] = cw[DM + c + j]; w2[j] = cw[2 * DM + c + j]; }
    const size_t t0 = (size_t)run * R; const int s0 = (int)(t0 & (SEQ - 1));
    const bf16_t* zp = ZC + t0 * 3072 + c;
    float prev[8], cur[8], nxt[8], ta[8], tb[8];
    if (s0 == 0) {
#pragma unroll
      for (int j = 0; j < 8; ++j) prev[j] = 0.f;
    } else { unpack8(*(const u32x4*)(zp - 3072 + 1024), ta); unpack8(*(const u32x4*)(zp - 3072 + 2048), tb);
#pragma unroll
      for (int j = 0; j < 8; ++j) prev[j] = ta[j] * tb[j]; }
    unpack8(*(const u32x4*)(zp + 1024), ta); unpack8(*(const u32x4*)(zp + 2048), tb);
#pragma unroll
    for (int j = 0; j < 8; ++j) cur[j] = ta[j] * tb[j];
#pragma unroll 4
    for (int r = 0; r < R; ++r) {
      if (s0 + r + 1 < SEQ) { unpack8(*(const u32x4*)(zp + (size_t)(r + 1) * 3072 + 1024), ta); unpack8(*(const u32x4*)(zp + (size_t)(r + 1) * 3072 + 2048), tb);
#pragma unroll
        for (int j = 0; j < 8; ++j) nxt[j] = ta[j] * tb[j]; }
      else {
#pragma unroll
        for (int j = 0; j < 8; ++j) nxt[j] = 0.f;
      }
      float gb[8]; unpack8(*(const u32x4*)(zp + (size_t)r * 3072), gb);
      float a[8];
#pragma unroll
      for (int j = 0; j < 8; ++j) a[j] = gb[j] * (w0[j] * prev[j] + w1[j] * cur[j] + w2[j] * nxt[j]);
      u32x4 w; w.x = cvt_pk_bf16(a[0], a[1]); w.y = cvt_pk_bf16(a[2], a[3]); w.z = cvt_pk_bf16(a[4], a[5]); w.w = cvt_pk_bf16(a[6], a[7]);
      *(u32x4*)(Y + (t0 + r) * 1024 + c) = w;
#pragma unroll
      for (int j = 0; j < 8; ++j) { prev[j] = cur[j]; cur[j] = nxt[j]; }
    }
  }
}

#define XB_TMO      128
#define XB_XCNT(j)  (256  + 64 * (j))
#define XB_XSUB(j)  (1280 + 64 * (j))
#define XB_XGEN(j)  (2304 + 64 * (j))
#define XB_TOP      3328
#define XB_TOPGEN   3392
#define XCD_BAR_WORDS 3456
#define XB_SPIN_CAP (1u << 18)
__device__ __forceinline__ unsigned xb_ld(unsigned* p)              { return __hip_atomic_load(p, __ATOMIC_RELAXED, __HIP_MEMORY_SCOPE_AGENT); }
__device__ __forceinline__ unsigned xb_add(unsigned* p, unsigned v) { return __hip_atomic_fetch_add(p, v, __ATOMIC_RELAXED, __HIP_MEMORY_SCOPE_AGENT); }
__device__ __forceinline__ unsigned xb_xcc_id() { return (unsigned)__builtin_amdgcn_s_getreg((3 << 11) | 20) & 0xFu; }
#define XB_SPIN(cond, bar) do { unsigned _sp = 0; while (cond) { __builtin_amdgcn_s_sleep(1); \
    if ((++_sp & 255u) == 0u) { if (xb_ld(&(bar)[XB_TMO])) break; if (_sp > XB_SPIN_CAP) { atomicAdd(&(bar)[XB_TMO], 1u); break; } } } } while (0)
__device__ __forceinline__ void xcd_barrier_complete(unsigned* bar, unsigned x, unsigned& nloc, unsigned& nx) {
  const unsigned G = gridDim.x * gridDim.y * gridDim.z;
  unsigned sum, cnt, mine, sp = 0u;
  for (;;) {
    sum = 0u; cnt = 0u; mine = 0u;
#pragma unroll
    for (unsigned j = 0; j < 16; ++j) { const unsigned c = xb_ld(&bar[XB_XCNT(j)]); sum += c; cnt += (c > 0u) ? 1u : 0u; mine = (j == x) ? c : mine; }
    if (sum == G) break;
    __builtin_amdgcn_s_sleep(1);
    if ((++sp & 255u) == 0u) { if (xb_ld(&bar[XB_TMO])) break; if (sp > XB_SPIN_CAP) { atomicAdd(&bar[XB_TMO], 1u); break; } }
  }
  nloc = mine > 0u ? mine : 1u; nx = cnt > 0u ? cnt : 1u;
}
__device__ __forceinline__ void xcd_barrier(volatile LAS unsigned* st) {
  asm volatile("s_waitcnt vmcnt(0)" ::: "memory");
  __syncthreads();
  if (threadIdx.x == 0) {
    unsigned* bar = (unsigned*)kws();
    const unsigned x = xb_xcc_id();
    __builtin_amdgcn_s_waitcnt(0);
    unsigned nloc = st[0], nx = st[1];
    if (nloc == 0u) { xcd_barrier_complete(bar, x, nloc, nx); st[0] = nloc; st[1] = nx; }
    const unsigned old = xb_add(&bar[XB_XSUB(x)], 1u);
    const unsigned gen = old / nloc;
    if (old + 1u == (gen + 1u) * nloc) {
      __builtin_amdgcn_fence(__ATOMIC_RELEASE, "agent");
      asm volatile("s_waitcnt vmcnt(0)" ::: "memory");
      const unsigned og = xb_add(&bar[XB_TOP], 1u);
      const unsigned tg = og / nx;
      if (og + 1u == (tg + 1u) * nx) xb_add(&bar[XB_TOPGEN], 1u);
      else XB_SPIN(xb_ld(&bar[XB_TOPGEN]) == tg, bar);
      __builtin_amdgcn_fence(__ATOMIC_ACQUIRE, "agent");
      xb_add(&bar[XB_XGEN(x)], 1u);
      asm volatile("s_waitcnt vmcnt(0)" ::: "memory");
    } else {
      XB_SPIN(xb_ld(&bar[XB_XGEN(x)]) == gen, bar);
      __builtin_amdgcn_fence(__ATOMIC_ACQUIRE, "agent");
      asm volatile("s_waitcnt vmcnt(0)" ::: "memory");
    }
  }
  __syncthreads();
}

__device__ __forceinline__ Job job_kv(unsigned char* ws, int l) {
  bf16_t* wl = (bf16_t*)(ws + WS_W) + W_LAY + (size_t)l * W_LAY_SZ;
  return job_std((bf16_t*)(ws + WS_MB), DM, wl + (size_t)1024 * DM, DM, DM, 16, 8, (bf16_t*)(ws + WS_KV), 2048);
}
__device__ __forceinline__ Job job_qk(unsigned char* ws, int l) {
  bf16_t* wl = (bf16_t*)(ws + WS_W) + W_LAY + (size_t)l * W_LAY_SZ;
  Job j = job_std((bf16_t*)(ws + WS_KV), 2048, wl, DM, 256, 64, 4, (bf16_t*)(ws + WS_WQK), DM);
  j.adiv = 4; j.a1 = 256 * 2048; j.a0 = 256; j.bdiv = 4; j.b1 = 0; j.b0 = 256; j.b2 = 256 * DM;
  return j;
}
__device__ __forceinline__ Job job_vo(unsigned char* ws, int l) {
  bf16_t* wl = (bf16_t*)(ws + WS_W) + W_LAY + (size_t)l * W_LAY_SZ;
  Job j = job_std(wl + (size_t)3072 * DM, DM, (bf16_t*)(ws + WS_KV) + 1024, 2048, 256, 16, 16, (bf16_t*)(ws + WS_VWO), DM);
  j.adiv = 4; j.a0 = 256 * DM; j.a1 = 256; j.bdiv = 4; j.b1 = 256; j.b0 = 0; j.b2 = 256 * 2048;
  j.odiv = 4; j.r1 = 0; j.r0 = 256; j.r2 = 1024; j.c1 = 256; j.c0 = 0; j.c2 = 0;
  return j;
}

__global__ void __launch_bounds__(512, 2) fwd_megakernel(Params p) {
  extern __shared__ __attribute__((aligned(16))) unsigned char lds_raw[];
  LAS unsigned char* lds = (LAS unsigned char*)lds_raw;
  cg::grid_group grid = cg::this_grid();
  const int G = gridDim.x, bx = blockIdx.x;

  volatile LAS unsigned* barst = (volatile LAS unsigned*)(lds + BARST_OFF);
  if (threadIdx.x < 4) barst[threadIdx.x] = 0u;
  if (bx == 0) { unsigned* bar = (unsigned*)kws(); for (int i = threadIdx.x; i < XCD_BAR_WORDS; i += 512) bar[i] = 0u; }
#ifndef NO_PRO
  prologue(lds);
#endif
  grid.sync();
  if (threadIdx.x == 0) (void)xb_add(&((unsigned*)kws())[XB_XCNT(xb_xcc_id())], 1u);
#define GRID_SYNC() xcd_barrier(barst)

#pragma unroll 1
  for (int l = 0; l < DEPTH; ++l) {
    const int jx = l >> 1;
    if ((l & 1) == 0) {
      { unsigned char* ws = kws(); bf16_t* we = (bf16_t*)(ws + WS_W) + W_EVEN + (size_t)jx * W_EVEN_SZ;
        Job js = job_std(we, DM, (bf16_t*)(ws + WS_HB), DM, DM, 4, 256, (bf16_t*)(ws + WS_Z + Z_DT), 0); js.ssp = (float*)(ws + WS_SSP); js.O2 = (bf16_t*)(ws + WS_Z + Z_VT);
        gemm_phase<EPI_SWAP>(lds, js, G, bx); }
      { unsigned char* ws = kws(); bf16_t* we = (bf16_t*)(ws + WS_W) + W_EVEN + (size_t)jx * W_EVEN_SZ;
        Job jq = job_std((bf16_t*)(ws + WS_HB), DM, we + (size_t)1024 * DM, DM, DM, 256, 4, (bf16_t*)(ws + WS_Z + Z_QK), DM); jq.ssp = (float*)(ws + WS_SSP);
        gemm_phase<EPI_SCALE>(lds, jq, G, bx); }
      { const Job jkv = job_kv(kws(), l); gemm_phase<EPI_SCALE>(lds, jkv, G, bx); }
      GRID_SYNC();
      { unsigned char* ws = kws();
        Job jd = job_std((bf16_t*)(ws + WS_FCAT), 8192, (bf16_t*)(ws + WS_Z + Z_DT), 8192, 8192, 128, 2, (bf16_t*)(ws + WS_Z + Z_YE), DM);
        jd.adiv = 8; jd.a0 = 256 * 8192; jd.a1 = 0; jd.a2 = 2048 * 8192;     jd.bdiv = 8; jd.b1 = 512 * 8192; jd.b0 = 0; jd.b2 = 256 * 8192; jd.cscale = 0.0013810679320049757f;
        jd.chain = 4;
        gemm_phase<EPI_DFT>(lds, jd, G, bx);
        dft_mid_row((bf16_t*)(ws + WS_Z + Z_DT), (bf16_t*)(ws + WS_Z + Z_YE), 0.0013810679320049757f); }
      { const Job jqk = job_qk(kws(), l); gemm_phase<EPI_SCALE>(lds, jqk, G, bx); }
      { const Job jvo = job_vo(kws(), l); gemm_phase<EPI_SCALE>(lds, jvo, G, bx); }
#ifndef NO_NATTEN
      { unsigned char* ws = kws();
        natten_phase((bf16_t*)(ws + WS_Z + Z_QK), (bf16_t*)(ws + WS_Z + Z_VT), (bf16_t*)(ws + WS_Z + Z_YE), kin(5) + (size_t)jx * 4 * 15 * 31, (LAS float*)(lds + XCH_OFF)); }
#endif
      GRID_SYNC();
    } else {
      { unsigned char* ws = kws(); bf16_t* wo = (bf16_t*)(ws + WS_W) + W_ODD + (size_t)jx * W_ODD_SZ;
        Job ji = job_std((bf16_t*)(ws + WS_HB), DM, wo, DM, DM, 256, 4, (bf16_t*)(ws + WS_Z), DM); ji.ssp = (float*)(ws + WS_SSP);
        gemm_phase<EPI_SCALE>(lds, ji, G, bx); }
      { const Job jkv = job_kv(kws(), l); gemm_phase<EPI_SCALE>(lds, jkv, G, bx); }
      GRID_SYNC();
      { unsigned char* ws = kws(); bf16_t* wo = (bf16_t*)(ws + WS_W) + W_ODD + (size_t)jx * W_ODD_SZ;
        Job jc = job_std((bf16_t*)(ws + WS_HB) - DM, DM, wo + (size_t)1024 * DM, DM, DM, 272, 8, (bf16_t*)(ws + WS_Z + Z_YO), DM); jc.ssp = (float*)(ws + WS_SSP);
        jc.adiv = 17; jc.a1 = SEQ * DM; jc.a0 = 254 * DM; jc.cw = kin(8) + (size_t)jx * 3 * DM; jc.GB = (const bf16_t*)(ws + WS_Z);
        gemm_phase<EPI_GCONV>(lds, jc, G, bx); }
      { const Job jqk = job_qk(kws(), l); gemm_phase<EPI_SCALE>(lds, jqk, G, bx); }
      { const Job jvo = job_vo(kws(), l); gemm_phase<EPI_SCALE>(lds, jvo, G, bx); }
      GRID_SYNC();
    }
    { unsigned char* ws = kws(); bf16_t* wb = (bf16_t*)(ws + WS_W);
      const bf16_t* wout = ((l & 1) == 0) ? wb + W_EVEN + (size_t)jx * W_EVEN_SZ + (size_t)2048 * DM : wb + W_ODD + (size_t)jx * W_ODD_SZ + (size_t)3072 * DM;
      const bf16_t* Ymix = (bf16_t*)(ws + WS_Z + (((l & 1) == 0) ? Z_YE : Z_YO));
      Job jo = job_std(Ymix, DM, wout, DM, DM, 256, 4, (bf16_t*)(ws + WS_HB), DM); jo.sspw = (float*)(ws + WS_SSP);
      gemm_phase<EPI_RES>(lds, jo, G, bx); }
    GRID_SYNC();
    { unsigned char* ws = kws();
      Job jx1 = job_std((bf16_t*)(ws + WS_HB), DM, (bf16_t*)(ws + WS_WQK), DM, DM, 256, 4, (bf16_t*)(ws + WS_Z), DM); jx1.bdiv = 16; jx1.b1 = DM * DM; jx1.ssp = (float*)(ws + WS_SSP);
      gemm_phase<EPI_SOFTMAX>(lds, jx1, G, bx); }
    GRID_SYNC();
    { unsigned char* ws = kws();
      Job jx2 = job_std((bf16_t*)(ws + WS_Z), DM, (bf16_t*)(ws + WS_VWO), DM, DM, 256, 4, (bf16_t*)(ws + WS_HB), DM); jx2.bdiv = 16; jx2.b1 = DM * DM; jx2.sspw = (float*)(ws + WS_SSP);
      gemm_phase<EPI_RES>(lds, jx2, G, bx); }
    GRID_SYNC();
    { unsigned char* ws = kws(); bf16_t* wl = (bf16_t*)(ws + WS_W) + W_LAY + (size_t)l * W_LAY_SZ;
      Job ju = job_std((bf16_t*)(ws + WS_HB), DM, wl + (size_t)4096 * DM, DM, DM, 256, 16, (bf16_t*)(ws + WS_Z), DFF); ju.ssp = (float*)(ws + WS_SSP);
      ju.chain = 1; ju.cw = kin(16) + (size_t)l * 3 * DFF; ju.cb = kin(17) + (size_t)l * DFF;
      gemm_phase<EPI_FFN>(lds, ju, G, bx); }
    GRID_SYNC();
    { unsigned char* ws = kws(); bf16_t* wl = (bf16_t*)(ws + WS_W) + W_LAY + (size_t)l * W_LAY_SZ;
      Job jd2 = job_std((bf16_t*)(ws + WS_Z), DFF, wl + (size_t)8192 * DM, DFF, DFF, 256, 4, (bf16_t*)(ws + WS_HB), DM); jd2.sspw = (float*)(ws + WS_SSP);
      gemm_phase<EPI_RES>(lds, jd2, G, bx); }
    GRID_SYNC();
  }
  {
    int tid = threadIdx.x; asm volatile("" : "+v"(tid));
    const int lane = tid & 63, gwave = bx * 8 + (tid >> 6), ngw = G * 8;
    float* H = kout(); unsigned char* ws = kws(); const float* ssp = (const float*)(ws + WS_SSP); const bf16_t* HB = (const bf16_t*)(ws + WS_HB); const float* gf = kin(19);
    f32x4 gg[4];
#pragma unroll
    for (int j = 0; j < 4; ++j) gg[j] = *((const f32x4*)gf + lane + 64 * j);
    for (int r = gwave; r < NTOK; r += 2 * ngw) {
      u32x2 hv[2][4]; float rs[2];
#pragma unroll
      for (int q = 0; q < 2; ++q) { const int rq = min(r + q * ngw, NTOK - 1); rs[q] = rstd_of(ssp, (size_t)rq);
#pragma unroll
        for (int j = 0; j < 4; ++j) hv[q][j] = *((const u32x2*)(HB + (size_t)rq * DM) + lane + 64 * j); }
#pragma unroll
      for (int q = 0; q < 2; ++q) { if (r + q * ngw >= NTOK) continue;
        f32x4* orow = (f32x4*)(H + (size_t)(r + q * ngw) * DM) + lane;
#pragma unroll
        for (int j = 0; j < 4; ++j) { const f32x4 v = (f32x4){bf_lo(hv[q][j].x), bf_hi(hv[q][j].x), bf_lo(hv[q][j].y), bf_hi(hv[q][j].y)}; orow[64 * j] = v * rs[q] * gg[j]; } }
    }
  }
}

extern "C" void kernel_launch(void* const* d_in, const int* in_sizes, int n_in, void* d_out, int out_size, void* d_ws, size_t ws_size, hipStream_t stream) {
  static int grid_blocks = 0;
  if (!grid_blocks) {
    int dev = 0, cus = 0, per_cu = 0;
    (void)hipGetDevice(&dev);
    (void)hipDeviceGetAttribute(&cus, hipDeviceAttributeMultiprocessorCount, dev);
    (void)hipFuncSetAttribute((const void*)fwd_megakernel, hipFuncAttributeMaxDynamicSharedMemorySize, LDS_BYTES);
    (void)hipOccupancyMaxActiveBlocksPerMultiprocessor(&per_cu, (const void*)fwd_megakernel, 512, LDS_BYTES);
    if (per_cu < 1) per_cu = 1;
    grid_blocks = cus * per_cu;
    if (n_in != 20 || out_size != NTOK * DM || ws_size < WS_END) { fprintf(stderr, "kernel_launch: unexpected shapes/workspace (n_in %d out %d ws %zu)\n", n_in, out_size, ws_size); grid_blocks = -1; }
  }
  if (grid_blocks < 0) return;
  Params p{};
  for (int i = 0; i < 20; ++i) p.in[i] = (const float*)d_in[i];
  p.out = (float*)d_out; p.ws = (unsigned char*)d_ws;
  void* args[] = {&p};
  hipError_t e = hipLaunchCooperativeKernel((void*)fwd_megakernel, dim3(grid_blocks), dim3(512), args, LDS_BYTES, stream);
  if (e != hipSuccess) fprintf(stderr, "cooperative launch failed: %s (grid %d)\n", hipGetErrorString(e), grid_blocks);
}
#ifdef TEST_EPI
__global__ void __launch_bounds__(512, 2) test_kernel(Job j, int G) {
  extern __shared__ __attribute__((aligned(16))) unsigned char lds_raw[];
  gemm_phase<TEST_EPI>((LAS unsigned char*)lds_raw, j, G, blockIdx.x);
}
#endif
```

```cpp
#include <hip/hip_runtime.h>
#include <hip/hip_cooperative_groups.h>
#include <cstdio>
#include <cstdint>
namespace cg = cooperative_groups;

#define LAS __attribute__((address_space(3)))
typedef unsigned short bf16_t;
typedef short bf16x8 __attribute__((ext_vector_type(8)));
typedef float f32x4 __attribute__((ext_vector_type(4)));
typedef float f32x2 __attribute__((ext_vector_type(2)));
typedef unsigned u32x4 __attribute__((ext_vector_type(4)));
typedef unsigned u32x2 __attribute__((ext_vector_type(2)));

constexpr int DM = 1024, NB = 16, SEQ = 4096, NTOK = NB * SEQ, DEPTH = 4, NMEM = 256, DFF = 2048;
constexpr float EPS = 1e-6f;
constexpr float LOG2E = 1.4426950408889634f;

constexpr size_t MiB = 1u << 20;
constexpr size_t WS_SSP = 1 * MiB;
constexpr size_t WS_W = 2 * MiB;
constexpr size_t WS_FCAT = 112 * MiB;
constexpr size_t WS_MB = 176 * MiB;
constexpr size_t WS_KV = 184 * MiB;
constexpr size_t WS_WQK = 200 * MiB;
constexpr size_t WS_VWO = 232 * MiB;
constexpr size_t WS_HB = 264 * MiB;
constexpr size_t WS_Z = 392 * MiB;
constexpr size_t WS_END = 904 * MiB;
constexpr size_t Z_DT = 0, Z_QK = 128 * MiB, Z_VT = 256 * MiB, Z_YE = 320 * MiB, Z_YO = 384 * MiB;

constexpr size_t W_EVEN = 0;
constexpr size_t W_EVEN_SZ = (size_t)(1024 + 1024 + 1024) * 1024;
constexpr size_t W_ODD = W_EVEN + 2 * W_EVEN_SZ;
constexpr size_t W_ODD_SZ = (size_t)(3072 + 1024) * 1024;
constexpr size_t W_LAY = W_ODD + 2 * W_ODD_SZ;
constexpr size_t W_LAY_SZ = (size_t)(1024 + 2048 + 1024 + 4096 + 2048) * 1024;
static_assert((W_LAY + 4 * W_LAY_SZ) * 2 <= 110 * MiB, "weights fit");

constexpr int RING_BYTES = 131072, XCH_OFF = RING_BYTES, XCH_BYTES = 8192, BARST_OFF = XCH_OFF + XCH_BYTES, LDS_BYTES = BARST_OFF + 16;

struct Params {
  const float* in[20]; float* out; unsigned char* ws;
};

#define CAS __attribute__((address_space(4)))
__device__ __forceinline__ CAS const char* ka_ptr() { CAS const char* ka = (CAS const char*)__builtin_amdgcn_kernarg_segment_ptr(); asm volatile("" : "+s"(ka)); return ka; }
__device__ __forceinline__ unsigned long long ka_u64(int off) { return *(CAS const unsigned long long*)(ka_ptr() + off); }
__device__ __forceinline__ const float* kin(int i) { return (const float*)(__attribute__((address_space(1))) const float*)ka_u64(8 * i); }
__device__ __forceinline__ float* kout() { return (float*)(__attribute__((address_space(1))) float*)ka_u64(160); }
__device__ __forceinline__ unsigned char* kws() { return (unsigned char*)(__attribute__((address_space(1))) unsigned char*)ka_u64(168); }
#define GAS __attribute__((address_space(1)))
template <class T> __device__ __forceinline__ T* uni(T* p) { const unsigned long long v = (unsigned long long)p; const unsigned lo = __builtin_amdgcn_readfirstlane((unsigned)v), hi = __builtin_amdgcn_readfirstlane((unsigned)(v >> 32)); return (T*)(GAS T*)(((unsigned long long)hi << 32) | lo); }
__device__ __forceinline__ int uni(int v) { return __builtin_amdgcn_readfirstlane(v); }
__device__ __forceinline__ unsigned cvt_pk_bf16(float lo, float hi) { unsigned r; asm volatile("v_cvt_pk_bf16_f32 %0, %1, %2" : "=v"(r) : "v"(lo), "v"(hi)); return r; }
__device__ __forceinline__ float bf_lo(unsigned u) { return __uint_as_float(u << 16); }
__device__ __forceinline__ float bf_hi(unsigned u) { return __uint_as_float(u & 0xffff0000u); }
__device__ __forceinline__ float wave_sum(float v) {
#pragma unroll
  for (int o = 1; o < 64; o <<= 1) v += __shfl_xor(v, o);
  return v;
}
__device__ __forceinline__ f32x2 gelu_pk(f32x2 v) {
  const f32x2 av = __builtin_elementwise_abs(v), d = av * 0.2316418882f + 1.0f;
  f32x2 t; t.x = __builtin_amdgcn_rcpf(d.x); t.y = __builtin_amdgcn_rcpf(d.y);
  f32x2 q = t * 0.5307027145f + (-0.7265760135f); q = q * t + 0.7107068705f; q = q * t + (-0.142248368f); q = q * t + 0.127414796f; q = q * t;
  const f32x2 s = (v * v) * (-0.72134752044f);
  f32x2 e; e.x = __builtin_amdgcn_exp2f(s.x); e.y = __builtin_amdgcn_exp2f(s.y);
  const f32x2 m = v * (q * e), r = v - m;
  f32x2 o; o.x = v.x < 0.f ? m.x : r.x; o.y = v.y < 0.f ? m.y : r.y; return o;
}
__device__ __forceinline__ float rstd_of(const float* ssp, size_t row) {
  const f32x4 s = *(const f32x4*)(ssp + row * 4);
  return rsqrtf(((s.x + s.y) + (s.z + s.w)) * (1.0f / DM) + EPS);
}

__device__ __forceinline__ void unpack8(const u32x4 w, float (&f)[8]) {
  f[0] = bf_lo(w.x); f[1] = bf_hi(w.x); f[2] = bf_lo(w.y); f[3] = bf_hi(w.y); f[4] = bf_lo(w.z); f[5] = bf_hi(w.z); f[6] = bf_lo(w.w); f[7] = bf_hi(w.w);
}

constexpr int BM = 256, BK = 64, HALF = 128, HTB = HALF * BK * 2, NXCD = 8, WGM = 8;
__device__ __forceinline__ int lds_byte(int r, int c) { const int st = (r >> 4) * 2 + (c >> 5), rr = r & 15, cc = c & 31, ob = rr * 64 + cc * 2; return st * 1024 + (ob ^ (((ob >> 9) & 1) << 5)); }
__device__ __forceinline__ void stage_rc(int b, int& R, int& C) { const int st = b / 1024, sb = b % 1024, swz = sb ^ (((sb >> 9) & 1) << 5); R = (st >> 1) * 16 + swz / 64; C = (st & 1) * 32 + (swz % 64) / 2; }
__device__ __forceinline__ int perm32(int rho) { const int n = rho >> 4, i = rho & 15; return 8 * (i >> 2) + 4 * n + (i & 3); }

struct Unit { int pm, pn; };
struct Job {
  const bf16_t* A; const bf16_t* Bt;
  int lda, ldb, K, nM, nN;
  int adiv, bdiv, odiv;
  int a0, a1, a2, b0, b1, b2;
  int r0, r1, r2, c0, c1, c2;
  bf16_t* O; int ldc;
  const float* ssp; float cscale;
  const float* base; float* H; float* sspw;
  bf16_t* O2;
  const float* cw; const float* cb;
  const bf16_t* GB;
  int chain;
};
__device__ __forceinline__ Job job_std(const bf16_t* A, int lda, const bf16_t* Bt, int ldb, int K, int nM, int nN, bf16_t* O, int ldc) {
  Job j; j.A = A; j.Bt = Bt; j.lda = lda; j.ldb = ldb; j.K = K; j.nM = nM; j.nN = nN;
  j.adiv = 1 << 20; j.bdiv = 1 << 20; j.odiv = 1 << 20;
  j.a0 = 256 * lda; j.a1 = 0; j.a2 = 0; j.b0 = 0; j.b1 = 0; j.b2 = 256 * ldb;
  j.r0 = 256; j.r1 = 0; j.r2 = 0; j.c0 = 0; j.c1 = 0; j.c2 = 256;
  j.O = O; j.ldc = ldc; j.ssp = nullptr; j.cscale = 1.0f; j.base = nullptr; j.H = nullptr; j.sspw = nullptr; j.O2 = nullptr; j.cw = nullptr; j.cb = nullptr; j.GB = nullptr; j.chain = 0;
  return j;
}
struct StaticOrder {
  int nM, nN, nwg, G, c, chain;
  __device__ __forceinline__ void init(int nM_, int nN_, int G_, int c_, int chain_) { nM = nM_; nN = nN_; nwg = nM * nN; G = G_; c = c_; chain = chain_; }
  __device__ __forceinline__ bool next(int i, Unit& u) const {
    if (chain == 4) {
      if (G != 256) { const int L = i * G + c; if (L >= nwg) return false; u.pm = uni(L >> 1); u.pn = uni(L & 1); return true; }
      if (i > 0) return false; const int x = c & 7, j = c >> 3; u.pn = uni(x >> 2); u.pm = uni((4 * (x & 3) + (j >> 3)) * 8 + (j & 7)); return true; }
    if (chain) {
      int bq, pq;
      if (G == 256) { if (i >= 16) return false; const int x = c & 7, j = c >> 3; bq = 8 * (x >> 2) + (j >> 2); pq = 4 * (x & 3) + (j & 3); }
      else { const int ch = c + (i >> 4) * G; if (ch >= 256) return false; bq = ch >> 4; pq = ch & 15; }
      u.pm = uni(bq * 16 + (i & 15)); u.pn = uni(pq); return true; }
    const int L = i * G + c; if (L >= nwg) return false;
    int wgid = L; { const int q = nwg / NXCD, r = nwg % NXCD, xcd = wgid % NXCD, off = wgid / NXCD; wgid = (xcd < r ? xcd * (q + 1) : r * (q + 1) + (xcd - r) * q) + off; }
    const int nig = WGM * nN, gid = wgid / nig, fm = gid * WGM, gsz = (nM - fm) < WGM ? (nM - fm) : WGM;
    u.pm = uni(fm + ((wgid % nig) % gsz)); u.pn = uni((wgid % nig) / gsz); return true;
  }
};
__device__ __forceinline__ size_t job_aoff(const Job& g, const Unit& u) { return (size_t)(u.pm / g.adiv) * g.a1 + (size_t)(u.pm % g.adiv) * g.a0 + (size_t)u.pn * g.a2; }
__device__ __forceinline__ size_t job_boff(const Job& g, const Unit& u) { return (size_t)(u.pm / g.bdiv) * g.b1 + (size_t)(u.pm % g.bdiv) * g.b0 + (size_t)u.pn * g.b2; }

#define RSTD_BATCH8(dst, sb, ROWOF) do { f32x4 _t[8]; _Pragma("unroll") for (int _q = 0; _q < 8; ++_q) _t[_q] = *(const f32x4*)((sb) + (size_t)(unsigned)(ROWOF(_q)) * 4); \
    __builtin_amdgcn_sched_barrier(0); _Pragma("unroll") for (int _q = 0; _q < 8; ++_q) (dst)[_q] = rsqrtf(((_t[_q].x + _t[_q].y) + (_t[_q].z + _t[_q].w)) * (1.0f / DM) + EPS); } while (0)
#define ROW8(q) (((q) >> 2) * HALF + rl + ((q) & 3) * 16)
enum { EPI_SCALE = 0, EPI_SWAP = 1, EPI_RES = 2, EPI_SOFTMAX = 3, EPI_FFN = 4, EPI_DFT = 5, EPI_GCONV = 6 };
template <int CTRL> __device__ __forceinline__ float dppf(float old, float src) { return __builtin_bit_cast(float, __builtin_amdgcn_update_dpp(__builtin_bit_cast(int, old), __builtin_bit_cast(int, src), CTRL, 0xF, 0xF, false)); }

template <int EPI>
__device__ __forceinline__ void epilogue(f32x4 (&acc)[2][2][4][2], const Job& g, const Unit& u, int wr, int wc, int fr, int fq, LAS unsigned char* xch) {
  const int rl = wr * 64 + fr, cl = wc * 32 + 8 * fq;
  if constexpr (EPI == EPI_SCALE) {
    const size_t orow0 = (size_t)(u.pm / g.odiv) * g.r1 + (size_t)(u.pm % g.odiv) * g.r0 + (size_t)u.pn * g.r2;
    const int ocol0 = (u.pm / g.odiv) * g.c1 + (u.pm % g.odiv) * g.c0 + u.pn * g.c2;
    bf16_t* obase = uni(g.O + orow0 * g.ldc + ocol0);
    const float* sbase = uni(g.ssp + (size_t)u.pm * BM * 4);
    float scr8[8];
    { const float* sb = g.ssp ? sbase : (const float*)uni(g.A);
      RSTD_BATCH8(scr8, sb, ROW8);
#pragma unroll
      for (int q = 0; q < 8; ++q) scr8[q] = g.ssp ? scr8[q] * g.cscale : g.cscale; }
#pragma unroll
    for (int ai = 0; ai < 2; ++ai)
#pragma unroll
      for (int m = 0; m < 4; ++m) {
        const int lr = ai * HALF + rl + m * 16;
        const float sc = scr8[ai * 4 + m];
        bf16_t* rowp = (bf16_t*)((char*)obase + (unsigned)(lr * g.ldc + cl) * 2u);
#pragma unroll
        for (int bj = 0; bj < 2; ++bj) {
          const f32x4 v0 = acc[ai][bj][m][0] * sc, v1 = acc[ai][bj][m][1] * sc;
          u32x4 w; w.x = cvt_pk_bf16(v0[0], v0[1]); w.y = cvt_pk_bf16(v0[2], v0[3]); w.z = cvt_pk_bf16(v1[0], v1[1]); w.w = cvt_pk_bf16(v1[2], v1[3]);
          __builtin_nontemporal_store(w, (u32x4*)(rowp + bj * HALF));
        }
      }
  } else if constexpr (EPI == EPI_SWAP) {
    float rs[2][8];
    const size_t tokt = (size_t)u.pn * BM;
    const float* sbase = uni(g.ssp + tokt * 4);
#define COL8A(q) (cl + (q))
#define COL8B(q) (cl + HALF + (q))
    RSTD_BATCH8(rs[0], sbase, COL8A);
    RSTD_BATCH8(rs[1], sbase, COL8B);
    __builtin_amdgcn_sched_barrier(0);
    const size_t bq = tokt >> 12, sq = tokt & 4095;
    bf16_t* dtb = uni(g.O + bq * 512 * 8192 + sq);
    bf16_t* vtb = uni(g.O2 + (size_t)((u.pm >= 2 ? u.pm - 2 : 0) * BM) * NTOK + tokt);
#pragma unroll
    for (int ai = 0; ai < 2; ++ai)
#pragma unroll
      for (int m = 0; m < 4; ++m) {
        const int lr = ai * HALF + rl + m * 16;
        int r1, r2, half;
        if (u.pm == 0) { const int gg = lr >> 6, cp = lr & 63; r1 = gg * 64 + cp; r2 = cp ? 256 + gg * 64 + 64 - cp : -1; half = 0; }
        else if (lr < 4) { r1 = 256 + lr * 64; r2 = -1; half = 0; }
        else { const int mm = lr - 4, gg = mm / 63, cp = 1 + mm % 63; r1 = gg * 64 + cp; r2 = 256 + gg * 64 + 64 - cp; half = 1; }
        bf16_t* p1 = (u.pm < 2) ? (bf16_t*)((char*)dtb + ((unsigned)(r1 * 8192 + half * 4096) + (unsigned)cl) * 2u) : (bf16_t*)((char*)vtb + ((unsigned)lr * (unsigned)NTOK + (unsigned)cl) * 2u);
        bf16_t* p2 = (bf16_t*)((char*)dtb + ((unsigned)((r2 < 0 ? 0 : r2) * 8192 + half * 4096) + (unsigned)cl) * 2u);
#pragma unroll
        for (int bj = 0; bj < 2; ++bj) {
          const f32x4 v0 = acc[ai][bj][m][0], v1 = acc[ai][bj][m][1];
          u32x4 w; w.x = cvt_pk_bf16(v0[0] * rs[bj][0], v0[1] * rs[bj][1]); w.y = cvt_pk_bf16(v0[2] * rs[bj][2], v0[3] * rs[bj][3]);
          w.z = cvt_pk_bf16(v1[0] * rs[bj][4], v1[1] * rs[bj][5]); w.w = cvt_pk_bf16(v1[2] * rs[bj][6], v1[3] * rs[bj][7]);
          __builtin_nontemporal_store(w, (u32x4*)(p1 + bj * HALF));
          if (u.pm < 2 && r2 >= 0) __builtin_nontemporal_store(w, (u32x4*)(p2 + bj * HALF));
          if (u.pm == 1 && lr < 4) {
            const u32x4 z = (u32x4){0u, 0u, 0u, 0u};
            __builtin_nontemporal_store(z, (u32x4*)((char*)dtb + ((unsigned)((256 + lr * 64) * 8192 + 4096) + (unsigned)(cl + bj * HALF)) * 2u));
            __builtin_nontemporal_store(z, (u32x4*)((char*)dtb + ((unsigned)((lr * 64) * 8192 + 4096) + (unsigned)(cl + bj * HALF)) * 2u));
          }
        }
      }
  } else if constexpr (EPI == EPI_RES) {
    LAS float* part = (LAS float*)xch;
    const size_t toff = (size_t)u.pm * BM * DM + (size_t)u.pn * BM;
    bf16_t* rO = uni(g.O + toff);
    u32x4 hbv[8][2];
#pragma unroll
    for (int q = 0; q < 8; ++q)
#pragma unroll
      for (int bj = 0; bj < 2; ++bj) hbv[q][bj] = *(const u32x4*)((const char*)rO + ((unsigned)(((q >> 2) * HALF + rl + (q & 3) * 16) * DM + cl) + bj * HALF) * 2u);
    __builtin_amdgcn_sched_barrier(0);
#pragma unroll
    for (int ai = 0; ai < 2; ++ai)
#pragma unroll
      for (int m = 0; m < 4; ++m) {
        const int lr = ai * HALF + rl + m * 16;
        const unsigned off = (unsigned)(lr * DM + cl);
        float ss = 0.f;
#pragma unroll
        for (int bj = 0; bj < 2; ++bj) {
          const u32x4 hb = hbv[ai * 4 + m][bj];
          f32x4 v0 = acc[ai][bj][m][0], v1 = acc[ai][bj][m][1];
          v0[0] += bf_lo(hb.x); v0[1] += bf_hi(hb.x); v0[2] += bf_lo(hb.y); v0[3] += bf_hi(hb.y);
          v1[0] += bf_lo(hb.z); v1[1] += bf_hi(hb.z); v1[2] += bf_lo(hb.w); v1[3] += bf_hi(hb.w);
          ss += (v0[0] * v0[0] + v0[1] * v0[1]) + (v0[2] * v0[2] + v0[3] * v0[3]) + (v1[0] * v1[0] + v1[1] * v1[1]) + (v1[2] * v1[2] + v1[3] * v1[3]);
          u32x4 w; w.x = cvt_pk_bf16(v0[0], v0[1]); w.y = cvt_pk_bf16(v0[2], v0[3]); w.z = cvt_pk_bf16(v1[0], v1[1]); w.w = cvt_pk_bf16(v1[2], v1[3]);
          *(u32x4*)((char*)rO + (off + bj * HALF) * 2u) = w;
        }
        ss += __shfl_xor(ss, 16); ss += __shfl_xor(ss, 32);
        if (fq == 0) part[lr * 4 + wc] = ss;
      }
    asm volatile("s_waitcnt lgkmcnt(0)" ::: "memory"); __builtin_amdgcn_s_barrier(); asm volatile("" ::: "memory");
    const int tix = (wr * 4 + wc) * 64 + fq * 16 + fr;
    if (tix < 256) {
      const f32x4 p = *(const LAS f32x4*)(part + tix * 4);
      float* sw = uni(g.sspw + (size_t)u.pm * BM * 4 + u.pn);
      *(float*)((char*)sw + (unsigned)tix * 16u) = (p.x + p.y) + (p.z + p.w);
    }
  } else if constexpr (EPI == EPI_DFT) {
    const int b = u.pm >> 3, st = u.pm & 7;
    bf16_t* obase = uni(g.O + ((size_t)b * SEQ + st * 256) * DM);
    bf16_t* mbase = uni(g.O + ((size_t)b * SEQ + SEQ - st * 256) * DM);
    const float sc = g.cscale;
#pragma unroll
    for (int ai = 0; ai < 2; ++ai)
#pragma unroll
      for (int m = 0; m < 4; ++m) {
        const int lr = ai * HALF + rl + m * 16;
        bf16_t* rowp = (bf16_t*)((char*)obase + (unsigned)(lr * DM) * 2u);
        bf16_t* mrow = mbase - (size_t)lr * DM;
        const bool mir = (st * 256 + lr) != 0;
#pragma unroll
        for (int bj = 0; bj < 2; ++bj) {
          const f32x4 v0 = acc[ai][bj][m][0] * sc, v1 = acc[ai][bj][m][1] * sc;
          u32x4 w; w.x = cvt_pk_bf16(v0[0], v0[1]); w.y = cvt_pk_bf16(v0[2], v0[3]); w.z = cvt_pk_bf16(v1[0], v1[1]); w.w = cvt_pk_bf16(v1[2], v1[3]);
          const int lc = bj * HALF + cl; const int c = 128 * (lc >> 6) + 64 * u.pn + (lc & 63);
          __builtin_nontemporal_store(w, (u32x4*)(rowp + c));
          if (mir) {
            const int gb = c & ~127, cp = c & 127;
            const unsigned ww[4] = {w.x, w.y, w.z, w.w};
#pragma unroll
            for (int j = 0; j < 8; ++j) mrow[gb + ((128 - (cp + j)) & 127)] = (bf16_t)((j & 1) ? (ww[j >> 1] >> 16) : (ww[j >> 1] & 0xffffu));
          }
        }
      }
  } else if constexpr (EPI == EPI_FFN || EPI == EPI_GCONV) {
    constexpr bool GC = (EPI == EPI_GCONV);
    constexpr int CSTR = GC ? DM : DFF;
    constexpr bool CH = !GC;
    LAS float* X = (LAS float*)xch;
    const int b = CH ? (u.pm >> 4) : u.pm / 17, ti = CH ? (u.pm & 15) : u.pm % 17, s0 = CH ? 256 * ti : 254 * ti - 1;
    LAS float* CYW = X + 1024 + (ti & 1) * 384;
    const LAS float* CYR = X + 1024 + ((ti + 1) & 1) * 384;
    const long row0 = (long)b * SEQ + s0;
    const float* sbase = uni(g.ssp + row0 * 4);
    const int ch0 = u.pn * 128 + cl;
    float rs8[8];
    RSTD_BATCH8(rs8, sbase, ROW8);
    __builtin_amdgcn_sched_barrier(0);
#pragma unroll
    for (int ai = 0; ai < 2; ++ai)
#pragma unroll
      for (int m = 0; m < 4; ++m) {
        const int lr = ai * HALF + rl + m * 16;
        const float sc = rs8[ai * 4 + m];
        const bool inb = CH ? true : ((unsigned)(s0 + lr) < (unsigned)SEQ);
#pragma unroll
        for (int n = 0; n < 2; ++n) {
          if constexpr (GC) { const f32x4 gv = (acc[ai][0][m][n] * sc) * (acc[ai][1][m][n] * sc); acc[ai][1][m][n] = inb ? gv : (f32x4){0.f, 0.f, 0.f, 0.f}; }
          else { acc[ai][0][m][n] = acc[ai][0][m][n] * sc; const f32x4 gv = acc[ai][1][m][n] * sc; acc[ai][1][m][n] = inb ? gv : (f32x4){0.f, 0.f, 0.f, 0.f}; } }
      }
#pragma unroll
    for (int ai = 0; ai < 2; ++ai) {
      const int seg = 2 * ai + wr;
      if (fr == 0) { *(LAS f32x4*)(X + (seg * 2 + 0) * 128 + cl) = acc[ai][1][0][0]; *(LAS f32x4*)(X + (seg * 2 + 0) * 128 + cl + 4) = acc[ai][1][0][1]; }
      if (fr == 15) { *(LAS f32x4*)(X + (seg * 2 + 1) * 128 + cl) = acc[ai][1][3][0]; *(LAS f32x4*)(X + (seg * 2 + 1) * 128 + cl + 4) = acc[ai][1][3][1]; }
    }
    if constexpr (CH) {
      if (wr == 1 && fr == 14) { *(LAS f32x4*)(CYW + cl) = acc[1][1][3][0]; *(LAS f32x4*)(CYW + cl + 4) = acc[1][1][3][1]; }
      if (wr == 1 && fr == 15) { *(LAS f32x4*)(CYW + 128 + cl) = acc[1][1][3][0]; *(LAS f32x4*)(CYW + 128 + cl + 4) = acc[1][1][3][1];
                                 *(LAS f32x4*)(CYW + 256 + cl) = acc[1][0][3][0]; *(LAS f32x4*)(CYW + 256 + cl + 4) = acc[1][0][3][1]; }
    }
    asm volatile("s_waitcnt lgkmcnt(0)" ::: "memory"); __builtin_amdgcn_s_barrier(); asm volatile("" ::: "memory");
    bf16_t* obase = uni(g.O + row0 * CSTR + u.pn * 128);
    const bf16_t* gbase = GC ? uni(g.GB + row0 * DM + u.pn * 128) : nullptr;
    u32x4 gbv[8];
    if constexpr (GC) {
#pragma unroll
      for (int q = 0; q < 8; ++q) gbv[q] = *(const u32x4*)((const char*)gbase + ((unsigned)(ROW8(q) < 1 ? 1 : ROW8(q)) * DM + (unsigned)cl) * 2u);
      __builtin_amdgcn_sched_barrier(0);
    }
    float w0[8], w1[8], w2[8], bb[8];
    { const f32x4 a0 = *(const f32x4*)(g.cw + ch0), a1 = *(const f32x4*)(g.cw + ch0 + 4), b0 = *(const f32x4*)(g.cw + CSTR + ch0), b1 = *(const f32x4*)(g.cw + CSTR + ch0 + 4);
      const f32x4 c0 = *(const f32x4*)(g.cw + 2 * CSTR + ch0), c1 = *(const f32x4*)(g.cw + 2 * CSTR + ch0 + 4);
      f32x4 d0 = (f32x4){0.f, 0.f, 0.f, 0.f}, d1 = d0; if constexpr (!GC) { d0 = *(const f32x4*)(g.cb + ch0); d1 = *(const f32x4*)(g.cb + ch0 + 4); }
#pragma unroll
      for (int j = 0; j < 4; ++j) { w0[j] = a0[j]; w0[4 + j] = a1[j]; w1[j] = b0[j]; w1[4 + j] = b1[j]; w2[j] = c0[j]; w2[4 + j] = c1[j]; bb[j] = d0[j]; bb[4 + j] = d1[j]; } }
#pragma unroll
    for (int ai = 0; ai < 2; ++ai) {
      const int seg = 2 * ai + wr;
      f32x4 pl[2], nl[2];
      const int sp = seg > 0 ? seg - 1 : 0, sn = seg < 3 ? seg + 1 : 3;
      pl[0] = *(const LAS f32x4*)(X + (sp * 2 + 1) * 128 + cl); pl[1] = *(const LAS f32x4*)(X + (sp * 2 + 1) * 128 + cl + 4);
      nl[0] = *(const LAS f32x4*)(X + (sn * 2 + 0) * 128 + cl); nl[1] = *(const LAS f32x4*)(X + (sn * 2 + 0) * 128 + cl + 4);
      if constexpr (CH) {
        if (seg == 0) { if (ti > 0) { pl[0] = *(const LAS f32x4*)(CYR + 128 + cl); pl[1] = *(const LAS f32x4*)(CYR + 128 + cl + 4); } else { pl[0] = (f32x4){0.f, 0.f, 0.f, 0.f}; pl[1] = pl[0]; } }
        if (seg == 3) { nl[0] = (f32x4){0.f, 0.f, 0.f, 0.f}; nl[1] = nl[0]; }
      }
#pragma unroll
      for (int m = 0; m < 4; ++m) {
        const int lr = ai * HALF + rl + m * 16;
        float a[8];
#pragma unroll
        for (int n = 0; n < 2; ++n)
#pragma unroll
          for (int v = 0; v < 4; ++v) {
            const float cur = acc[ai][1][m][n][v];
            float oldp, oldn;
            if (m > 0) { const float t = acc[ai][1][m > 0 ? m - 1 : 0][n][v]; oldp = dppf<0x121>(t, t); } else oldp = pl[n][v];
            if (m < 3) { const float t = acc[ai][1][m < 3 ? m + 1 : 3][n][v]; oldn = dppf<0x12F>(t, t); } else oldn = nl[n][v];
            const float prev = dppf<0x111>(oldp, cur), next = dppf<0x101>(oldn, cur);
            a[4 * n + v] = w0[4 * n + v] * prev + w1[4 * n + v] * cur + w2[4 * n + v] * next + bb[4 * n + v];
          }
        if constexpr (!GC) {
#pragma unroll
          for (int j = 0; j < 8; j += 2) { const f32x2 ge = gelu_pk((f32x2){a[j], a[j + 1]}); a[j] = ge.x * acc[ai][0][m][j >> 2][j & 3]; a[j + 1] = ge.y * acc[ai][0][m][(j + 1) >> 2][(j + 1) & 3]; }
        }
        if (CH ? (lr != 255 || ti == 15) : (lr >= 1 && lr <= 254 && s0 + lr < SEQ)) {
          if constexpr (GC) { float gb[8]; unpack8(gbv[ai * 4 + m], gb);
#pragma unroll
            for (int j = 0; j < 8; ++j) a[j] *= gb[j]; }
          u32x4 w; w.x = cvt_pk_bf16(a[0], a[1]); w.y = cvt_pk_bf16(a[2], a[3]); w.z = cvt_pk_bf16(a[4], a[5]); w.w = cvt_pk_bf16(a[6], a[7]);
          __builtin_nontemporal_store(w, (u32x4*)((char*)obase + ((unsigned)lr * CSTR + (unsigned)cl) * 2u));
        }
      }
    }
    if constexpr (CH) {
      const int tix = (wr * 4 + wc) * 64 + fq * 16 + fr;
      if (ti > 0 && tix < 16) {
        const int ch = tix * 8, gch = u.pn * 128 + ch;
        const f32x4 ga0 = *(const LAS f32x4*)(CYR + ch), ga1 = *(const LAS f32x4*)(CYR + ch + 4), gb0 = *(const LAS f32x4*)(CYR + 128 + ch), gb1 = *(const LAS f32x4*)(CYR + 128 + ch + 4);
        const f32x4 uu0 = *(const LAS f32x4*)(CYR + 256 + ch), uu1 = *(const LAS f32x4*)(CYR + 256 + ch + 4), gn0 = *(const LAS f32x4*)(X + ch), gn1 = *(const LAS f32x4*)(X + ch + 4);
        const f32x4 p0 = *(const f32x4*)(g.cw + gch), p1 = *(const f32x4*)(g.cw + gch + 4), q0 = *(const f32x4*)(g.cw + CSTR + gch), q1 = *(const f32x4*)(g.cw + CSTR + gch + 4);
        const f32x4 r0 = *(const f32x4*)(g.cw + 2 * CSTR + gch), r1 = *(const f32x4*)(g.cw + 2 * CSTR + gch + 4), e0 = *(const f32x4*)(g.cb + gch), e1 = *(const f32x4*)(g.cb + gch + 4);
        const f32x4 x0 = p0 * ga0 + q0 * gb0 + r0 * gn0 + e0, x1 = p1 * ga1 + q1 * gb1 + r1 * gn1 + e1;
        const f32x2 y0 = gelu_pk((f32x2){x0[0], x0[1]}), y1 = gelu_pk((f32x2){x0[2], x0[3]}), y2 = gelu_pk((f32x2){x1[0], x1[1]}), y3 = gelu_pk((f32x2){x1[2], x1[3]});
        u32x4 w; w.x = cvt_pk_bf16(y0.x * uu0[0], y0.y * uu0[1]); w.y = cvt_pk_bf16(y1.x * uu0[2], y1.y * uu0[3]); w.z = cvt_pk_bf16(y2.x * uu1[0], y2.y * uu1[1]); w.w = cvt_pk_bf16(y3.x * uu1[2], y3.y * uu1[3]);
        __builtin_nontemporal_store(w, (u32x4*)(g.O + (row0 - 1) * CSTR + gch));
      }
    }
  } else {
    LAS float* mx = (LAS float*)xch;
    LAS float* sm = (LAS float*)(xch + 4096);
    const float* sbase = uni(g.ssp + (size_t)u.pm * BM * 4);
    bf16_t* obase = uni(g.O + (size_t)u.pm * BM * g.ldc + (size_t)u.pn * BM);
    float rs8[8];
    RSTD_BATCH8(rs8, sbase, ROW8);
    __builtin_amdgcn_sched_barrier(0);
    float mown[8];
#pragma unroll
    for (int ai = 0; ai < 2; ++ai)
#pragma unroll
      for (int m = 0; m < 4; ++m) {
        const int lr = ai * HALF + rl + m * 16;
        const float sc = rs8[ai * 4 + m];
        float mv = -3.0e38f;
#pragma unroll
        for (int bj = 0; bj < 2; ++bj)
#pragma unroll
          for (int n = 0; n < 2; ++n) { f32x4 v = acc[ai][bj][m][n] * sc; acc[ai][bj][m][n] = v; mv = fmaxf(mv, fmaxf(fmaxf(v[0], v[1]), fmaxf(v[2], v[3]))); }
        mv = fmaxf(mv, __shfl_xor(mv, 16)); mv = fmaxf(mv, __shfl_xor(mv, 32));
        mown[ai * 4 + m] = mv;
        float sacc = 0.f;
#pragma unroll
        for (int bj = 0; bj < 2; ++bj)
#pragma unroll
          for (int n = 0; n < 2; ++n) { f32x4 v = acc[ai][bj][m][n];
            v[0] = __builtin_amdgcn_exp2f(v[0] - mv); v[1] = __builtin_amdgcn_exp2f(v[1] - mv); v[2] = __builtin_amdgcn_exp2f(v[2] - mv); v[3] = __builtin_amdgcn_exp2f(v[3] - mv);
            acc[ai][bj][m][n] = v; sacc += (v[0] + v[1]) + (v[2] + v[3]); }
        sacc += __shfl_xor(sacc, 16); sacc += __shfl_xor(sacc, 32);
        if (fq == 0) { mx[lr * 4 + wc] = mv; sm[lr * 4 + wc] = sacc; }
      }
    asm volatile("s_waitcnt lgkmcnt(0)" ::: "memory"); __builtin_amdgcn_s_barrier(); asm volatile("" ::: "memory");
#pragma unroll
    for (int ai = 0; ai < 2; ++ai)
#pragma unroll
      for (int m = 0; m < 4; ++m) {
        const int lr = ai * HALF + rl + m * 16;
        const f32x4 m4 = *(const LAS f32x4*)(mx + lr * 4), s4 = *(const LAS f32x4*)(sm + lr * 4);
        const float M = fmaxf(fmaxf(m4.x, m4.y), fmaxf(m4.z, m4.w));
        const float tot = (s4.x * __builtin_amdgcn_exp2f(m4.x - M) + s4.y * __builtin_amdgcn_exp2f(m4.y - M)) + (s4.z * __builtin_amdgcn_exp2f(m4.z - M) + s4.w * __builtin_amdgcn_exp2f(m4.w - M));
        const float inv = __builtin_amdgcn_exp2f(mown[ai * 4 + m] - M) / tot;
        bf16_t* rowp = (bf16_t*)((char*)obase + (unsigned)(lr * g.ldc + cl) * 2u);
#pragma unroll
        for (int bj = 0; bj < 2; ++bj) {
          const f32x4 v0 = acc[ai][bj][m][0] * inv, v1 = acc[ai][bj][m][1] * inv;
          u32x4 w; w.x = cvt_pk_bf16(v0[0], v0[1]); w.y = cvt_pk_bf16(v0[2], v0[3]); w.z = cvt_pk_bf16(v1[0], v1[1]); w.w = cvt_pk_bf16(v1[2], v1[3]);
          __builtin_nontemporal_store(w, (u32x4*)(rowp + bj * HALF));
        }
      }
  }
}

template <int EPI>
__device__ __forceinline__ void gemm_phase(LAS unsigned char* lds, const Job& g, int G, int c) {
  int tid = threadIdx.x; asm volatile("" : "+v"(tid));
  const int wid = __builtin_amdgcn_readfirstlane(tid >> 6), lane = tid & 63, wr = wid >> 2, wc = wid & 3, fr = lane & 15, fq = lane >> 4;
  const int nt = g.K / BK;
  int c_ = c; asm volatile("" : "+s"(c_));
  StaticOrder S; S.init(g.nM, g.nN, G, c_, g.chain);
  unsigned voffA, voffB;
  { int R, C; stage_rc(tid * 16, R, C); const int Rb = (R & ~31) + perm32(R & 31); voffA = (unsigned)(R * g.lda + C) * 2u; voffB = (unsigned)(Rb * g.ldb + C) * 2u; }
  const size_t rsA = (size_t)64 * g.lda * 2, rsB = (size_t)64 * g.ldb * 2, hA = 2 * rsA, hB = 2 * rsB;
  const size_t kstep = (size_t)(BK * 2);
  const unsigned ldsw = (unsigned)wid * 1024u;
  const int aoff = lds_byte(wr * 64 + fr, fq * 8), boff = lds_byte(wc * 32 + fr, fq * 8);
#define PG8_SA(b, h) (((b) * 2 + (h)) * HTB)
#define PG8_SB(b, h) ((4 + (b) * 2 + (h)) * HTB)
#define PG8_STAGE(bufoff, gbase, voff, rs) do { _Pragma("unroll") for (int _i = 0; _i < 2; ++_i) \
        __builtin_amdgcn_global_load_lds((const unsigned*)((const char*)(gbase) + (size_t)_i * (rs) + (voff)), (LAS unsigned*)(lds + (bufoff) + ldsw + _i * 8192), 16, 0, 0); } while (0)
#define PG8_LDA(dst, b, h) do { _Pragma("unroll") for (int m = 0; m < 4; ++m) _Pragma("unroll") for (int k = 0; k < 2; ++k) dst[m][k] = *(const LAS bf16x8*)(lds + PG8_SA(b, h) + aoff + m * 2048 + k * 1024); } while (0)
#define PG8_LDB(dst, b, h) do { _Pragma("unroll") for (int n = 0; n < 2; ++n) _Pragma("unroll") for (int k = 0; k < 2; ++k) dst[n][k] = *(const LAS bf16x8*)(lds + PG8_SB(b, h) + boff + n * 2048 + k * 1024); } while (0)
#define PG8_MMA(ai, bj, At, Bt) do { __builtin_amdgcn_s_setprio(1); _Pragma("unroll") for (int m = 0; m < 4; ++m) _Pragma("unroll") for (int n = 0; n < 2; ++n) _Pragma("unroll") for (int k = 0; k < 2; ++k) \
        acc[ai][bj][m][n] = __builtin_amdgcn_mfma_f32_16x16x32_bf16(Bt[n][k], At[m][k], acc[ai][bj][m][n], 0, 0, 0); __builtin_amdgcn_s_setprio(0); } while (0)
#define PG8_WAIT_V(n) asm volatile("s_waitcnt vmcnt(" #n ")" ::: "memory")
#define PG8_WAIT_L(n) asm volatile("s_waitcnt lgkmcnt(" #n ")" ::: "memory")
#define PG8_BAR __builtin_amdgcn_s_barrier()
#define PG8_SCHED __builtin_amdgcn_sched_barrier(0)
  Unit cur, nxt; int ui = 0;
  if (!S.next(0, cur)) return;
  const char* gA = uni((const char*)g.A); const char* gB = uni((const char*)g.Bt);
  f32x4 acc[2][2][4][2];
#pragma unroll
  for (int a = 0; a < 2; ++a)
#pragma unroll
    for (int b = 0; b < 2; ++b)
#pragma unroll
      for (int m = 0; m < 4; ++m)
#pragma unroll
        for (int n = 0; n < 2; ++n) acc[a][b][m][n] = (f32x4){0.f, 0.f, 0.f, 0.f};
  bf16x8 At[4][2], B0[2][2], B1[2][2];
  const char* cA = uni(gA + job_aoff(g, cur) * 2); const char* cB = uni(gB + job_boff(g, cur) * 2);
  PG8_STAGE(PG8_SB(0, 0), cB, voffB, rsB); PG8_STAGE(PG8_SB(0, 1), cB + hB, voffB, rsB); PG8_STAGE(PG8_SA(0, 0), cA, voffA, rsA); PG8_STAGE(PG8_SA(0, 1), cA + hA, voffA, rsA);
  if (wr == 1) PG8_BAR;
  PG8_WAIT_V(2); PG8_BAR;
  PG8_STAGE(PG8_SB(1, 0), cB + kstep, voffB, rsB); PG8_STAGE(PG8_SA(1, 0), cA + kstep, voffA, rsA); PG8_STAGE(PG8_SB(1, 1), cB + hB + kstep, voffB, rsB);
  PG8_WAIT_V(6); PG8_BAR;
  for (;;) {
    const bool has_next = S.next(ui + 1, nxt);
    const char* nA = has_next ? uni(gA + job_aoff(g, nxt) * 2) : cA; const char* nB = has_next ? uni(gB + job_boff(g, nxt) * 2) : cB;
    for (int t = 0; t < nt; t += 2) {
      const bool last = (t == nt - 2);
      const char* a1 = cA + (size_t)(t + 1) * kstep;
      const char* a2 = last ? nA : cA + (size_t)(t + 2) * kstep; const char* b2 = last ? nB : cB + (size_t)(t + 2) * kstep;
      const char* a3 = a2 + kstep; const char* b3 = b2 + kstep;
      PG8_LDB(B0, 0, 0); PG8_LDB(B1, 0, 1); PG8_SCHED; PG8_LDA(At, 0, 0); PG8_STAGE(PG8_SA(1, 1), a1 + hA, voffA, rsA);
      PG8_WAIT_V(8); PG8_WAIT_L(0); PG8_BAR; PG8_MMA(0, 0, At, B0); PG8_MMA(0, 1, At, B1); PG8_BAR; PG8_SCHED;
      PG8_LDA(At, 0, 1); PG8_STAGE(PG8_SB(0, 0), b2, voffB, rsB); PG8_STAGE(PG8_SB(0, 1), b2 + hB, voffB, rsB); PG8_STAGE(PG8_SA(0, 0), a2, voffA, rsA);
      PG8_WAIT_V(8); PG8_WAIT_L(0); PG8_BAR; PG8_MMA(1, 0, At, B0); PG8_MMA(1, 1, At, B1); PG8_BAR; PG8_SCHED;
      PG8_LDB(B0, 1, 0); PG8_LDB(B1, 1, 1); PG8_SCHED; PG8_LDA(At, 1, 0); PG8_STAGE(PG8_SA(0, 1), a2 + hA, voffA, rsA);
      PG8_WAIT_V(8); PG8_WAIT_L(0); PG8_BAR; PG8_MMA(0, 0, At, B0); PG8_MMA(0, 1, At, B1); PG8_BAR; PG8_SCHED;
      PG8_LDA(At, 1, 1); PG8_STAGE(PG8_SB(1, 0), b3, voffB, rsB); PG8_STAGE(PG8_SB(1, 1), b3 + hB, voffB, rsB); PG8_STAGE(PG8_SA(1, 0), a3, voffA, rsA);
      PG8_WAIT_V(8); PG8_WAIT_L(0); PG8_BAR; PG8_MMA(1, 0, At, B0); PG8_MMA(1, 1, At, B1); PG8_BAR; PG8_SCHED;
    }
    if (wr == 0) PG8_BAR;
    { int e_fr = fr, e_fq = fq; asm volatile("" : "+v"(e_fr), "+v"(e_fq));
      epilogue<EPI>(acc, g, cur, wr, wc, e_fr, e_fq, lds + XCH_OFF); }
    if (!has_next) break;
#pragma unroll
    for (int a = 0; a < 2; ++a)
#pragma unroll
      for (int b = 0; b < 2; ++b)
#pragma unroll
        for (int m = 0; m < 4; ++m)
#pragma unroll
          for (int n = 0; n < 2; ++n) acc[a][b][m][n] = (f32x4){0.f, 0.f, 0.f, 0.f};
    cur = nxt; cA = nA; cB = nB; ++ui;
    if (wr == 1) PG8_BAR;
  }
  PG8_WAIT_V(0);
  PG8_BAR;
#undef PG8_SA
#undef PG8_SB
#undef PG8_STAGE
#undef PG8_LDA
#undef PG8_LDB
#undef PG8_MMA
#undef PG8_WAIT_V
#undef PG8_WAIT_L
#undef PG8_BAR
#undef PG8_SCHED
}

__device__ __forceinline__ void transpose_item(const float* W, int ldw, int col0, int K, int N, bf16_t* WT, const float* gain, float cs, LAS float* scr, int item, int lane, int permup) {
  const int nblk = N / 32, kb = item / nblk, nb = item % nblk, k0 = 64 * kb, n0 = 32 * nb;
  f32x4 tv[8]; float tg[8];
#pragma unroll
  for (int i = 0; i < 8; ++i) { const int kk = 8 * i + (lane >> 3), nn = (lane & 7) * 4; tv[i] = *(const f32x4*)(W + (size_t)(k0 + kk) * ldw + col0 + n0 + nn); tg[i] = gain ? gain[k0 + kk] : 1.0f; }
  __builtin_amdgcn_sched_barrier(0);
#pragma unroll
  for (int i = 0; i < 8; ++i) { const int kk = 8 * i + (lane >> 3), nn = (lane & 7) * 4; const float gv = tg[i] * cs; const f32x4 v = tv[i];
    LAS float* d = scr + kk * 33 + nn; d[0] = v.x * gv; d[1] = v.y * gv; d[2] = v.z * gv; d[3] = v.w * gv; }
  asm volatile("s_waitcnt lgkmcnt(0)" ::: "memory");
  const int c = lane & 7;
#pragma unroll
  for (int j = 0; j < 4; ++j) { const int n = (lane >> 3) + 8 * j; const LAS float* s = scr + (8 * c) * 33 + n;
    u32x4 o; o.x = cvt_pk_bf16(s[0 * 33], s[1 * 33]); o.y = cvt_pk_bf16(s[2 * 33], s[3 * 33]); o.z = cvt_pk_bf16(s[4 * 33], s[5 * 33]); o.w = cvt_pk_bf16(s[6 * 33], s[7 * 33]);
    const int nn = n0 + n; const int nr = (permup == 1) ? (((nn & 2047) >> 7) * 256 + (nn >> 11) * 128 + (nn & 127)) : (permup == 2) ? (((nn & 1023) >> 7) * 256 + (nn >> 10) * 128 + (nn & 127)) : nn;
    *(u32x4*)(WT + (size_t)nr * K + k0 + 8 * c) = o; }
  asm volatile("s_waitcnt lgkmcnt(0)" ::: "memory");
}
struct TrDesc { const float* W; int ldw, col0, K, N; bf16_t* WT; const float* gain; float cs; int nitems; int permup; };
__device__ __forceinline__ TrDesc tr_desc(bf16_t* wb, int d) {
  TrDesc t; t.cs = 1.0f; t.gain = nullptr; t.col0 = 0; t.permup = 0;
  if (d < 8) {
    const int j = d >> 2, w = d & 3; bf16_t* e = wb + W_EVEN + (size_t)j * W_EVEN_SZ;
    if (w < 3) { t.W = kin(4) + (size_t)j * DM * 2048; t.ldw = 2048; t.col0 = 512 + 512 * w; t.K = DM; t.N = 512; t.gain = kin(3) + (size_t)(2 * j) * DM;
      t.WT = (w == 0) ? e + (size_t)1024 * DM : (w == 1) ? e + (size_t)1536 * DM : e + (size_t)512 * DM;
      if (w == 0) t.cs = 0.08838834764831845f * LOG2E; }
    else { t.W = kin(6) + (size_t)j * DM * DM; t.ldw = DM; t.K = DM; t.N = DM; t.WT = e + (size_t)2048 * DM; }
  } else if (d < 14) {
    const int j = (d - 8) / 3, w = (d - 8) % 3; bf16_t* o = wb + W_ODD + (size_t)j * W_ODD_SZ;
    if (w == 0) { t.W = kin(7) + (size_t)j * DM * 3072; t.ldw = 3072; t.K = DM; t.N = 1024; t.gain = kin(3) + (size_t)(2 * j + 1) * DM; t.WT = o; }
    else if (w == 2) { t.W = kin(7) + (size_t)j * DM * 3072; t.ldw = 3072; t.col0 = 1024; t.K = DM; t.N = 2048; t.gain = kin(3) + (size_t)(2 * j + 1) * DM; t.WT = o + (size_t)1024 * DM; t.permup = 2; }
    else { t.W = kin(9) + (size_t)j * DM * DM; t.ldw = DM; t.K = DM; t.N = DM; t.WT = o + (size_t)3072 * DM; }
  } else {
    const int l = (d - 14) >> 2, w = (d - 14) & 3; bf16_t* y = wb + W_LAY + (size_t)l * W_LAY_SZ;
    if (w == 0) { t.W = kin(12) + (size_t)l * DM * 2048; t.ldw = 2048; t.K = DM; t.N = 2048; t.WT = y + (size_t)1024 * DM; }
    else if (w == 1) { t.W = kin(13) + (size_t)l * DM * DM; t.ldw = DM; t.K = DM; t.N = DM; t.WT = y + (size_t)3072 * DM; }
    else if (w == 2) { t.W = kin(15) + (size_t)l * DM * 4096; t.ldw = 4096; t.K = DM; t.N = 4096; t.gain = kin(14) + (size_t)l * DM; t.WT = y + (size_t)4096 * DM; t.permup = 1; }
    else { t.W = kin(18) + (size_t)l * DFF * DM; t.ldw = DM; t.K = DFF; t.N = DM; t.WT = y + (size_t)8192 * DM; }
  }
  t.nitems = (t.K / 64) * (t.N / 32);
  return t;
}

__device__ __forceinline__ void prologue(LAS unsigned char* lds) {
  int tid_ = threadIdx.x; asm volatile("" : "+v"(tid_));
  const int lane = tid_ & 63, wave = __builtin_amdgcn_readfirstlane(tid_ >> 6), gwave = (int)blockIdx.x * 8 + wave, ngw = (int)gridDim.x * 8;
  unsigned char* ws = kws();
  bf16_t* wb = (bf16_t*)(ws + WS_W);
  LAS float* scr = (LAS float*)(lds + wave * 16384);
  for (int d = 0; d < 30; ++d) {
    const TrDesc t = tr_desc(wb, d);
    for (int it = (gwave + d * 293) % ngw; it < t.nitems; it += ngw) transpose_item(t.W, t.ldw, t.col0, t.K, t.N, t.WT, t.gain, t.cs, scr, it, lane, t.permup);
  }
  {
    const size_t n4 = (size_t)DEPTH * DM * DM / 4;
    for (size_t i = (size_t)gwave * 64 + lane; i < n4; i += (size_t)ngw * 64) {
      const size_t e = i * 4; const int l = (int)(e / ((size_t)DM * DM)); const size_t r = e % ((size_t)DM * DM); const int k = (int)(r / DM);
      const f32x4 v = *(const f32x4*)(kin(11) + e); const float gv = kin(10)[l * DM + k] * (0.0625f * LOG2E);
      u32x2 w; w.x = cvt_pk_bf16(v[0] * gv, v[1] * gv); w.y = cvt_pk_bf16(v[2] * gv, v[3] * gv);
      *(u32x2*)(wb + W_LAY + (size_t)l * W_LAY_SZ + r) = w;
    }
  }
  LAS float* T = (LAS float*)(lds + RING_BYTES - 16384);
  __syncthreads();
  LAS float* T128 = (LAS float*)(lds + XCH_OFF);
  for (int i = tid_; i < 4096; i += 512) T[i] = cospif((float)i * (1.0f / 2048.0f));
  if (tid_ < 128) T128[tid_] = cospif((float)tid_ * (1.0f / 64.0f));
  __syncthreads();
  {
    bf16_t* F = (bf16_t*)(ws + WS_FCAT);
    const size_t nchunk = (size_t)4096 * 8192 / 8;
    for (size_t ci = (size_t)gwave * 64 + lane; ci < nchunk; ci += (size_t)ngw * 64) {
      const int s = (int)(ci >> 10), k0 = (int)(ci & 1023) * 8;
      float v[8];
#pragma unroll
      for (int j = 0; j < 8; ++j) { const int k = k0 + j; const int sr = s & 2047; const int idx = (k < 4096) ? ((sr * k) & 4095) : ((sr * (k - 4096) + ((s < 2048) ? 1024 : 3072)) & 4095); v[j] = T[idx]; }
      u32x4 w; w.x = cvt_pk_bf16(v[0], v[1]); w.y = cvt_pk_bf16(v[2], v[3]); w.z = cvt_pk_bf16(v[4], v[5]); w.w = cvt_pk_bf16(v[6], v[7]);
      *(u32x4*)(F + ci * 8) = w;
    }
  }
  for (int it = gwave; it < 2 * 1024 * 4; it += ngw) {
    const int j = it >> 12, k = (it >> 2) & 1023, gq = it & 3;
    const float* wrow = kin(4) + ((size_t)j * DM + k) * 2048 + gq * 128;
    const float gv = kin(3)[(2 * j) * DM + k];
    const float w0 = wrow[lane] * gv, w1 = wrow[64 + lane] * gv;
    float ac0 = 0.f, ac1 = 0.f, as0 = 0.f;
#pragma unroll 8
    for (int c = 0; c < 128; ++c) {
      const float wv = (c < 64) ? __shfl(w0, c) : __shfl(w1, c - 64);
      const int i0 = (c * lane) & 127, i1 = (c * (lane + 64)) & 127;
      ac0 += wv * T128[i0]; as0 += wv * T128[(i0 + 96) & 127];
      ac1 += wv * T128[i1];
    }
    bf16_t* e = wb + W_EVEN + (size_t)j * W_EVEN_SZ;
    e[(size_t)(gq * 64 + lane) * DM + k] = (bf16_t)(cvt_pk_bf16(ac0, 0.f) & 0xffff);
    if (lane == 0) e[(size_t)(256 + gq) * DM + k] = (bf16_t)(cvt_pk_bf16(ac1, 0.f) & 0xffff);
    else e[(size_t)(260 + gq * 63 + lane - 1) * DM + k] = (bf16_t)(cvt_pk_bf16(as0, 0.f) & 0xffff);
  }
  for (int r = gwave; r < NB * NMEM; r += ngw) {
    const f32x4* xr = (const f32x4*)(kin(1) + (size_t)r * DM) + lane; f32x4 v[4]; float s = 0.f;
#pragma unroll
    for (int j = 0; j < 4; ++j) { v[j] = xr[64 * j]; s += (v[j].x * v[j].x + v[j].y * v[j].y) + (v[j].z * v[j].z + v[j].w * v[j].w); }
    const float rs = rsqrtf(wave_sum(s) * (1.0f / DM) + EPS);
    u32x2* o = (u32x2*)((bf16_t*)(ws + WS_MB) + (size_t)r * DM) + lane;
#pragma unroll
    for (int j = 0; j < 4; ++j) { const f32x4 gg = *((const f32x4*)kin(2) + lane + 64 * j);
      u32x2 w; w.x = cvt_pk_bf16(v[j].x * rs * gg.x, v[j].y * rs * gg.y); w.y = cvt_pk_bf16(v[j].z * rs * gg.z, v[j].w * rs * gg.w); o[64 * j] = w; }
  }
  {
    const float* xin = kin(0); bf16_t* hbp = (bf16_t*)(ws + WS_HB); float* sspp = (float*)(ws + WS_SSP);
    for (int r = gwave; r < NTOK; r += 4 * ngw) {
      f32x4 v[4][4];
#pragma unroll
      for (int q = 0; q < 4; ++q) { const int rq = min(r + q * ngw, NTOK - 1); const f32x4* xr = (const f32x4*)(xin + (size_t)rq * DM) + lane;
#pragma unroll
        for (int j = 0; j < 4; ++j) v[q][j] = xr[64 * j]; }
#pragma unroll
      for (int q = 0; q < 4; ++q) { float sq = 0.f;
#pragma unroll
        for (int j = 0; j < 4; ++j) sq += (v[q][j].x * v[q][j].x + v[q][j].y * v[q][j].y) + (v[q][j].z * v[q][j].z + v[q][j].w * v[q][j].w);
        sq = wave_sum(sq);
        if (r + q * ngw >= NTOK) continue;
        u32x2* o = (u32x2*)(hbp + (size_t)(r + q * ngw) * DM) + lane;
#pragma unroll
        for (int j = 0; j < 4; ++j) { u32x2 w; w.x = cvt_pk_bf16(v[q][j].x, v[q][j].y); w.y = cvt_pk_bf16(v[q][j].z, v[q][j].w); o[64 * j] = w; }
        if (lane == 0) *(f32x4*)(sspp + (size_t)(r + q * ngw) * 4) = (f32x4){sq, 0.f, 0.f, 0.f}; }
    }
  }
}

__device__ __forceinline__ void natten_phase(const bf16_t* QK, const bf16_t* VT, bf16_t* Y, const float* rpb, LAS float* rpbs) {
  int tid_ = threadIdx.x; asm volatile("" : "+v"(tid_));
  const int lane = tid_ & 63, wave = __builtin_amdgcn_readfirstlane(tid_ >> 6);
  for (int i = tid_; i < 4 * 15 * 31; i += 512) rpbs[i] = rpb[i] * LOG2E;
  __syncthreads();
  const int n = lane & 15, g = lane >> 4;
  const int keyl = 8 * (n >> 2) + (n & 3);
  const int vcu0 = ((gridDim.x & 7) == 0) ? ((int)blockIdx.x & 7) * ((int)gridDim.x >> 3) + ((int)blockIdx.x >> 3) : (int)blockIdx.x;
  for (int slot = vcu0; slot < 256; slot += (int)gridDim.x)
  for (int it = 0; it < 4; ++it) {
    const int u = (slot * 4 + it) * 8 + wave;
    const int jb = u & 3, ip = (u >> 2) & 31, h = (u >> 7) & 3, b = u >> 9;
    const int i0 = 2 * ip;
    const int rs0 = min(max(i0 - 4, 0), 56), d1 = min(max(i0 - 3, 0), 56) - rs0;
    const int c0 = (jb == 0) ? 0 : (jb == 1) ? 8 : (jb == 2) ? 24 : 32;
    const int j = jb * 16 + n; const int cs = min(max(j - 8, 0), 48);
    const size_t tq = (size_t)b * SEQ + i0 * 64 + j;
    bf16x8 qf[2][4];
#pragma unroll
    for (int q = 0; q < 2; ++q)
#pragma unroll
      for (int ks = 0; ks < 4; ++ks) qf[q][ks] = *(const bf16x8*)(QK + (tq + q * 64) * 1024 + h * 128 + ks * 32 + 8 * g);
    f32x4 sc[2][9][2];
#pragma unroll
    for (int ur = 0; ur < 9; ++ur) {
      const int krow = min(rs0 + ur, 63);
      const size_t tk0 = (size_t)b * SEQ + (size_t)krow * 64 + c0;
      bf16x8 kf[2][4];
#pragma unroll
      for (int t = 0; t < 2; ++t) {
        const bf16_t* kp = QK + (tk0 + keyl + 4 * t) * 1024 + 512 + h * 128 + 8 * g;
#pragma unroll
        for (int ks = 0; ks < 4; ++ks) kf[t][ks] = *(const bf16x8*)(kp + ks * 32);
      }
      __builtin_amdgcn_sched_barrier(0);
#pragma unroll
      for (int t = 0; t < 2; ++t) {
        f32x4 a0 = (f32x4){0.f, 0.f, 0.f, 0.f}, a1 = a0;
#pragma unroll
        for (int ks = 0; ks < 4; ++ks) { a0 = __builtin_amdgcn_mfma_f32_16x16x32_bf16(kf[t][ks], qf[0][ks], a0, 0, 0, 0); a1 = __builtin_amdgcn_mfma_f32_16x16x32_bf16(kf[t][ks], qf[1][ks], a1, 0, 0, 0); }
        sc[0][ur][t] = a0; sc[1][ur][t] = a1;
      }
      __builtin_amdgcn_sched_barrier(0);
    }
    float inv[2];
#pragma unroll
    for (int q = 0; q < 2; ++q) {
      const int dq = q ? d1 : 0, iq = i0 + q;
      float mx = -3.0e38f;
#pragma unroll
      for (int ur = 0; ur < 9; ++ur) {
        const bool rowv = (unsigned)(ur - dq) < 8u;
        const LAS float* brow = rpbs + h * 465 + min(max(rs0 + ur - iq + 7, 0), 14) * 31;
#pragma unroll
        for (int t = 0; t < 2; ++t)
#pragma unroll
          for (int v = 0; v < 4; ++v) {
            const int kc = c0 + 8 * g + 4 * t + v;
            const bool valid = rowv && (kc >= cs) && (kc < cs + 16);
            const int co = min(max(kc - j + 15, 0), 30);
            const float s = valid ? sc[q][ur][t][v] + brow[co] : -3.0e38f;
            sc[q][ur][t][v] = s; mx = fmaxf(mx, s);
          }
      }
      mx = fmaxf(mx, __shfl_xor(mx, 16)); mx = fmaxf(mx, __shfl_xor(mx, 32));
      float sum = 0.f;
#pragma unroll
      for (int ur = 0; ur < 9; ++ur)
#pragma unroll
        for (int t = 0; t < 2; ++t)
#pragma unroll
          for (int v = 0; v < 4; ++v) { const float e = __builtin_amdgcn_exp2f(sc[q][ur][t][v] - mx); sc[q][ur][t][v] = e; sum += e; }
      sum += __shfl_xor(sum, 16); sum += __shfl_xor(sum, 32);
      inv[q] = 1.0f / sum;
    }
    f32x4 o[2][8];
#pragma unroll
    for (int q = 0; q < 2; ++q)
#pragma unroll
      for (int dt = 0; dt < 8; ++dt) o[q][dt] = (f32x4){0.f, 0.f, 0.f, 0.f};
    bf16x8 pf[2][9];
#pragma unroll
    for (int ur = 0; ur < 9; ++ur)
#pragma unroll
      for (int q = 0; q < 2; ++q) { u32x4 pw; pw.x = cvt_pk_bf16(sc[q][ur][0][0], sc[q][ur][0][1]); pw.y = cvt_pk_bf16(sc[q][ur][0][2], sc[q][ur][0][3]); pw.z = cvt_pk_bf16(sc[q][ur][1][0], sc[q][ur][1][1]); pw.w = cvt_pk_bf16(sc[q][ur][1][2], sc[q][ur][1][3]);
        pf[q][ur] = __builtin_bit_cast(bf16x8, pw); }
    bf16x8 vf[2][8];
    { const bf16_t* vp = VT + (size_t)(h * 128 + n) * NTOK + (size_t)b * SEQ + (size_t)min(rs0, 63) * 64 + c0 + 8 * g;
#pragma unroll
      for (int dt = 0; dt < 8; ++dt) vf[0][dt] = *(const bf16x8*)(vp + (size_t)dt * 16 * NTOK); }
#pragma unroll
    for (int ur = 0; ur < 9; ++ur) {
      if (ur + 1 < 9) { const bf16_t* vp = VT + (size_t)(h * 128 + n) * NTOK + (size_t)b * SEQ + (size_t)min(rs0 + ur + 1, 63) * 64 + c0 + 8 * g;
#pragma unroll
        for (int dt = 0; dt < 8; ++dt) vf[(ur + 1) & 1][dt] = *(const bf16x8*)(vp + (size_t)dt * 16 * NTOK); }
      __builtin_amdgcn_sched_barrier(0);
#pragma unroll
      for (int dt = 0; dt < 8; ++dt) { o[0][dt] = __builtin_amdgcn_mfma_f32_16x16x32_bf16(vf[ur & 1][dt], pf[0][ur], o[0][dt], 0, 0, 0); o[1][dt] = __builtin_amdgcn_mfma_f32_16x16x32_bf16(vf[ur & 1][dt], pf[1][ur], o[1][dt], 0, 0, 0); }
      __builtin_amdgcn_sched_barrier(0);
    }
#pragma unroll
    for (int q = 0; q < 2; ++q) {
      bf16_t* yp = Y + (tq + q * 64) * 1024 + 512 + h * 128 + 4 * g;
#pragma unroll
      for (int dt = 0; dt < 8; ++dt) { u32x2 w; w.x = cvt_pk_bf16(o[q][dt][0] * inv[q], o[q][dt][1] * inv[q]); w.y = cvt_pk_bf16(o[q][dt][2] * inv[q], o[q][dt][3] * inv[q]); *(u32x2*)(yp + dt * 16) = w; }
    }
  }
}

__device__ __forceinline__ void dft_mid_row(const bf16_t* DT, bf16_t* Y, float scale) {
  int tid_ = threadIdx.x; asm volatile("" : "+v"(tid_));
  const int lane = tid_ & 63, gwave = (int)blockIdx.x * 8 + (tid_ >> 6), ngw = (int)gridDim.x * 8;
  for (int it = gwave; it < NB * 512; it += ngw) {
    const bf16_t* row = DT + (size_t)it * 8192;
    float s = 0.f; u32x4 rv[8];
#pragma unroll
    for (int i = 0; i < 8; ++i) rv[i] = *(const u32x4*)(row + (i * 64 + lane) * 8);
    __builtin_amdgcn_sched_barrier(0);
#pragma unroll
    for (int i = 0; i < 8; ++i) { float f[8]; unpack8(rv[i], f); s += (f[0] - f[1]) + (f[2] - f[3]) + (f[4] - f[5]) + (f[6] - f[7]); }
    s = wave_sum(s);
    if (lane == 0) { const int b = it >> 9, r = it & 511, c = 128 * ((r >> 6) & 3) + 64 * (r >> 8) + (r & 63); Y[((size_t)b * SEQ + 2048) * DM + c] = (bf16_t)(cvt_pk_bf16(s * scale, 0.f) & 0xffffu); }
  }
}
__device__ __forceinline__ void ffn_conv_phase(bf16_t* Z, const float* cw, const float* cb) {
  constexpr int R = 32;
  int tid_ = threadIdx.x; asm volatile("" : "+v"(tid_));
  const int gthread = (int)blockIdx.x * 512 + tid_, nthreads = (int)gridDim.x * 512;
  for (int item = gthread; item < (NTOK / R) * 256; item += nthreads) {
    const int cgp = item & 255, run = item >> 8, c = cgp * 8;
    float w0[8], w1[8], w2[8], bb[8];
#pragma unroll
    for (int j = 0; j < 8; ++j) { w0[j] = cw[c + j]; w1[j] = cw[DFF + c + j]; w2[j] = cw[2 * DFF + c + j]; bb[j] = cb[c + j]; }
    const size_t t0 = (size_t)run * R; const int s0 = (int)(t0 & (SEQ - 1));
    bf16_t* zp = Z + t0 * 4096 + c;
    float prev[8], cur[8], nxt[8];
    if (s0 == 0) {
#pragma unroll
      for (int j = 0; j < 8; ++j) prev[j] = 0.f;
    } else unpack8(*(const u32x4*)(zp - 4096 + DFF), prev);
    unpack8(*(const u32x4*)(zp + DFF), cur);
#pragma unroll 4
    for (int r = 0; r < R; ++r) {
      if (s0 + r + 1 < SEQ) unpack8(*(const u32x4*)(zp + (size_t)(r + 1) * 4096 + DFF), nxt);
      else {
#pragma unroll
        for (int j = 0; j < 8; ++j) nxt[j] = 0.f;
      }
      float uu[8]; unpack8(*(const u32x4*)(zp + (size_t)r * 4096), uu);
      float a[8];
#pragma unroll
      for (int j = 0; j < 8; j += 2) {
        f32x2 gv; gv.x = w0[j] * prev[j] + w1[j] * cur[j] + w2[j] * nxt[j] + bb[j]; gv.y = w0[j + 1] * prev[j + 1] + w1[j + 1] * cur[j + 1] + w2[j + 1] * nxt[j + 1] + bb[j + 1];
        const f32x2 ge = gelu_pk(gv); a[j] = ge.x * uu[j]; a[j + 1] = ge.y * uu[j + 1];
      }
      u32x4 w; w.x = cvt_pk_bf16(a[0], a[1]); w.y = cvt_pk_bf16(a[2], a[3]); w.z = cvt_pk_bf16(a[4], a[5]); w.w = cvt_pk_bf16(a[6], a[7]);
      *(u32x4*)(zp + (size_t)r * 4096) = w;
#pragma unroll
      for (int j = 0; j < 8; ++j) { prev[j] = cur[j]; cur[j] = nxt[j]; }
    }
  }
}
__device__ __forceinline__ void gconv_phase(const bf16_t* ZC, bf16_t* Y, const float* cw) {
  constexpr int R = 32;
  int tid_ = threadIdx.x; asm volatile("" : "+v"(tid_));
  const int gthread = (int)blockIdx.x * 512 + tid_, nthreads = (int)gridDim.x * 512;
  for (int item = gthread; item < (NTOK / R) * 128; item += nthreads) {
    const int cgp = item & 127, run = item >> 7, c = cgp * 8;
    float w0[8], w1[8], w2[8];
#pragma unroll
    for (int j = 0; j < 8; ++j) { w0[j] = cw[c + j]; w1[j] = cw[DM + c + j]; w2[j] = cw[2 * DM + c + j]; }
    const size_t t0 = (size_t)run * R; const int s0 = (int)(t0 & (SEQ - 1));
    const bf16_t* zp = ZC + t0 * 3072 + c;
    float prev[8], cur[8], nxt[8], ta[8], tb[8];
    if (s0 == 0) {
#pragma unroll
      for (int j = 0; j < 8; ++j) prev[j] = 0.f;
    } else { unpack8(*(const u32x4*)(zp - 3072 + 1024), ta); unpack8(*(const u32x4*)(zp - 3072 + 2048), tb);
#pragma unroll
      for (int j = 0; j < 8; ++j) prev[j] = ta[j] * tb[j]; }
    unpack8(*(const u32x4*)(zp + 1024), ta); unpack8(*(const u32x4*)(zp + 2048), tb);
#pragma unroll
    for (int j = 0; j < 8; ++j) cur[j] = ta[j] * tb[j];
#pragma unroll 4
    for (int r = 0; r < R; ++r) {
      if (s0 + r + 1 < SEQ) { unpack8(*(const u32x4*)(zp + (size_t)(r + 1) * 3072 + 1024), ta); unpack8(*(const u32x4*)(zp + (size_t)(r + 1) * 3072 + 2048), tb);
#pragma unroll
        for (int j = 0; j < 8; ++j) nxt[j] = ta[j] * tb[j]; }
      else {
#pragma unroll
        for (int j = 0; j < 8; ++j) nxt[j] = 0.f;
      }
      float gb[8]; unpack8(*(const u32x4*)(zp + (size_t)r * 3072), gb);
      float a[8];
#pragma unroll
      for (int j = 0; j < 8; ++j) a[j] = gb[j] * (w0[j] * prev[j] + w1[j] * cur[j] + w2[j] * nxt[j]);
      u32x4 w; w.x = cvt_pk_bf16(a[0], a[1]); w.y = cvt_pk_bf16(a[2], a[3]); w.z = cvt_pk_bf16(a[4], a[5]); w.w = cvt_pk_bf16(a[6], a[7]);
      *(u32x4*)(Y + (t0 + r) * 1024 + c) = w;
#pragma unroll
      for (int j = 0; j < 8; ++j) { prev[j] = cur[j]; cur[j] = nxt[j]; }
    }
  }
}

#define XB_TMO      128
#define XB_XCNT(j)  (256  + 64 * (j))
#define XB_XSUB(j)  (1280 + 64 * (j))
#define XB_XGEN(j)  (2304 + 64 * (j))
#define XB_TOP      3328
#define XB_TOPGEN   3392
#define XCD_BAR_WORDS 3456
#define XB_SPIN_CAP (1u << 18)
__device__ __forceinline__ unsigned xb_ld(unsigned* p)              { return __hip_atomic_load(p, __ATOMIC_RELAXED, __HIP_MEMORY_SCOPE_AGENT); }
__device__ __forceinline__ unsigned xb_add(unsigned* p, unsigned v) { return __hip_atomic_fetch_add(p, v, __ATOMIC_RELAXED, __HIP_MEMORY_SCOPE_AGENT); }
__device__ __forceinline__ unsigned xb_xcc_id() { return (unsigned)__builtin_amdgcn_s_getreg((3 << 11) | 20) & 0xFu; }
#define XB_SPIN(cond, bar) do { unsigned _sp = 0; while (cond) { __builtin_amdgcn_s_sleep(1); \
    if ((++_sp & 255u) == 0u) { if (xb_ld(&(bar)[XB_TMO])) break; if (_sp > XB_SPIN_CAP) { atomicAdd(&(bar)[XB_TMO], 1u); break; } } } } while (0)
__device__ __forceinline__ void xcd_barrier_complete(unsigned* bar, unsigned x, unsigned& nloc, unsigned& nx) {
  const unsigned G = gridDim.x * gridDim.y * gridDim.z;
  unsigned sum, cnt, mine, sp = 0u;
  for (;;) {
    sum = 0u; cnt = 0u; mine = 0u;
#pragma unroll
    for (unsigned j = 0; j < 16; ++j) { const unsigned c = xb_ld(&bar[XB_XCNT(j)]); sum += c; cnt += (c > 0u) ? 1u : 0u; mine = (j == x) ? c : mine; }
    if (sum == G) break;
    __builtin_amdgcn_s_sleep(1);
    if ((++sp & 255u) == 0u) { if (xb_ld(&bar[XB_TMO])) break; if (sp > XB_SPIN_CAP) { atomicAdd(&bar[XB_TMO], 1u); break; } }
  }
  nloc = mine > 0u ? mine : 1u; nx = cnt > 0u ? cnt : 1u;
}
__device__ __forceinline__ void xcd_barrier(volatile LAS unsigned* st) {
  asm volatile("s_waitcnt vmcnt(0)" ::: "memory");
  __syncthreads();
  if (threadIdx.x == 0) {
    unsigned* bar = (unsigned*)kws();
    const unsigned x = xb_xcc_id();
    __builtin_amdgcn_s_waitcnt(0);
    unsigned nloc = st[0], nx = st[1];
    if (nloc == 0u) { xcd_barrier_complete(bar, x, nloc, nx); st[0] = nloc; st[1] = nx; }
    const unsigned old = xb_add(&bar[XB_XSUB(x)], 1u);
    const unsigned gen = old / nloc;
    if (old + 1u == (gen + 1u) * nloc) {
      __builtin_amdgcn_fence(__ATOMIC_RELEASE, "agent");
      asm volatile("s_waitcnt vmcnt(0)" ::: "memory");
      const unsigned og = xb_add(&bar[XB_TOP], 1u);
      const unsigned tg = og / nx;
      if (og + 1u == (tg + 1u) * nx) xb_add(&bar[XB_TOPGEN], 1u);
      else XB_SPIN(xb_ld(&bar[XB_TOPGEN]) == tg, bar);
      __builtin_amdgcn_fence(__ATOMIC_ACQUIRE, "agent");
      xb_add(&bar[XB_XGEN(x)], 1u);
      asm volatile("s_waitcnt vmcnt(0)" ::: "memory");
    } else {
      XB_SPIN(xb_ld(&bar[XB_XGEN(x)]) == gen, bar);
      __builtin_amdgcn_fence(__ATOMIC_ACQUIRE, "agent");
      asm volatile("s_waitcnt vmcnt(0)" ::: "memory");
    }
  }
  __syncthreads();
}

__device__ __forceinline__ Job job_kv(unsigned char* ws, int l) {
  bf16_t* wl = (bf16_t*)(ws + WS_W) + W_LAY + (size_t)l * W_LAY_SZ;
  return job_std((bf16_t*)(ws + WS_MB), DM, wl + (size_t)1024 * DM, DM, DM, 16, 8, (bf16_t*)(ws + WS_KV), 2048);
}
__device__ __forceinline__ Job job_qk(unsigned char* ws, int l) {
  bf16_t* wl = (bf16_t*)(ws + WS_W) + W_LAY + (size_t)l * W_LAY_SZ;
  Job j = job_std((bf16_t*)(ws + WS_KV), 2048, wl, DM, 256, 64, 4, (bf16_t*)(ws + WS_WQK), DM);
  j.adiv = 4; j.a1 = 256 * 2048; j.a0 = 256; j.bdiv = 4; j.b1 = 0; j.b0 = 256; j.b2 = 256 * DM;
  return j;
}
__device__ __forceinline__ Job job_vo(unsigned char* ws, int l) {
  bf16_t* wl = (bf16_t*)(ws + WS_W) + W_LAY + (size_t)l * W_LAY_SZ;
  Job j = job_std(wl + (size_t)3072 * DM, DM, (bf16_t*)(ws + WS_KV) + 1024, 2048, 256, 16, 16, (bf16_t*)(ws + WS_VWO), DM);
  j.adiv = 4; j.a0 = 256 * DM; j.a1 = 256; j.bdiv = 4; j.b1 = 256; j.b0 = 0; j.b2 = 256 * 2048;
  j.odiv = 4; j.r1 = 0; j.r0 = 256; j.r2 = 1024; j.c1 = 256; j.c0 = 0; j.c2 = 0;
  return j;
}

__global__ void __launch_bounds__(512, 2) fwd_megakernel(Params p) {
  extern __shared__ __attribute__((aligned(16))) unsigned char lds_raw[];
  LAS unsigned char* lds = (LAS unsigned char*)lds_raw;
  cg::grid_group grid = cg::this_grid();
  const int G = gridDim.x, bx = blockIdx.x;

  volatile LAS unsigned* barst = (volatile LAS unsigned*)(lds + BARST_OFF);
  if (threadIdx.x < 4) barst[threadIdx.x] = 0u;
  if (bx == 0) { unsigned* bar = (unsigned*)kws(); for (int i = threadIdx.x; i < XCD_BAR_WORDS; i += 512) bar[i] = 0u; }
#ifndef NO_PRO
  prologue(lds);
#endif
  grid.sync();
  if (threadIdx.x == 0) (void)xb_add(&((unsigned*)kws())[XB_XCNT(xb_xcc_id())], 1u);
#define GRID_SYNC() xcd_barrier(barst)

#pragma unroll 1
  for (int l = 0; l < DEPTH; ++l) {
    const int jx = l >> 1;
    if ((l & 1) == 0) {
      { unsigned char* ws = kws(); bf16_t* we = (bf16_t*)(ws + WS_W) + W_EVEN + (size_t)jx * W_EVEN_SZ;
        Job js = job_std(we, DM, (bf16_t*)(ws + WS_HB), DM, DM, 4, 256, (bf16_t*)(ws + WS_Z + Z_DT), 0); js.ssp = (float*)(ws + WS_SSP); js.O2 = (bf16_t*)(ws + WS_Z + Z_VT);
        gemm_phase<EPI_SWAP>(lds, js, G, bx); }
      { unsigned char* ws = kws(); bf16_t* we = (bf16_t*)(ws + WS_W) + W_EVEN + (size_t)jx * W_EVEN_SZ;
        Job jq = job_std((bf16_t*)(ws + WS_HB), DM, we + (size_t)1024 * DM, DM, DM, 256, 4, (bf16_t*)(ws + WS_Z + Z_QK), DM); jq.ssp = (float*)(ws + WS_SSP);
        gemm_phase<EPI_SCALE>(lds, jq, G, bx); }
      { const Job jkv = job_kv(kws(), l); gemm_phase<EPI_SCALE>(lds, jkv, G, bx); }
      GRID_SYNC();
      { unsigned char* ws = kws();
        Job jd = job_std((bf16_t*)(ws + WS_FCAT), 8192, (bf16_t*)(ws + WS_Z + Z_DT), 8192, 8192, 128, 2, (bf16_t*)(ws + WS_Z + Z_YE), DM);
        jd.adiv = 8; jd.a0 = 256 * 8192; jd.a1 = 0; jd.a2 = 2048 * 8192;     jd.bdiv = 8; jd.b1 = 512 * 8192; jd.b0 = 0; jd.b2 = 256 * 8192; jd.cscale = 0.0013810679320049757f;
        jd.chain = 4;
        gemm_phase<EPI_DFT>(lds, jd, G, bx);
        dft_mid_row((bf16_t*)(ws + WS_Z + Z_DT), (bf16_t*)(ws + WS_Z + Z_YE), 0.0013810679320049757f); }
      { const Job jqk = job_qk(kws(), l); gemm_phase<EPI_SCALE>(lds, jqk, G, bx); }
      { const Job jvo = job_vo(kws(), l); gemm_phase<EPI_SCALE>(lds, jvo, G, bx); }
#ifndef NO_NATTEN
      { unsigned char* ws = kws();
        natten_phase((bf16_t*)(ws + WS_Z + Z_QK), (bf16_t*)(ws + WS_Z + Z_VT), (bf16_t*)(ws + WS_Z + Z_YE), kin(5) + (size_t)jx * 4 * 15 * 31, (LAS float*)(lds + XCH_OFF)); }
#endif
      GRID_SYNC();
    } else {
      { unsigned char* ws = kws(); bf16_t* wo = (bf16_t*)(ws + WS_W) + W_ODD + (size_t)jx * W_ODD_SZ;
        Job ji = job_std((bf16_t*)(ws + WS_HB), DM, wo, DM, DM, 256, 4, (bf16_t*)(ws + WS_Z), DM); ji.ssp = (float*)(ws + WS_SSP);
        gemm_phase<EPI_SCALE>(lds, ji, G, bx); }
      { const Job jkv = job_kv(kws(), l); gemm_phase<EPI_SCALE>(lds, jkv, G, bx); }
      GRID_SYNC();
      { unsigned char* ws = kws(); bf16_t* wo = (bf16_t*)(ws + WS_W) + W_ODD + (size_t)jx * W_ODD_SZ;
        Job jc = job_std((bf16_t*)(ws + WS_HB) - DM, DM, wo + (size_t)1024 * DM, DM, DM, 272, 8, (bf16_t*)(ws + WS_Z + Z_YO), DM); jc.ssp = (float*)(ws + WS_SSP);
        jc.adiv = 17; jc.a1 = SEQ * DM; jc.a0 = 254 * DM; jc.cw = kin(8) + (size_t)jx * 3 * DM; jc.GB = (const bf16_t*)(ws + WS_Z);
        gemm_phase<EPI_GCONV>(lds, jc, G, bx); }
      { const Job jqk = job_qk(kws(), l); gemm_phase<EPI_SCALE>(lds, jqk, G, bx); }
      { const Job jvo = job_vo(kws(), l); gemm_phase<EPI_SCALE>(lds, jvo, G, bx); }
      GRID_SYNC();
    }
    { unsigned char* ws = kws(); bf16_t* wb = (bf16_t*)(ws + WS_W);
      const bf16_t* wout = ((l & 1) == 0) ? wb + W_EVEN + (size_t)jx * W_EVEN_SZ + (size_t)2048 * DM : wb + W_ODD + (size_t)jx * W_ODD_SZ + (size_t)3072 * DM;
      const bf16_t* Ymix = (bf16_t*)(ws + WS_Z + (((l & 1) == 0) ? Z_YE : Z_YO));
      Job jo = job_std(Ymix, DM, wout, DM, DM, 256, 4, (bf16_t*)(ws + WS_HB), DM); jo.sspw = (float*)(ws + WS_SSP);
      gemm_phase<EPI_RES>(lds, jo, G, bx); }
    GRID_SYNC();
    { unsigned char* ws = kws();
      Job jx1 = job_std((bf16_t*)(ws + WS_HB), DM, (bf16_t*)(ws + WS_WQK), DM, DM, 256, 4, (bf16_t*)(ws + WS_Z), DM); jx1.bdiv = 16; jx1.b1 = DM * DM; jx1.ssp = (float*)(ws + WS_SSP);
      gemm_phase<EPI_SOFTMAX>(lds, jx1, G, bx); }
    GRID_SYNC();
    { unsigned char* ws = kws();
      Job jx2 = job_std((bf16_t*)(ws + WS_Z), DM, (bf16_t*)(ws + WS_VWO), DM, DM, 256, 4, (bf16_t*)(ws + WS_HB), DM); jx2.bdiv = 16; jx2.b1 = DM * DM; jx2.sspw = (float*)(ws + WS_SSP);
      gemm_phase<EPI_RES>(lds, jx2, G, bx); }
    GRID_SYNC();
    { unsigned char* ws = kws(); bf16_t* wl = (bf16_t*)(ws + WS_W) + W_LAY + (size_t)l * W_LAY_SZ;
      Job ju = job_std((bf16_t*)(ws + WS_HB), DM, wl + (size_t)4096 * DM, DM, DM, 256, 16, (bf16_t*)(ws + WS_Z), DFF); ju.ssp = (float*)(ws + WS_SSP);
      ju.chain = 1; ju.cw = kin(16) + (size_t)l * 3 * DFF; ju.cb = kin(17) + (size_t)l * DFF;
      gemm_phase<EPI_FFN>(lds, ju, G, bx); }
    GRID_SYNC();
    { unsigned char* ws = kws(); bf16_t* wl = (bf16_t*)(ws + WS_W) + W_LAY + (size_t)l * W_LAY_SZ;
      Job jd2 = job_std((bf16_t*)(ws + WS_Z), DFF, wl + (size_t)8192 * DM, DFF, DFF, 256, 4, (bf16_t*)(ws + WS_HB), DM); jd2.sspw = (float*)(ws + WS_SSP);
      gemm_phase<EPI_RES>(lds, jd2, G, bx); }
    GRID_SYNC();
  }
  {
    int tid = threadIdx.x; asm volatile("" : "+v"(tid));
    const int lane = tid & 63, gwave = bx * 8 + (tid >> 6), ngw = G * 8;
    float* H = kout(); unsigned char* ws = kws(); const float* ssp = (const float*)(ws + WS_SSP); const bf16_t* HB = (const bf16_t*)(ws + WS_HB); const float* gf = kin(19);
    f32x4 gg[4];
#pragma unroll
    for (int j = 0; j < 4; ++j) gg[j] = *((const f32x4*)gf + lane + 64 * j);
    for (int r = gwave; r < NTOK; r += 2 * ngw) {
      u32x2 hv[2][4]; float rs[2];
#pragma unroll
      for (int q = 0; q < 2; ++q) { const int rq = min(r + q * ngw, NTOK - 1); rs[q] = rstd_of(ssp, (size_t)rq);
#pragma unroll
        for (int j = 0; j < 4; ++j) hv[q][j] = *((const u32x2*)(HB + (size_t)rq * DM) + lane + 64 * j); }
#pragma unroll
      for (int q = 0; q < 2; ++q) { if (r + q * ngw >= NTOK) continue;
        f32x4* orow = (f32x4*)(H + (size_t)(r + q * ngw) * DM) + lane;
#pragma unroll
        for (int j = 0; j < 4; ++j) { const f32x4 v = (f32x4){bf_lo(hv[q][j].x), bf_hi(hv[q][j].x), bf_lo(hv[q][j].y), bf_hi(hv[q][j].y)}; orow[64 * j] = v * rs[q] * gg[j]; } }
    }
  }
}

extern "C" void kernel_launch(void* const* d_in, const int* in_sizes, int n_in, void* d_out, int out_size, void* d_ws, size_t ws_size, hipStream_t stream) {
  static int grid_blocks = 0;
  if (!grid_blocks) {
    int dev = 0, cus = 0, per_cu = 0;
    (void)hipGetDevice(&dev);
    (void)hipDeviceGetAttribute(&cus, hipDeviceAttributeMultiprocessorCount, dev);
    (void)hipFuncSetAttribute((const void*)fwd_megakernel, hipFuncAttributeMaxDynamicSharedMemorySize, LDS_BYTES);
    (void)hipOccupancyMaxActiveBlocksPerMultiprocessor(&per_cu, (const void*)fwd_megakernel, 512, LDS_BYTES);
    if (per_cu < 1) per_cu = 1;
    grid_blocks = cus * per_cu;
    if (n_in != 20 || out_size != NTOK * DM || ws_size < WS_END) { fprintf(stderr, "kernel_launch: unexpected shapes/workspace (n_in %d out %d ws %zu)\n", n_in, out_size, ws_size); grid_blocks = -1; }
  }
  if (grid_blocks < 0) return;
  Params p{};
  for (int i = 0; i < 20; ++i) p.in[i] = (const float*)d_in[i];
  p.out = (float*)d_out; p.ws = (unsigned char*)d_ws;
  void* args[] = {&p};
  hipError_t e = hipLaunchCooperativeKernel((void*)fwd_megakernel, dim3(grid_blocks), dim3(512), args, LDS_BYTES, stream);
  if (e != hipSuccess) fprintf(stderr, "cooperative launch failed: %s (grid %d)\n", hipGetErrorString(e), grid_blocks);
}
#ifdef TEST_EPI
__global__ void __launch_bounds__(512, 2) test_kernel(Job j, int G) {
  extern __shared__ __attribute__((aligned(16))) unsigned char lds_raw[];
  gemm_phase<TEST_EPI>((LAS unsigned char*)lds_raw, j, G, blockIdx.x);
}
#endif
```
